# Optimizing an MI355X kernel written in HIP

```python
import math
import jax, jax.numpy as jnp
from jax import lax
import numpy as np

D_MODEL = 1024
BATCH = 8
SEQ = 2048
DEPTH = 4
DEC_BATCH = 128
DEC_SEQ = 4
PAST_LEN = 8192
PAGE_SIZE = 128

N_META = 16
HEAD_DIM = 64
N_Q_HEADS = 8
N_KV_HEADS = 2
Q_PER_KV = N_Q_HEADS // N_KV_HEADS
ATTN_WIDTH = N_Q_HEADS * HEAD_DIM
KV_WIDTH = N_KV_HEADS * HEAD_DIM
WINDOW = 128
ATTN_BLOCK = 128
ROPE_THETA = 10000.0
D_RNN = D_MODEL
N_LRU_BLOCKS = 8
LRU_BLOCK = D_RNN // N_LRU_BLOCKS
CONV_W = 4
LRU_C = 8.0
D_FF = -(-8 * D_MODEL // (3 * 256)) * 256
LN_EPS = 1e-5
NEG_INF = -1e30
DEEPNORM_ALPHA = (2 * DEPTH) ** 0.25
DEEPNORM_BETA = (8 * DEPTH) ** -0.25

Q_END = ATTN_WIDTH
K_END = Q_END + KV_WIDTH
V_END = K_END + KV_WIDTH
XR_END = V_END + D_RNN
GATE_END = XR_END + D_RNN
GA_END = GATE_END + D_MODEL
D_IN = GA_END + D_MODEL

kernel_name = 'griffin_swa_sink_rglru_deepnorm_meta_step'


def layer_norm(x, g, b):
    x32 = x.astype(jnp.float32)
    mu = x32.mean(-1, keepdims=True)
    var = jnp.square(x32 - mu).mean(-1, keepdims=True)
    y = (x32 - mu) * lax.rsqrt(var + LN_EPS) * g.astype(jnp.float32) + b.astype(jnp.float32)
    return y.astype(x.dtype)


def rope(x, pos):
    half = HEAD_DIM // 2
    inv = ROPE_THETA ** (-jnp.arange(half, dtype=jnp.float32) / half)
    ang = pos.astype(jnp.float32)[:, None] * inv[None, :]
    cos = jnp.cos(ang)[None, :, None, :]
    sin = jnp.sin(ang)[None, :, None, :]
    x32 = x.astype(jnp.float32)
    x1, x2 = x32[..., :half], x32[..., half:]
    return jnp.concatenate([x1 * cos - x2 * sin, x2 * cos + x1 * sin], axis=-1).astype(x.dtype)


def sink_attention(q, k, v, valid, sinks):
    s = jnp.einsum('bnqkgd,bnskd->bnkgqs', q, k, preferred_element_type=jnp.float32) * (HEAD_DIM ** -0.5)
    s = jnp.where(valid[None, :, None, None], s, NEG_INF)
    sink = sinks.astype(jnp.float32).reshape(N_KV_HEADS, Q_PER_KV)[None, None, :, :, None, None]
    m = jnp.maximum(s.max(-1, keepdims=True), sink)
    p = jnp.exp(s - m)
    denom = p.sum(-1, keepdims=True) + jnp.exp(sink - m)
    return jnp.einsum('bnkgqs,bnskd->bnqkgd', (p / denom).astype(v.dtype), v)


def window_mask(qpos, kpos):
    qp = qpos[..., :, None]
    kp = kpos[..., None, :]
    return (kp <= qp) & (kp > qp - WINDOW) & (kp >= 0)


def attn_prompt(q, k, v, sinks):
    B, L = q.shape[:2]
    pad = (-L) % ATTN_BLOCK
    Lp = L + pad
    nb = Lp // ATTN_BLOCK

    def padf(t):
        return jnp.pad(t, ((0, 0), (pad, 0)) + ((0, 0),) * (t.ndim - 2))

    def with_prev(t):
        prev = jnp.concatenate([jnp.zeros_like(t[:, :1]), t[:, :-1]], axis=1)
        return jnp.concatenate([prev, t], axis=2)

    qb = padf(q).reshape(B, nb, ATTN_BLOCK, N_KV_HEADS, Q_PER_KV, HEAD_DIM)
    kb = with_prev(padf(k).reshape(B, nb, ATTN_BLOCK, N_KV_HEADS, HEAD_DIM))
    vb = with_prev(padf(v).reshape(B, nb, ATTN_BLOCK, N_KV_HEADS, HEAD_DIM))
    qpos = (jnp.arange(Lp, dtype=jnp.int32) - pad).reshape(nb, ATTN_BLOCK)
    kpos = jnp.concatenate([qpos - ATTN_BLOCK, qpos], axis=1)
    o = sink_attention(qb, kb, vb, window_mask(qpos, kpos), sinks)
    return o.reshape(B, Lp, ATTN_WIDTH)[:, pad:]


def attn_sample(q, k_new, v_new, k_buf, v_buf, sinks):
    DB, S = q.shape[:2]
    W = k_buf.shape[1]
    kk = jnp.concatenate([k_buf.astype(k_new.dtype), k_new], axis=1)
    vv = jnp.concatenate([v_buf.astype(v_new.dtype), v_new], axis=1)
    qpos = PAST_LEN + jnp.arange(S, dtype=jnp.int32)
    kpos = jnp.concatenate([PAST_LEN - W + jnp.arange(W, dtype=jnp.int32), qpos])
    valid = window_mask(qpos, kpos)[None]
    o = sink_attention(q.reshape(DB, 1, S, N_KV_HEADS, Q_PER_KV, HEAD_DIM), kk[:, None], vv[:, None], valid, sinks)
    return o.reshape(DB, S, ATTN_WIDTH), kk[:, S:], vv[:, S:]


def causal_conv(xr, buf, w, b):
    T = xr.shape[1]
    xe = jnp.concatenate([buf.astype(xr.dtype), xr], axis=1)
    y = sum(xe[:, j:j + T] * w[j] for j in range(CONV_W)) + b
    return y, xe[:, -(CONV_W - 1):]


def _lin_combine(c1, c2):
    a1, b1 = c1
    a2, b2 = c2
    return a1 * a2, a2 * b1 + b2


def rg_lru(xc, h0, wa, ba, wx, bx, lam):
    B, T, _ = xc.shape
    x32 = xc.astype(jnp.float32)
    xb = x32.reshape(B, T, N_LRU_BLOCKS, LRU_BLOCK)
    r = jax.nn.sigmoid(jnp.einsum('btnc,ncd->btnd', xb, wa.astype(jnp.float32)).reshape(B, T, D_RNN) + ba.astype(jnp.float32))
    i = jax.nn.sigmoid(jnp.einsum('btnc,ncd->btnd', xb, wx.astype(jnp.float32)).reshape(B, T, D_RNN) + bx.astype(jnp.float32))
    log_a = -LRU_C * r * jax.nn.softplus(-lam.astype(jnp.float32))
    a = jnp.exp(log_a)
    b = jnp.sqrt(-jnp.expm1(2.0 * log_a)) * (i * x32)
    b = b.at[:, 0].add(a[:, 0] * h0.astype(jnp.float32))
    _, h = lax.associative_scan(_lin_combine, (a, b), axis=1)
    return h, h[:, -1]


def mixer_block(x, pos, l, p, k_buf, v_buf, conv_buf, h0):
    B, T, _ = x.shape
    proj = x @ p['w_in'][l]
    q = rope(proj[..., :Q_END].reshape(B, T, N_Q_HEADS, HEAD_DIM), pos)
    k = rope(proj[..., Q_END:K_END].reshape(B, T, N_KV_HEADS, HEAD_DIM), pos)
    v = proj[..., K_END:V_END].reshape(B, T, N_KV_HEADS, HEAD_DIM)
    xr = proj[..., V_END:XR_END]
    gate = proj[..., XR_END:GATE_END]
    g_attn = proj[..., GATE_END:GA_END]
    g_lru = proj[..., GA_END:]
    sinks = p['attn_sinks'][l]
    if k_buf is None:
        attn = attn_prompt(q, k, v, sinks)
        new_k, new_v = k[:, -WINDOW:], v[:, -WINDOW:]
    else:
        attn, new_k, new_v = attn_sample(q, k, v, k_buf, v_buf, sinks)
    xc, new_conv = causal_conv(xr, conv_buf, p['conv_w'][l], p['conv_b'][l])
    h, h_last = rg_lru(xc, h0, p['lru_wa'][l], p['lru_ba'][l], p['lru_wx'][l], p['lru_bx'][l], p['lru_lambda'][l])
    rec = h.astype(x.dtype) * jax.nn.gelu(gate)
    merged = (jax.nn.sigmoid(g_attn) * (attn @ p['w_attn_proj'][l])
              + jax.nn.sigmoid(g_lru) * (rec @ p['w_lru_proj'][l]))
    return merged @ p['w_out'][l], (new_k, new_v, new_conv, h_last.astype(x.dtype))


def swiglu(x, w_in, w_out):
    u = x @ w_in
    return (jax.nn.silu(u[..., :D_FF]) * u[..., D_FF:]) @ w_out


def trunk(x, pos, p, cache_k, cache_v, conv_state, lru_state):
    B = x.shape[0]
    outs = ([], [], [], [])
    for l in range(DEPTH):
        if cache_k is None:
            kb = vb = None
            cb = jnp.zeros((B, CONV_W - 1, D_RNN), x.dtype)
            h0 = jnp.zeros((B, D_RNN), x.dtype)
        else:
            kb, vb, cb, h0 = cache_k[l], cache_v[l], conv_state[l], lru_state[l]
        mix, st = mixer_block(x, pos, l, p, kb, vb, cb, h0)
        x = layer_norm(DEEPNORM_ALPHA * x + mix, p['ln1_g'][l], p['ln1_b'][l])
        x = layer_norm(DEEPNORM_ALPHA * x + swiglu(x, p['w_ffn_in'][l], p['w_ffn_out'][l]), p['ln2_g'][l], p['ln2_b'][l])
        for o, s in zip(outs, st):
            o.append(s)
    return x, [jnp.stack(o) for o in outs]


def setup_inputs(seed: int = 0) -> dict:
    key = jax.random.key(seed)
    ks = jax.random.split(key, 32)
    f32 = jnp.float32

    def nrm(k, shape, scale=1.0):
        return jax.random.normal(k, shape, f32) * scale

    a_c = jax.random.uniform(ks[14], (DEPTH, D_RNN), f32, 0.9, 0.999)
    a_base = a_c ** (1.0 / LRU_C)
    lru_lambda = jnp.log(a_base) - jnp.log1p(-a_base)
    return {
        'x_prompt': nrm(ks[0], (BATCH, SEQ, D_MODEL)),
        'x_sample': nrm(ks[1], (DEC_BATCH, DEC_SEQ, D_MODEL)),
        'cache_win_k': nrm(ks[2], (DEPTH, DEC_BATCH, WINDOW, N_KV_HEADS, HEAD_DIM)),
        'cache_win_v': nrm(ks[3], (DEPTH, DEC_BATCH, WINDOW, N_KV_HEADS, HEAD_DIM)),
        'state_conv': nrm(ks[4], (DEPTH, DEC_BATCH, CONV_W - 1, D_RNN)),
        'state_lru': nrm(ks[5], (DEPTH, DEC_BATCH, D_RNN), 0.5),
        'meta_tokens': nrm(ks[6], (N_META, D_MODEL)),
        'w_in': nrm(ks[7], (DEPTH, D_MODEL, D_IN), D_MODEL ** -0.5),
        'w_attn_proj': nrm(ks[8], (DEPTH, ATTN_WIDTH, D_MODEL), ATTN_WIDTH ** -0.5),
        'w_lru_proj': nrm(ks[9], (DEPTH, D_RNN, D_MODEL), D_RNN ** -0.5),
        'w_out': nrm(ks[10], (DEPTH, D_MODEL, D_MODEL), DEEPNORM_BETA * D_MODEL ** -0.5),
        'attn_sinks': nrm(ks[11], (DEPTH, N_Q_HEADS), 0.5),
        'conv_w': nrm(ks[12], (DEPTH, CONV_W, D_RNN), CONV_W ** -0.5),
        'conv_b': nrm(ks[13], (DEPTH, D_RNN), 0.01),
        'lru_wa': nrm(ks[15], (DEPTH, N_LRU_BLOCKS, LRU_BLOCK, LRU_BLOCK), LRU_BLOCK ** -0.5),
        'lru_ba': nrm(ks[16], (DEPTH, D_RNN), 0.01),
        'lru_wx': nrm(ks[17], (DEPTH, N_LRU_BLOCKS, LRU_BLOCK, LRU_BLOCK), LRU_BLOCK ** -0.5),
        'lru_bx': nrm(ks[18], (DEPTH, D_RNN), 0.01),
        'lru_lambda': lru_lambda,
        'ln1_g': 1.0 + nrm(ks[19], (DEPTH, D_MODEL), 0.01),
        'ln1_b': nrm(ks[20], (DEPTH, D_MODEL), 0.01),
        'w_ffn_in': nrm(ks[21], (DEPTH, D_MODEL, 2 * D_FF), D_MODEL ** -0.5),
        'w_ffn_out': nrm(ks[22], (DEPTH, D_FF, D_MODEL), DEEPNORM_BETA * D_FF ** -0.5),
        'ln2_g': 1.0 + nrm(ks[23], (DEPTH, D_MODEL), 0.01),
        'ln2_b': nrm(ks[24], (DEPTH, D_MODEL), 0.01),
    }


def reference(x_prompt, x_sample, cache_win_k, cache_win_v, state_conv, state_lru,
              meta_tokens, w_in, w_attn_proj, w_lru_proj, w_out, attn_sinks,
              conv_w, conv_b, lru_wa, lru_ba, lru_wx, lru_bx, lru_lambda,
              ln1_g, ln1_b, w_ffn_in, w_ffn_out, ln2_g, ln2_b):
    p = dict(w_in=w_in, w_attn_proj=w_attn_proj, w_lru_proj=w_lru_proj, w_out=w_out,
             attn_sinks=attn_sinks, conv_w=conv_w, conv_b=conv_b, lru_wa=lru_wa, lru_ba=lru_ba,
             lru_wx=lru_wx, lru_bx=lru_bx, lru_lambda=lru_lambda, ln1_g=ln1_g, ln1_b=ln1_b,
             w_ffn_in=w_ffn_in, w_ffn_out=w_ffn_out, ln2_g=ln2_g, ln2_b=ln2_b)
    B, T, D = x_prompt.shape
    meta = jnp.broadcast_to(meta_tokens.astype(x_prompt.dtype)[None], (B, N_META, D))
    xp = jnp.concatenate([meta, x_prompt], axis=1)
    pos_p = jnp.arange(T + N_META, dtype=jnp.int32)
    yp, st_p = trunk(xp, pos_p, p, None, None, None, None)
    pos_s = PAST_LEN + jnp.arange(x_sample.shape[1], dtype=jnp.int32)
    ys, st_s = trunk(x_sample, pos_s, p, cache_win_k, cache_win_v, state_conv, state_lru)
    return (yp[:, N_META:], ys, st_p[0], st_p[1], st_p[2], st_p[3], st_s[0], st_s[1], st_s[2], st_s[3])
```

```cpp
#include <hip/hip_runtime.h>
#include <hip/hip_cooperative_groups.h>
#include <cstdio>
#include <cstdint>
namespace cg = cooperative_groups;
namespace pg8 {
#define PG8_LAS __attribute__((address_space(3)))
typedef unsigned short bf16_t;
typedef short bf16x8 __attribute__((ext_vector_type(8)));
typedef float f32x4 __attribute__((ext_vector_type(4)));
typedef unsigned u32x4 __attribute__((ext_vector_type(4)));
constexpr int BM = 256, BK = 64, HALF = 128, HTB = HALF * BK * 2  , STAGE_BYTES = 8 * HTB, NXCD = 8, WGM = 8;

__host__ __device__ __forceinline__ int lds_byte(int r, int c) { const int st = (r >> 4) * 2 + (c >> 5), rr = r & 15, cc = c & 31, ob = rr * 64 + cc * 2; return st * 1024 + (ob ^ (((ob >> 9) & 1) << 5)); }
__host__ __device__ __forceinline__ void stage_rc(int b, int& R, int& C) { const int st = b / 1024, sb = b % 1024, swz = sb ^ (((sb >> 9) & 1) << 5); R = (st >> 1) * 16 + swz / 64; C = (st & 1) * 32 + (swz % 64) / 2; }
__host__ __device__ __forceinline__ int perm32(int rho) { const int n = rho >> 4, i = rho & 15; return 8 * (i >> 2) + 4 * n + (i & 3); }

struct Unit { int pm, pn; };
struct Gemm { const bf16_t* A; const bf16_t* Bt; int M, N, K; };

struct StaticOrder {
    int nM, nN, nwg, G, c;
    __host__ __device__ void init(int M, int N, int G_, int c_) { nM = M / BM; nN = N / BM; nwg = nM * nN; G = G_; c = c_; }
    __host__ __device__ bool next(int i, Unit& u) const {
        const long L = (long)i * G + c; if (L >= nwg) return false;
        int wgid = (int)L; { const int q = nwg / NXCD, r = nwg % NXCD, xcd = wgid % NXCD, off = wgid / NXCD; wgid = (xcd < r ? xcd * (q + 1) : r * (q + 1) + (xcd - r) * q) + off; }
        const int nig = WGM * nN, gid = wgid / nig, fm = gid * WGM, gsz = (nM - fm) < WGM ? (nM - fm) : WGM;
        u.pm = fm + ((wgid % nig) % gsz); u.pn = (wgid % nig) / gsz; return true;
    }
    __device__ __forceinline__ void a_ready(const Unit&) const {}
    __device__ __forceinline__ void done(const Unit&) const {}
};

template <class Epi, class Sched, bool ALIGN_EPI = false, bool SP2 = false>
__device__ __forceinline__ void gemm_phase(PG8_LAS unsigned char* lds, const Gemm g, const Sched& S, const Epi& E) {
    int tid_ = threadIdx.x; asm volatile("" : "+v"(tid_));
    const int tid = tid_, wid = __builtin_amdgcn_readfirstlane(tid >> 6), lane = tid & 63, wr = wid >> 2, wc = wid & 3, fr = lane & 15, fq = lane >> 4;
    const int K = g.K, nt = K / BK;
    unsigned voffA[2], voffB[2];
#pragma unroll
    for (int i = 0; i < 2; ++i) { int R, C; stage_rc(tid * 16 + i * 8192, R, C); const int Rb = Epi::PERM ? ((R & ~31) + perm32(R & 31)) : R;
        voffA[i] = (unsigned)(R * K + C) * 2u; voffB[i] = (unsigned)(Rb * K + C) * 2u; }
    const size_t kstep = (size_t)(BK * 2);
    const size_t hstep = (size_t)HALF * K * 2;
    const size_t tstep = 2 * hstep;
    const unsigned ldsw = (unsigned)wid * 1024u;
    const int aoff = lds_byte(wr * 64 + fr, fq * 8), boff = lds_byte(wc * 32 + fr, fq * 8);
#define PG8_SA(b, h) (((b) * 2 + (h)) * HTB)
#define PG8_SB(b, h) ((4 + (b) * 2 + (h)) * HTB)
#define PG8_STAGE(bufoff, gbase, voff) do { _Pragma("unroll") for (int _i = 0; _i < 2; ++_i) \
        __builtin_amdgcn_global_load_lds((const unsigned*)((const char*)(gbase) + (voff)[_i]), (PG8_LAS unsigned*)(lds + (bufoff) + ldsw + _i * 8192), 16, 0, 0); } while (0)
#define PG8_LDA(dst, b, h) do { _Pragma("unroll") for (int m = 0; m < 4; ++m) _Pragma("unroll") for (int k = 0; k < 2; ++k) dst[m][k] = *(const PG8_LAS bf16x8*)(lds + PG8_SA(b, h) + aoff + m * 2048 + k * 1024); } while (0)
#define PG8_LDB(dst, b, h) do { _Pragma("unroll") for (int n = 0; n < 2; ++n) _Pragma("unroll") for (int k = 0; k < 2; ++k) dst[n][k] = *(const PG8_LAS bf16x8*)(lds + PG8_SB(b, h) + boff + n * 2048 + k * 1024); } while (0)
#define PG8_MMA(ai, bj, At, Bt) do { __builtin_amdgcn_s_setprio(1); _Pragma("unroll") for (int m = 0; m < 4; ++m) _Pragma("unroll") for (int n = 0; n < 2; ++n) _Pragma("unroll") for (int k = 0; k < 2; ++k) \
        acc[ai][bj][m][n] = __builtin_amdgcn_mfma_f32_16x16x32_bf16(Bt[n][k], At[m][k], acc[ai][bj][m][n], 0, 0, 0); __builtin_amdgcn_s_setprio(0); } while (0)
#define PG8_WAIT_V(n) asm volatile("s_waitcnt vmcnt(" #n ")" ::: "memory")
#define PG8_WAIT_L(n) asm volatile("s_waitcnt lgkmcnt(" #n ")" ::: "memory")
#define PG8_BAR __builtin_amdgcn_s_barrier()
#define PG8_SCHED __builtin_amdgcn_sched_barrier(0)
    Unit cur, nxt; int ui = 0;
    if (!S.next(0, cur)) return;
    f32x4 acc[2][2][4][2];
#pragma unroll
    for (int a = 0; a < 2; ++a)
#pragma unroll
        for (int b = 0; b < 2; ++b)
#pragma unroll
            for (int m = 0; m < 4; ++m)
#pragma unroll
                for (int n = 0; n < 2; ++n) acc[a][b][m][n] = (f32x4){0.f, 0.f, 0.f, 0.f};
    bf16x8 At[4][2], B0[2][2], B1[2][2];
    const char* cA = (const char*)g.A + (size_t)cur.pm * tstep; const char* cB = (const char*)g.Bt + (size_t)cur.pn * tstep;
    S.a_ready(cur);
    if constexpr (SP2) {
        PG8_STAGE(PG8_SB(0, 0), cB, voffB); PG8_STAGE(PG8_SB(0, 1), cB + hstep, voffB); PG8_STAGE(PG8_SA(0, 0), cA, voffA); PG8_STAGE(PG8_SA(0, 1), cA + hstep, voffA);
        if (wr == 1) PG8_BAR;
        PG8_WAIT_V(2); PG8_BAR;
        PG8_STAGE(PG8_SB(1, 0), cB + kstep, voffB); PG8_STAGE(PG8_SA(1, 0), cA + kstep, voffA); PG8_STAGE(PG8_SB(1, 1), cB + hstep + kstep, voffB);
        PG8_WAIT_V(6); PG8_BAR;
    } else {
        PG8_STAGE(PG8_SB(0, 0), cB, voffB); PG8_STAGE(PG8_SA(0, 0), cA, voffA); PG8_STAGE(PG8_SB(0, 1), cB + hstep, voffB); PG8_STAGE(PG8_SA(0, 1), cA + hstep, voffA);
        if (wr == 1) PG8_BAR;
        PG8_WAIT_V(4); PG8_BAR;
        PG8_STAGE(PG8_SB(1, 0), cB + kstep, voffB); PG8_STAGE(PG8_SA(1, 0), cA + kstep, voffA); PG8_STAGE(PG8_SB(1, 1), cB + hstep + kstep, voffB);
        PG8_WAIT_V(6); PG8_BAR;
    }
    for (;;) {
        const bool has_next = S.next(ui + 1, nxt);
        const char* nA = has_next ? (const char*)g.A + (size_t)nxt.pm * tstep : cA; const char* nB = has_next ? (const char*)g.Bt + (size_t)nxt.pn * tstep : cB;
        for (int t = 0; t < nt; t += 2) {
            const bool last = (t == nt - 2);
            const char* a1 = cA + (size_t)(t + 1) * kstep;
            const char* a2 = last ? nA : cA + (size_t)(t + 2) * kstep; const char* b2 = last ? nB : cB + (size_t)(t + 2) * kstep;
            const char* a3 = a2 + kstep; const char* b3 = b2 + kstep;
            if (last && has_next) S.a_ready(nxt);
            if constexpr (SP2) {
            PG8_LDB(B0, 0, 0); PG8_LDB(B1, 0, 1); PG8_SCHED; PG8_LDA(At, 0, 0); PG8_STAGE(PG8_SA(1, 1), a1 + hstep, voffA);
            PG8_WAIT_V(8); PG8_WAIT_L(0); PG8_BAR; PG8_MMA(0, 0, At, B0); PG8_MMA(0, 1, At, B1); PG8_BAR; PG8_SCHED;
            PG8_LDA(At, 0, 1); PG8_STAGE(PG8_SB(0, 0), b2, voffB); PG8_STAGE(PG8_SB(0, 1), b2 + hstep, voffB); PG8_STAGE(PG8_SA(0, 0), a2, voffA);
            PG8_WAIT_V(8); PG8_WAIT_L(0); PG8_BAR; PG8_MMA(1, 0, At, B0); PG8_MMA(1, 1, At, B1); PG8_BAR; PG8_SCHED;
            PG8_LDB(B0, 1, 0); PG8_LDB(B1, 1, 1); PG8_SCHED; PG8_LDA(At, 1, 0); PG8_STAGE(PG8_SA(0, 1), a2 + hstep, voffA);
            PG8_WAIT_V(8); PG8_WAIT_L(0); PG8_BAR; PG8_MMA(0, 0, At, B0); PG8_MMA(0, 1, At, B1); PG8_BAR; PG8_SCHED;
            PG8_LDA(At, 1, 1); PG8_STAGE(PG8_SB(1, 0), b3, voffB); PG8_STAGE(PG8_SB(1, 1), b3 + hstep, voffB); PG8_STAGE(PG8_SA(1, 0), a3, voffA);
            PG8_WAIT_V(8); PG8_WAIT_L(0); PG8_BAR; PG8_MMA(1, 0, At, B0); PG8_MMA(1, 1, At, B1); PG8_BAR; PG8_SCHED;
            } else {
            PG8_LDB(B0, 0, 0); PG8_SCHED; PG8_LDA(At, 0, 0); PG8_STAGE(PG8_SA(1, 1), a1 + hstep, voffA);
            PG8_WAIT_L(8); PG8_BAR; PG8_WAIT_L(0); PG8_MMA(0, 0, At, B0); PG8_BAR; PG8_SCHED;
            PG8_LDB(B1, 0, 1); PG8_STAGE(PG8_SB(0, 0), b2, voffB);
            PG8_BAR; PG8_WAIT_L(0); PG8_MMA(0, 1, At, B1); PG8_BAR;
            PG8_LDA(At, 0, 1); PG8_STAGE(PG8_SA(0, 0), a2, voffA);
            PG8_BAR; PG8_WAIT_L(0); PG8_MMA(1, 0, At, B0); PG8_BAR; PG8_SCHED;
            PG8_STAGE(PG8_SB(0, 1), b2 + hstep, voffB);
            PG8_WAIT_V(6); PG8_BAR; PG8_MMA(1, 1, At, B1); PG8_BAR;
            PG8_LDB(B0, 1, 0); PG8_SCHED; PG8_LDA(At, 1, 0); PG8_STAGE(PG8_SA(0, 1), a2 + hstep, voffA);
            PG8_WAIT_L(8); PG8_BAR; PG8_WAIT_L(0); PG8_MMA(0, 0, At, B0); PG8_BAR; PG8_SCHED;
            PG8_LDB(B1, 1, 1); PG8_STAGE(PG8_SB(1, 0), b3, voffB);
            PG8_BAR; PG8_WAIT_L(0); PG8_MMA(0, 1, At, B1); PG8_BAR;
            PG8_LDA(At, 1, 1); PG8_STAGE(PG8_SA(1, 0), a3, voffA);
            PG8_BAR; PG8_WAIT_L(0); PG8_MMA(1, 0, At, B0); PG8_BAR; PG8_SCHED;
            PG8_STAGE(PG8_SB(1, 1), b3 + hstep, voffB);
            PG8_WAIT_V(6); PG8_BAR; PG8_MMA(1, 1, At, B1); PG8_BAR;
            }
        }
        if constexpr (ALIGN_EPI) { if (wr == 0) PG8_BAR; }
        if constexpr (!Epi::AFTER_DRAIN) { E(acc, cur, wr, wc, fr, fq); S.done(cur); }
        if (!has_next) break;
#pragma unroll
        for (int a = 0; a < 2; ++a)
#pragma unroll
            for (int b = 0; b < 2; ++b)
#pragma unroll
                for (int m = 0; m < 4; ++m)
#pragma unroll
                    for (int n = 0; n < 2; ++n) acc[a][b][m][n] = (f32x4){0.f, 0.f, 0.f, 0.f};
        cur = nxt; cA = nA; cB = nB; ++ui;
        if constexpr (ALIGN_EPI) { if (wr == 1) PG8_BAR; }
    }
    PG8_WAIT_V(0);
    if constexpr (!ALIGN_EPI) { if (wr == 0) PG8_BAR; }
    PG8_BAR;
    if constexpr (Epi::AFTER_DRAIN) { E.fused(acc, cur, wr, wc, fr, fq, lds, wid, lane); S.done(cur); }
#undef PG8_SA
#undef PG8_SB
#undef PG8_STAGE
#undef PG8_LDA
#undef PG8_LDB
#undef PG8_MMA
#undef PG8_WAIT_V
#undef PG8_WAIT_L
#undef PG8_BAR
#undef PG8_SCHED
}
}
#define LAS __attribute__((address_space(3)))
typedef unsigned short bf16;
typedef float f32x4 __attribute__((ext_vector_type(4)));
typedef float f32x16 __attribute__((ext_vector_type(16)));
typedef short bf16x8 __attribute__((ext_vector_type(8)));
typedef short s16x4 __attribute__((ext_vector_type(4)));
typedef unsigned u32x4 __attribute__((ext_vector_type(4)));
typedef unsigned u32x2 __attribute__((ext_vector_type(2)));
typedef float f32x2_t __attribute__((ext_vector_type(2)));
typedef __bf16 bf16x2_t __attribute__((ext_vector_type(2)));

constexpr int D = 1024, LP = 2064, NPT = 8 * LP  , M = NPT + 512  , MP = 17152, DIN = 4864, DFF = 2816, DEPTH = 4;
constexpr int NTILE64 = M / 64;
constexpr float ALPHA = 1.6817928305074292f;
constexpr float LN_EPS = 1e-5f;
constexpr size_t O_YP = 0, O_YS = 16777216, O_WKP = 17301504, O_WVP = 17825792, O_CVP = 18350080, O_LRP = 18448384,
                 O_WKS = 18481152, O_WVS = 26869760, O_CVS = 35258368, O_LRS = 36831232, O_END = 37355520;
constexpr size_t OB_Q = 0, OB_ATT = (size_t)MP * 512 * 2;
constexpr size_t SZ_WIN = (size_t)DIN * D * 2, SZ_WAP = (size_t)D * 512 * 2, SZ_WLP = (size_t)D * D * 2, SZ_WOUT = SZ_WLP, SZ_WFI = (size_t)2 * DFF * D * 2, SZ_WFO = (size_t)D * DFF * 2, SZ_LW = (size_t)8 * 256 * 128 * 2;
constexpr size_t WS_WIN = 0, WS_WAP = WS_WIN + 4 * SZ_WIN, WS_WLP = WS_WAP + 4 * SZ_WAP, WS_WOUT = WS_WLP + 4 * SZ_WLP, WS_WFI = WS_WOUT + 4 * SZ_WOUT, WS_WFO = WS_WFI + 4 * SZ_WFI,
                 WS_LW = WS_WFO + 4 * SZ_WFO, WS_ROPE = WS_LW + 4 * SZ_LW, WS_AGG = WS_ROPE + 1048576, WS_X = WS_AGG + 3145728, WS_XB = WS_X + (size_t)MP * D * 4,
                 WS_R = WS_XB + (size_t)MP * D * 2;
constexpr size_t WS_KB = WS_R, WS_VT = WS_KB + (size_t)MP * 128 * 2, WS_XR = WS_VT + (size_t)MP * 128 * 2, WS_GG = WS_XR + (size_t)MP * D * 2, WS_SA = WS_GG + (size_t)MP * D * 2, WS_SL = WS_SA + (size_t)MP * D * 2,
                 WS_END = WS_SL + (size_t)MP * D * 2;
constexpr size_t WS_H = WS_R;
static_assert(WS_H + (size_t)MP * DFF * 2 <= WS_END, "H overlay");
static_assert(WS_GG == WS_XR + (size_t)MP * D * 2 && WS_SA == WS_GG + (size_t)MP * D * 2 && WS_SL == WS_SA + (size_t)MP * D * 2, "XR|GG|SA|SL consecutive");
constexpr int LDS_BYTES = 147456;

struct Params { const float* in[25]; float* out; unsigned char* ws; };
enum { I_XP = 0, I_XS, I_CK, I_CV, I_SC, I_SLRU, I_META, I_WIN, I_WAP, I_WLP, I_WOUT, I_SINK, I_CW, I_CB, I_WA, I_BA, I_WX, I_BX, I_LAM, I_L1G, I_L1B, I_WFI, I_WFO, I_L2G, I_L2B };

__device__ __forceinline__ unsigned cvtpk(float lo, float hi) { f32x2_t v = {lo, hi}; bf16x2_t b = __builtin_convertvector(v, bf16x2_t); return __builtin_bit_cast(unsigned, b); }
__device__ __forceinline__ bf16 f2bf(float f) { return (bf16)(cvtpk(f, 0.f) & 0xffffu); }
__device__ __forceinline__ float bf2f(unsigned b) { return __uint_as_float(b << 16); }
__device__ __forceinline__ float bflo(unsigned w) { return __uint_as_float(w << 16); }
__device__ __forceinline__ float bfhi(unsigned w) { return __uint_as_float(w & 0xffff0000u); }
__device__ __forceinline__ float sigmoidf_(float x) { return __builtin_amdgcn_rcpf(1.f + __expf(-x)); }
__device__ __forceinline__ float gelu_tanh(float x) { return x * sigmoidf_(1.5957691216057308f * (x + 0.044715f * x * x * x)); }
__device__ __forceinline__ u32x4 pack8(f32x4 a, f32x4 b) { u32x4 w; w.x = cvtpk(a[0], a[1]); w.y = cvtpk(a[2], a[3]); w.z = cvtpk(b[0], b[1]); w.w = cvtpk(b[2], b[3]); return w; }
__device__ __forceinline__ int opaque_tid() { int t = threadIdx.x; asm volatile("" : "+v"(t)); return t; }
__device__ __forceinline__ int crow(int reg, int h) { return (reg & 3) + 8 * (reg >> 2) + 4 * h; }
#define MFMA32(a, b, c) __builtin_amdgcn_mfma_f32_32x32x16_bf16((a), (b), (c), 0, 0, 0)
#define LDS_WAIT() asm volatile("s_waitcnt lgkmcnt(0)" ::: "memory")

struct EpiProj {
    static constexpr bool PERM = true, AFTER_DRAIN = false;
    int l; bf16 *Q, *KB, *VT, *XR; const float* rope; float* out;
    __device__ __forceinline__ static int pos_idx(int row) { return row < NPT ? row % LP : (row < M ? LP + ((row - NPT) & 3) : 0); }
    __device__ __forceinline__ void operator()(const pg8::f32x4 (&acc)[2][2][4][2], const pg8::Unit& u, int wr, int wc, int fr, int fq) const {
        const int pn = u.pn, cl = wc * 32 + 8 * fq;
        if (pn < 3) {
#pragma unroll
            for (int ai = 0; ai < 2; ++ai)
#pragma unroll
                for (int m = 0; m < 4; ++m) {
                    const int row = u.pm * 256 + ai * 128 + wr * 64 + m * 16 + fr;
                    const int pi = pos_idx(row);
                    const int d0 = (cl & 63) >> 1;
                    const f32x4 cs0 = *(const f32x4*)(rope + (size_t)pi * 64 + d0 * 2), cs1 = *(const f32x4*)(rope + (size_t)pi * 64 + d0 * 2 + 4);
#pragma unroll
                    for (int bj = 0; bj < 2; ++bj) {
                        const f32x4 v0 = acc[ai][bj][m][0], v1 = acc[ai][bj][m][1];
                        if (pn == 2 && bj == 1) {
                            const int vc = cl;
                            const f32x4 t0 = v0 + 0.f, t1 = v1 + 0.f;
                            const u32x4 w = pack8(t0, t1);
                            bf16* vt = VT + (size_t)vc * MP + row;
                            vt[0] = (bf16)(w.x & 0xffff); vt[(size_t)MP] = (bf16)(w.x >> 16); vt[(size_t)2 * MP] = (bf16)(w.y & 0xffff); vt[(size_t)3 * MP] = (bf16)(w.y >> 16);
                            vt[(size_t)4 * MP] = (bf16)(w.z & 0xffff); vt[(size_t)5 * MP] = (bf16)(w.z >> 16); vt[(size_t)6 * MP] = (bf16)(w.w & 0xffff); vt[(size_t)7 * MP] = (bf16)(w.w >> 16);
                            float* dst = nullptr;
                            if (row < NPT) { const int t = row % LP; if (t >= LP - 128) dst = out + O_WVP + ((size_t)((l * 8 + row / LP) * 128 + (t - (LP - 128)))) * 128 + vc; }
                            else if (row < M) { const int db = (row - NPT) >> 2, s = (row - NPT) & 3; dst = out + O_WVS + ((size_t)((l * 128 + db) * 128 + 124 + s)) * 128 + vc; }
                            if (dst) { *(f32x4*)dst = t0; *(f32x4*)(dst + 4) = t1; }
                        } else {
                            f32x4 y0, y1;
                            y0[0] = v0[0] * cs0[0] - v0[1] * cs0[1]; y0[1] = v0[1] * cs0[0] + v0[0] * cs0[1];
                            y0[2] = v0[2] * cs0[2] - v0[3] * cs0[3]; y0[3] = v0[3] * cs0[2] + v0[2] * cs0[3];
                            y1[0] = v1[0] * cs1[0] - v1[1] * cs1[1]; y1[1] = v1[1] * cs1[0] + v1[0] * cs1[1];
                            y1[2] = v1[2] * cs1[2] - v1[3] * cs1[3]; y1[3] = v1[3] * cs1[2] + v1[2] * cs1[3];
                            if (pn < 2) {
                                const int col = pn * 256 + bj * 128 + cl;
                                *(u32x4*)(Q + (size_t)row * 512 + col) = pack8(y0 * 0.125f, y1 * 0.125f);
                            } else {
                                *(u32x4*)(KB + (size_t)row * 128 + cl) = pack8(y0, y1);
                                float* dst = nullptr;
                                if (row < NPT) { const int t = row % LP; if (t >= LP - 128) dst = out + O_WKP + ((size_t)((l * 8 + row / LP) * 128 + (t - (LP - 128)))) * 128; }
                                else if (row < M) { const int db = (row - NPT) >> 2, s = (row - NPT) & 3; dst = out + O_WKS + ((size_t)((l * 128 + db) * 128 + 124 + s)) * 128; }
                                if (dst) { dst += (cl & 64) + d0;
                                    dst[0] = y0[0]; dst[32] = y0[1]; dst[1] = y0[2]; dst[33] = y0[3]; dst[2] = y1[0]; dst[34] = y1[1]; dst[3] = y1[2]; dst[35] = y1[3]; }
                            }
                        }
                    }
                    asm volatile("" ::: "memory");
                }
        } else {
            const int kind = (pn - 3) >> 2;
            bf16* dstb = XR + (size_t)kind * ((size_t)MP * D);
            const int cbase = ((pn - 3) & 3) * 256 + cl;
#pragma unroll
            for (int ai = 0; ai < 2; ++ai)
#pragma unroll
                for (int m = 0; m < 4; ++m) {
                    const int row = u.pm * 256 + ai * 128 + wr * 64 + m * 16 + fr;
#pragma unroll
                    for (int bj = 0; bj < 2; ++bj) {
                        f32x4 v0 = acc[ai][bj][m][0] + 0.f, v1 = acc[ai][bj][m][1] + 0.f;
                        const int c = cbase + bj * 128;
                        if (kind == 0) {
                            float* dst = nullptr;
                            if (row < NPT) { const int t = row % LP; if (t >= LP - 3) dst = out + O_CVP + ((size_t)((l * 8 + row / LP) * 3 + (t - (LP - 3)))) * 1024 + c; }
                            else if (row < M) { const int db = (row - NPT) >> 2, s = (row - NPT) & 3; if (s >= 1) dst = out + O_CVS + ((size_t)((l * 128 + db) * 3 + (s - 1))) * 1024 + c; }
                            if (dst) { *(f32x4*)dst = v0; *(f32x4*)(dst + 4) = v1; }
                        } else if (kind == 1) {
#pragma unroll
                            for (int j = 0; j < 4; ++j) { v0[j] = gelu_tanh(v0[j]); v1[j] = gelu_tanh(v1[j]); }
                        } else {
#pragma unroll
                            for (int j = 0; j < 4; ++j) { v0[j] = sigmoidf_(v0[j]); v1[j] = sigmoidf_(v1[j]); }
                        }
                        *(u32x4*)(dstb + (size_t)row * 1024 + c) = pack8(v0, v1);
                    }
                    asm volatile("" ::: "memory");
                }
        }
    }
};
template <bool ADD> struct EpiGate {
    static constexpr bool PERM = true, AFTER_DRAIN = false;
    bf16* S; const bf16* A;
    __device__ __forceinline__ void operator()(const pg8::f32x4 (&acc)[2][2][4][2], const pg8::Unit& u, int wr, int wc, int fr, int fq) const {
#pragma unroll
        for (int ai = 0; ai < 2; ++ai)
#pragma unroll
            for (int m = 0; m < 4; ++m) {
                const int row = u.pm * 256 + ai * 128 + wr * 64 + m * 16 + fr;
#pragma unroll
                for (int bj = 0; bj < 2; ++bj) {
                    const size_t off = (size_t)row * 1024 + u.pn * 256 + bj * 128 + wc * 32 + 8 * fq;
                    const u32x4 s = *(const u32x4*)(S + off);
                    f32x4 v0 = acc[ai][bj][m][0], v1 = acc[ai][bj][m][1];
                    v0[0] *= bflo(s.x); v0[1] *= bfhi(s.x); v0[2] *= bflo(s.y); v0[3] *= bfhi(s.y); v1[0] *= bflo(s.z); v1[1] *= bfhi(s.z); v1[2] *= bflo(s.w); v1[3] *= bfhi(s.w);
                    if (ADD) { const u32x4 a = *(const u32x4*)(A + off);
                        v0[0] += bflo(a.x); v0[1] += bfhi(a.x); v0[2] += bflo(a.y); v0[3] += bfhi(a.y); v1[0] += bflo(a.z); v1[1] += bfhi(a.z); v1[2] += bflo(a.w); v1[3] += bfhi(a.w); }
                    *(u32x4*)(S + off) = pack8(v0, v1);
                }
                asm volatile("" ::: "memory");
            }
    }
};
struct EpiRes {
    static constexpr bool PERM = true, AFTER_DRAIN = false;
    float* X;
    __device__ __forceinline__ void operator()(const pg8::f32x4 (&acc)[2][2][4][2], const pg8::Unit& u, int wr, int wc, int fr, int fq) const {
#pragma unroll
        for (int ai = 0; ai < 2; ++ai)
#pragma unroll
            for (int m = 0; m < 4; ++m) {
                const int row = u.pm * 256 + ai * 128 + wr * 64 + m * 16 + fr;
#pragma unroll
                for (int bj = 0; bj < 2; ++bj) {
                    float* p = X + (size_t)row * 1024 + u.pn * 256 + bj * 128 + wc * 32 + 8 * fq;
                    const f32x4 x0 = *(const f32x4*)p, x1 = *(const f32x4*)(p + 4);
                    *(f32x4*)p = x0 * ALPHA + acc[ai][bj][m][0]; *(f32x4*)(p + 4) = x1 * ALPHA + acc[ai][bj][m][1];
                }
                asm volatile("" ::: "memory");
            }
    }
};
struct EpiSwiglu {
    static constexpr bool PERM = true, AFTER_DRAIN = false;
    bf16* H;
    __device__ __forceinline__ void operator()(const pg8::f32x4 (&acc)[2][2][4][2], const pg8::Unit& u, int wr, int wc, int fr, int fq) const {
#pragma unroll
        for (int ai = 0; ai < 2; ++ai)
#pragma unroll
            for (int m = 0; m < 4; ++m) {
                const int row = u.pm * 256 + ai * 128 + wr * 64 + m * 16 + fr;
                f32x4 h0, h1;
#pragma unroll
                for (int j = 0; j < 4; ++j) { const float a = acc[ai][0][m][0][j], b = acc[ai][0][m][1][j];
                    h0[j] = a * sigmoidf_(a) * acc[ai][1][m][0][j]; h1[j] = b * sigmoidf_(b) * acc[ai][1][m][1][j]; }
                *(u32x4*)(H + (size_t)row * DFF + u.pn * 128 + wc * 32 + 8 * fq) = pack8(h0, h1);
            }
    }
};

__device__ __forceinline__ int colmap(int mode, int n) {
    if (mode == 1) { if (n < 640) { const int p = n & 63; return (n & ~63) + (p >> 1) + ((p & 1) << 5); } return n; }
    if (mode == 2) { const int pn = n >> 8, bj = (n >> 7) & 1, j = n & 127; return bj * DFF + pn * 128 + j; }
    return n;
}
__device__ __forceinline__ void transpose_item(const float* W, int K, int N, bf16* WT, int mode, LAS float* scr, int item, int lane) {
    const int nblk = N / 32, kb = item / nblk, nb = item % nblk, k0 = 64 * kb, n0 = 32 * nb;
    const int nsrc = colmap(mode, n0 + (lane & 31));
#pragma unroll 8
    for (int i = 0; i < 32; ++i) { const int kk = 2 * i + (lane >> 5); scr[kk * 33 + (lane & 31)] = W[(size_t)(k0 + kk) * N + nsrc]; }
    LDS_WAIT();
    const int c = lane & 7;
#pragma unroll
    for (int j = 0; j < 4; ++j) { const int n = (lane >> 3) + 8 * j; const LAS float* s = scr + (8 * c) * 33 + n;
        u32x4 o; o.x = cvtpk(s[0 * 33], s[1 * 33]); o.y = cvtpk(s[2 * 33], s[3 * 33]); o.z = cvtpk(s[4 * 33], s[5 * 33]); o.w = cvtpk(s[6 * 33], s[7 * 33]);
        *(u32x4*)(WT + (size_t)(n0 + n) * K + k0 + 8 * c) = o; }
    LDS_WAIT();
}
__device__ __forceinline__ void prologue(const Params& P, LAS unsigned char* lds) {
    const int tid = opaque_tid(), lane = tid & 63, wave = tid >> 6;
    const int gw = blockIdx.x * 8 + wave, NGW = gridDim.x * 8;
    LAS float* scr = (LAS float*)(lds + wave * 8704);
    unsigned char* ws = P.ws;
    constexpr int IT_IN = 16 * (DIN / 32), IT_AP = 8 * 32, IT_LP = 16 * 32, IT_OUT = 16 * 32, IT_FI = 16 * (2 * DFF / 32), IT_FO = (DFF / 64) * 32, IT_LW = 16 * 8;
    constexpr int IT_LAYER = IT_IN + IT_AP + IT_LP + IT_OUT + IT_FI + IT_FO + IT_LW;
    for (int it = gw; it < DEPTH * IT_LAYER; it += NGW) {
        const int l = it / IT_LAYER; int r = it % IT_LAYER;
        if (r < IT_IN) { transpose_item(P.in[I_WIN] + (size_t)l * D * DIN, D, DIN, (bf16*)(ws + WS_WIN + l * SZ_WIN), 1, scr, r, lane); continue; } r -= IT_IN;
        if (r < IT_AP) { transpose_item(P.in[I_WAP] + (size_t)l * 512 * D, 512, D, (bf16*)(ws + WS_WAP + l * SZ_WAP), 0, scr, r, lane); continue; } r -= IT_AP;
        if (r < IT_LP) { transpose_item(P.in[I_WLP] + (size_t)l * D * D, D, D, (bf16*)(ws + WS_WLP + l * SZ_WLP), 0, scr, r, lane); continue; } r -= IT_LP;
        if (r < IT_OUT) { transpose_item(P.in[I_WOUT] + (size_t)l * D * D, D, D, (bf16*)(ws + WS_WOUT + l * SZ_WOUT), 0, scr, r, lane); continue; } r -= IT_OUT;
        if (r < IT_FI) { transpose_item(P.in[I_WFI] + (size_t)l * D * 2 * DFF, D, 2 * DFF, (bf16*)(ws + WS_WFI + l * SZ_WFI), 2, scr, r, lane); continue; } r -= IT_FI;
        if (r < IT_FO) { transpose_item(P.in[I_WFO] + (size_t)l * DFF * D, DFF, D, (bf16*)(ws + WS_WFO + l * SZ_WFO), 0, scr, r, lane); continue; } r -= IT_FO;
        { const int mat = r >> 3, sub = r & 7, nb = mat >> 1, which = mat & 1;
          transpose_item(P.in[which ? I_WX : I_WA] + (size_t)(l * 8 + nb) * 128 * 128, 128, 128, (bf16*)(ws + WS_LW + l * SZ_LW) + (size_t)(nb * 256 + which * 128) * 128, 0, scr, sub, lane); }
    }
    float* X = (float*)(ws + WS_X); bf16* XB = (bf16*)(ws + WS_XB);
    for (int m = gw; m < MP; m += NGW) {
        const float* src = nullptr;
        if (m < NPT) { const int b = m / LP, t = m % LP; src = t < 16 ? P.in[I_META] + (size_t)t * D : P.in[I_XP] + ((size_t)b * 2048 + (t - 16)) * D; }
        else if (m < M) src = P.in[I_XS] + (size_t)(m - NPT) * D;
#pragma unroll
        for (int j = 0; j < 4; ++j) {
            f32x4 v = {0.f, 0.f, 0.f, 0.f}; if (src) v = *(const f32x4*)(src + 256 * j + 4 * lane);
            *(f32x4*)(X + (size_t)m * D + 256 * j + 4 * lane) = v;
            u32x2 w; w.x = cvtpk(v[0], v[1]); w.y = cvtpk(v[2], v[3]); *(u32x2*)(XB + (size_t)m * D + 256 * j + 4 * lane) = w;
        }
    }
    float* rope = (float*)(ws + WS_ROPE);
    for (int e = blockIdx.x * 512 + tid; e < (LP + 4) * 32; e += gridDim.x * 512) {
        const int pi = e >> 5, d = e & 31; const double pos = pi < LP ? (double)pi : (double)(8192 + pi - LP);
        const double inv = pow(10000.0, -(double)d / 32.0), ang = pos * inv;
        rope[2 * e] = (float)cos(ang); rope[2 * e + 1] = (float)sin(ang);
    }
}

template <bool FINAL> __device__ __forceinline__ void ln_pass(const Params& P, const float* g, const float* b) {
    const int tid = opaque_tid(), lane = tid & 63, wave = tid >> 6, gw = blockIdx.x * 8 + wave, NGW = gridDim.x * 8;
    float* X = (float*)(P.ws + WS_X); bf16* XB = (bf16*)(P.ws + WS_XB);
    f32x4 gv[4], bv[4];
#pragma unroll
    for (int j = 0; j < 4; ++j) { gv[j] = *(const f32x4*)(g + 256 * j + 4 * lane); bv[j] = *(const f32x4*)(b + 256 * j + 4 * lane); }
    for (int m = gw; m < M; m += NGW) {
        f32x4 v[4]; float s = 0.f;
#pragma unroll
        for (int j = 0; j < 4; ++j) { v[j] = *(const f32x4*)(X + (size_t)m * D + 256 * j + 4 * lane); s += (v[j][0] + v[j][1]) + (v[j][2] + v[j][3]); }
#pragma unroll
        for (int o = 1; o < 64; o <<= 1) s += __shfl_xor(s, o);
        const float mean = s * (1.f / D); float q = 0.f;
#pragma unroll
        for (int j = 0; j < 4; ++j) { v[j] = v[j] - mean; q += (v[j][0] * v[j][0] + v[j][1] * v[j][1]) + (v[j][2] * v[j][2] + v[j][3] * v[j][3]); }
#pragma unroll
        for (int o = 1; o < 64; o <<= 1) q += __shfl_xor(q, o);
        const float rstd = 1.f / sqrtf(q * (1.f / D) + LN_EPS);
        float* yo = nullptr;
        if (FINAL) { if (m < NPT) { const int bb = m / LP, t = m % LP; if (t >= 16) yo = P.out + O_YP + ((size_t)bb * 2048 + (t - 16)) * D; } else yo = P.out + O_YS + (size_t)(m - NPT) * D; }
#pragma unroll
        for (int j = 0; j < 4; ++j) {
            const f32x4 y = v[j] * rstd * gv[j] + bv[j];
            if (FINAL) { if (yo) *(f32x4*)(yo + 256 * j + 4 * lane) = y; }
            else { *(f32x4*)(X + (size_t)m * D + 256 * j + 4 * lane) = y;
                   u32x2 w; w.x = cvtpk(y[0], y[1]); w.y = cvtpk(y[2], y[3]); *(u32x2*)(XB + (size_t)m * D + 256 * j + 4 * lane) = w; }
        }
    }
}

template <int MODE> __device__ __forceinline__ void lru_tile(const Params& P, LAS unsigned char* lds, int l, int tile, int nb) {
    const int tid = opaque_tid(), lane = tid & 63, wid = tid >> 6;
    LAS bf16* xcb = (LAS bf16*)lds;
    LAS float* xcf = (LAS float*)(lds + 17408);
    LAS float* sa = (LAS float*)(lds + 17408 + 32768);
    LAS float* sb = (LAS float*)(lds + 17408 + 65536);
    const bf16* XR = (const bf16*)(P.ws + WS_XR);
    const int t0 = tile * 64; const bool samp = t0 >= NPT;
    for (int e = tid; e < 64 * 16; e += 512) {
        const int r = e >> 4, c8 = e & 15, m = t0 + r, c0 = nb * 128 + c8 * 8;
        const int pos = samp ? ((m - NPT) & 3) : (m % LP);
        const float* buf = P.in[I_SC] + (size_t)((l * 128 + ((m - NPT) >> 2)) * 3) * 1024 + c0;
        f32x4 a0 = *(const f32x4*)(P.in[I_CB] + l * 1024 + c0), a1 = *(const f32x4*)(P.in[I_CB] + l * 1024 + c0 + 4);
#pragma unroll
        for (int i = 0; i < 4; ++i) {
            const f32x4 w0 = *(const f32x4*)(P.in[I_CW] + (size_t)(l * 4 + 3 - i) * 1024 + c0), w1 = *(const f32x4*)(P.in[I_CW] + (size_t)(l * 4 + 3 - i) * 1024 + c0 + 4);
            f32x4 x0 = {0.f, 0.f, 0.f, 0.f}, x1 = {0.f, 0.f, 0.f, 0.f};
            if (pos - i >= 0) { const u32x4 xw = *(const u32x4*)(XR + (size_t)(m - i) * 1024 + c0);
                x0[0] = bflo(xw.x); x0[1] = bfhi(xw.x); x0[2] = bflo(xw.y); x0[3] = bfhi(xw.y); x1[0] = bflo(xw.z); x1[1] = bfhi(xw.z); x1[2] = bflo(xw.w); x1[3] = bfhi(xw.w); }
            else if (samp) { x0 = *(const f32x4*)(buf + (size_t)(3 + pos - i) * 1024); x1 = *(const f32x4*)(buf + (size_t)(3 + pos - i) * 1024 + 4); }
            a0 += w0 * x0; a1 += w1 * x1;
        }
        *(LAS f32x4*)(xcf + r * 128 + c8 * 8) = a0; *(LAS f32x4*)(xcf + r * 128 + c8 * 8 + 4) = a1;
        *(LAS u32x4*)(xcb + r * 136 + c8 * 8) = pack8(a0, a1);
    }
    __syncthreads();
    {
        const int rb = wid & 1, cb = wid >> 1, l32 = lane & 31, h = lane >> 5;
        const bf16* LW = (const bf16*)(P.ws + WS_LW + l * SZ_LW) + (size_t)(nb * 256 + cb * 32 + l32) * 128 + h * 8;
        f32x16 ar, ai;
#pragma unroll
        for (int i = 0; i < 16; ++i) { ar[i] = 0.f; ai[i] = 0.f; }
#pragma unroll
        for (int kk = 0; kk < 8; ++kk) {
            const bf16x8 a = *(const LAS bf16x8*)(xcb + (rb * 32 + l32) * 136 + kk * 16 + h * 8);
            const bf16x8 br = *(const bf16x8*)(LW + kk * 16), bi = *(const bf16x8*)(LW + 128 * 128 + kk * 16);
            ar = MFMA32(a, br, ar); ai = MFMA32(a, bi, ai);
        }
        const int c = cb * 32 + l32, cg_ = nb * 128 + c;
        const float ba = P.in[I_BA][l * 1024 + cg_], bx = P.in[I_BX][l * 1024 + cg_];
        const float sp = log1pf(expf(-P.in[I_LAM][l * 1024 + cg_]));
#pragma unroll
        for (int i = 0; i < 16; ++i) {
            const int r = rb * 32 + crow(i, h);
            const float rr = sigmoidf_(ar[i] + ba), ii = sigmoidf_(ai[i] + bx);
            const float la = -8.f * rr * sp, a = expf(la), mult = sqrtf(-expm1f(2.f * la));
            sa[r * 128 + c] = a; sb[r * 128 + c] = mult * ii * xcf[r * 128 + c];
        }
    }
    __syncthreads();
    if (tid < 128) {
        const int c = tid, cg_ = nb * 128 + c;
        float* AGG = (float*)(P.ws + WS_AGG);
        float h = 0.f, pa = 1.f;
        if (MODE == 1 && !samp && (t0 % LP) != 0) {
            const int j0 = (((t0 - 1) / LP) * LP) / 64;
            for (int j = j0; j < tile; ++j) h = AGG[(size_t)j * 2048 + cg_] * h + AGG[(size_t)j * 2048 + 1024 + cg_];
        }
        bf16* GG = (bf16*)(P.ws + WS_GG);
        for (int r = 0; r < 64; ++r) {
            const int m = t0 + r; const int pos = samp ? ((m - NPT) & 3) : (m % LP);
            const float a = sa[r * 128 + c], b = sb[r * 128 + c];
            if (pos == 0) { const float h0 = samp ? P.in[I_SLRU][(size_t)(l * 128 + ((m - NPT) >> 2)) * 1024 + cg_] : 0.f; h = a * h0 + b; pa = 0.f; }
            else { h = a * h + b; pa *= a; }
            if (MODE == 1) {
                const float g = bf2f(GG[(size_t)m * 1024 + cg_]);
                GG[(size_t)m * 1024 + cg_] = f2bf(h * g);
                if (samp) { if (pos == 3) P.out[O_LRS + (size_t)(l * 128 + ((m - NPT) >> 2)) * 1024 + cg_] = h; }
                else if (pos == LP - 1) P.out[O_LRP + (size_t)(l * 8 + m / LP) * 1024 + cg_] = h;
            }
        }
        if (MODE == 0) { AGG[(size_t)tile * 2048 + cg_] = pa; AGG[(size_t)tile * 2048 + 1024 + cg_] = h; }
    }
    __syncthreads();
}

__device__ __forceinline__ void attn_prompt_wave(const Params& P, int l, int qt) {
    const int tid = opaque_tid(), lane = tid & 63, l32 = lane & 31, h = lane >> 5, head = tid >> 6, kvh = head >> 2;
    const bf16* Q = (const bf16*)((const unsigned char*)P.out + OB_Q); bf16* ATT = (bf16*)((unsigned char*)P.out + OB_ATT);
    const bf16* KB = (const bf16*)(P.ws + WS_KB); const bf16* VT = (const bf16*)(P.ws + WS_VT);
    const int q0 = qt * 32, key0 = q0 - 128;
    bf16x8 qf[4];
#pragma unroll
    for (int kk = 0; kk < 4; ++kk) qf[kk] = *(const bf16x8*)(Q + (size_t)(q0 + l32) * 512 + head * 64 + kk * 16 + h * 8);
    f32x16 st[5];
#pragma unroll
    for (int kb = 0; kb < 5; ++kb) {
#pragma unroll
        for (int i = 0; i < 16; ++i) st[kb][i] = 0.f;
        int krow_ = key0 + kb * 32 + l32; krow_ = krow_ < 0 ? 0 : krow_;
        const bf16* kp = KB + (size_t)krow_ * 128 + kvh * 64 + h * 8;
#pragma unroll
        for (int kk = 0; kk < 4; ++kk) { const bf16x8 kf = *(const bf16x8*)(kp + kk * 16); st[kb] = MFMA32(kf, qf[kk], st[kb]); }
    }
    const int qi = q0 + l32, bstart = (qi / LP) * LP;
    const float sink = P.in[I_SINK][l * 8 + head];
    float mx = sink;
#pragma unroll
    for (int kb = 0; kb < 5; ++kb)
#pragma unroll
        for (int i = 0; i < 16; ++i) { const int ki = key0 + kb * 32 + crow(i, h); const bool ok = ki <= qi && ki > qi - 128 && ki >= bstart;
            st[kb][i] = ok ? st[kb][i] : -1e30f; mx = fmaxf(mx, st[kb][i]); }
    mx = fmaxf(mx, __shfl_xor(mx, 32));
    float sum = 0.f;
#pragma unroll
    for (int kb = 0; kb < 5; ++kb)
#pragma unroll
        for (int i = 0; i < 16; ++i) { const float p = st[kb][i] > -1e29f ? __expf(st[kb][i] - mx) : 0.f; st[kb][i] = p; sum += p; }
    sum += __shfl_xor(sum, 32);
    const float inv = 1.f / (sum + __expf(sink - mx));
    f32x16 o0, o1;
#pragma unroll
    for (int i = 0; i < 16; ++i) { o0[i] = 0.f; o1[i] = 0.f; }
#pragma unroll
    for (int kb = 0; kb < 5; ++kb)
#pragma unroll
        for (int s = 0; s < 2; ++s) {
            u32x4 pw; pw.x = cvtpk(st[kb][8 * s], st[kb][8 * s + 1]); pw.y = cvtpk(st[kb][8 * s + 2], st[kb][8 * s + 3]); pw.z = cvtpk(st[kb][8 * s + 4], st[kb][8 * s + 5]); pw.w = cvtpk(st[kb][8 * s + 6], st[kb][8 * s + 7]);
            const bf16x8 pf = __builtin_bit_cast(bf16x8, pw);
            int k0 = key0 + kb * 32 + 16 * s + 4 * h, k1 = k0 + 8; k0 = k0 < 0 ? 0 : k0; k1 = k1 < 0 ? 0 : k1;
#pragma unroll
            for (int db = 0; db < 2; ++db) {
                const bf16* vp = VT + (size_t)(kvh * 64 + db * 32 + l32) * MP;
                const u32x2 va = *(const u32x2*)(vp + k0), vb = *(const u32x2*)(vp + k1);
                u32x4 vw; vw.x = va.x; vw.y = va.y; vw.z = vb.x; vw.w = vb.y;
                const bf16x8 vf = __builtin_bit_cast(bf16x8, vw);
                if (db == 0) o0 = MFMA32(vf, pf, o0); else o1 = MFMA32(vf, pf, o1);
            }
        }
    bf16* op = ATT + (size_t)qi * 512 + head * 64 + 4 * h;
#pragma unroll
    for (int g = 0; g < 4; ++g) {
        u32x2 w; w.x = cvtpk(o0[4 * g] * inv, o0[4 * g + 1] * inv); w.y = cvtpk(o0[4 * g + 2] * inv, o0[4 * g + 3] * inv); *(u32x2*)(op + 8 * g) = w;
        u32x2 w2; w2.x = cvtpk(o1[4 * g] * inv, o1[4 * g + 1] * inv); w2.y = cvtpk(o1[4 * g + 2] * inv, o1[4 * g + 3] * inv); *(u32x2*)(op + 32 + 8 * g) = w2;
    }
}

__device__ __forceinline__ void attn_sample_item(const Params& P, LAS unsigned char* lds, int l, int db, int kvh) {
    const int tid = opaque_tid(), lane = tid & 63, wid = tid >> 6;
    LAS float* Ks = (LAS float*)lds;
    LAS float* Vs = Ks + 132 * 65;
    LAS float* qs = Vs + 132 * 64;
    LAS float* S = qs + 16 * 64;
    const bf16* Q = (const bf16*)((const unsigned char*)P.out + OB_Q); bf16* ATT = (bf16*)((unsigned char*)P.out + OB_ATT);
    const size_t cbase = (size_t)(l * 128 + db) * 128;
    for (int e = tid; e < 132 * 64; e += 512) {
        const int key = e >> 6, d = e & 63;
        float kv, vv;
        if (key < 128) { kv = P.in[I_CK][((cbase + key) * 2 + kvh) * 64 + d]; vv = P.in[I_CV][((cbase + key) * 2 + kvh) * 64 + d]; }
        else { kv = P.out[O_WKS + ((cbase + key - 4) * 2 + kvh) * 64 + d]; vv = P.out[O_WVS + ((cbase + key - 4) * 2 + kvh) * 64 + d]; }
        Ks[key * 65 + d] = kv; Vs[key * 64 + d] = vv;
        if (key >= 4 && key < 128) { P.out[O_WKS + ((cbase + key - 4) * 2 + kvh) * 64 + d] = kv; P.out[O_WVS + ((cbase + key - 4) * 2 + kvh) * 64 + d] = vv; }
    }
    for (int e = tid; e < 16 * 64; e += 512) {
        const int row = e >> 6, d = e & 63, g = row >> 2, s = row & 3, p = d < 32 ? 2 * d : 2 * (d - 32) + 1;
        qs[e] = bf2f(Q[(size_t)(NPT + db * 4 + s) * 512 + (kvh * 4 + g) * 64 + p]);
    }
    __syncthreads();
    for (int e = tid; e < 16 * 132; e += 512) {
        const int row = e / 132, key = e % 132, s = row & 3;
        float acc = 0.f;
#pragma unroll 16
        for (int d = 0; d < 64; ++d) acc += qs[row * 64 + d] * Ks[key * 65 + d];
        const bool ok = key < 128 ? key > s : (key - 128) <= s;
        S[e] = ok ? acc : -1e30f;
    }
    __syncthreads();
    for (int rr = 0; rr < 2; ++rr) {
        const int row = wid * 2 + rr, g = row >> 2; const float sink = P.in[I_SINK][l * 8 + kvh * 4 + g];
        float v0 = S[row * 132 + lane], v1 = S[row * 132 + 64 + lane], v2 = lane < 4 ? S[row * 132 + 128 + lane] : -1e30f;
        float mx = fmaxf(fmaxf(v0, v1), fmaxf(v2, sink));
#pragma unroll
        for (int o = 1; o < 64; o <<= 1) mx = fmaxf(mx, __shfl_xor(mx, o));
        const float p0 = v0 > -1e29f ? __expf(v0 - mx) : 0.f, p1 = v1 > -1e29f ? __expf(v1 - mx) : 0.f, p2 = v2 > -1e29f ? __expf(v2 - mx) : 0.f;
        float sum = p0 + p1 + p2;
#pragma unroll
        for (int o = 1; o < 64; o <<= 1) sum += __shfl_xor(sum, o);
        const float inv = 1.f / (sum + __expf(sink - mx));
        S[row * 132 + lane] = p0 * inv; S[row * 132 + 64 + lane] = p1 * inv; if (lane < 4) S[row * 132 + 128 + lane] = p2 * inv;
    }
    __syncthreads();
    for (int e = tid; e < 16 * 64; e += 512) {
        const int row = e >> 6, d = e & 63, g = row >> 2, s = row & 3;
        float acc = 0.f;
#pragma unroll 4
        for (int key = 0; key < 132; ++key) acc += S[row * 132 + key] * Vs[key * 64 + d];
        ATT[(size_t)(NPT + db * 4 + s) * 512 + (kvh * 4 + g) * 64 + d] = f2bf(acc);
    }
    __syncthreads();
}

__global__ void __launch_bounds__(512, 2) fwd_mega(Params P) {
    extern __shared__ __attribute__((aligned(16))) unsigned char lds_raw[];
    LAS unsigned char* lds = (LAS unsigned char*)lds_raw;
    cg::grid_group grid = cg::this_grid();
    unsigned char* ws = P.ws;
    const int G = gridDim.x, bx = blockIdx.x;
    bf16* XB = (bf16*)(ws + WS_XB); float* X = (float*)(ws + WS_X);
    bf16* Qb = (bf16*)((unsigned char*)P.out + OB_Q); bf16* ATT = (bf16*)((unsigned char*)P.out + OB_ATT);
    bf16 *KB = (bf16*)(ws + WS_KB), *VT = (bf16*)(ws + WS_VT), *XR = (bf16*)(ws + WS_XR), *GG = (bf16*)(ws + WS_GG), *SA = (bf16*)(ws + WS_SA), *SL = (bf16*)(ws + WS_SL), *H = (bf16*)(ws + WS_H);

#ifndef NO_P0
    prologue(P, lds);
#endif
    grid.sync();
    for (int l = 0; l < DEPTH; ++l) {
        {
            pg8::Gemm g{XB, (const bf16*)(ws + WS_WIN + l * SZ_WIN), MP, DIN, D}; pg8::StaticOrder S; S.init(MP, DIN, G, bx);
            EpiProj E{l, Qb, KB, VT, XR, (const float*)(ws + WS_ROPE), P.out};
#ifndef NO_G1
            pg8::gemm_phase<EpiProj, pg8::StaticOrder, true, true>(lds, g, S, E);
#endif
        }
        grid.sync();
#ifndef NO_LRU0
        for (int it = bx; it < NTILE64 * 8; it += G) lru_tile<0>(P, lds, l, it >> 3, it & 7);
#endif
        grid.sync();
        for (int it = bx; it < 516 + 256 + NTILE64 * 8; it += G) {
#ifndef NO_ATTP
            if (it < 516) { attn_prompt_wave(P, l, it); } else
#endif
#ifndef NO_ATTS
            if (it < 772) { attn_sample_item(P, lds, l, (it - 516) >> 1, (it - 516) & 1); } else
#endif
#ifndef NO_LRU1
            { const int j = it - 772; lru_tile<1>(P, lds, l, j >> 3, j & 7); }
#else
            {}
#endif
        }
        grid.sync();
        {
            pg8::Gemm g{ATT, (const bf16*)(ws + WS_WAP + l * SZ_WAP), MP, D, 512}; pg8::StaticOrder S; S.init(MP, D, G, bx);
            EpiGate<false> E{SA, nullptr};
#ifndef NO_G3
            pg8::gemm_phase<EpiGate<false>, pg8::StaticOrder, true, true>(lds, g, S, E);
#endif
        }
        grid.sync();
        {
            pg8::Gemm g{GG, (const bf16*)(ws + WS_WLP + l * SZ_WLP), MP, D, D}; pg8::StaticOrder S; S.init(MP, D, G, bx);
            EpiGate<true> E{SL, SA};
#ifndef NO_G4
            pg8::gemm_phase<EpiGate<true>, pg8::StaticOrder, true, true>(lds, g, S, E);
#endif
        }
        grid.sync();
        {
            pg8::Gemm g{SL, (const bf16*)(ws + WS_WOUT + l * SZ_WOUT), MP, D, D}; pg8::StaticOrder S; S.init(MP, D, G, bx);
            EpiRes E{X};
#ifndef NO_G5
            pg8::gemm_phase<EpiRes, pg8::StaticOrder, true, true>(lds, g, S, E);
#endif
        }
        grid.sync();
#ifndef NO_LN
        ln_pass<false>(P, P.in[I_L1G] + l * D, P.in[I_L1B] + l * D);
#endif
        grid.sync();
        {
            pg8::Gemm g{XB, (const bf16*)(ws + WS_WFI + l * SZ_WFI), MP, 2 * DFF, D}; pg8::StaticOrder S; S.init(MP, 2 * DFF, G, bx);
            EpiSwiglu E{H};
#ifndef NO_G6
            pg8::gemm_phase<EpiSwiglu, pg8::StaticOrder, true, true>(lds, g, S, E);
#endif
        }
        grid.sync();
        {
            pg8::Gemm g{H, (const bf16*)(ws + WS_WFO + l * SZ_WFO), MP, D, DFF}; pg8::StaticOrder S; S.init(MP, D, G, bx);
            EpiRes E{X};
#ifndef NO_G5
            pg8::gemm_phase<EpiRes, pg8::StaticOrder, true, true>(lds, g, S, E);
#endif
        }
        grid.sync();
        if (l < DEPTH - 1) { ln_pass<false>(P, P.in[I_L2G] + l * D, P.in[I_L2B] + l * D); grid.sync(); }
        else ln_pass<true>(P, P.in[I_L2G] + l * D, P.in[I_L2B] + l * D);
    }
}

extern "C" void kernel_launch(void* const* d_in, const int* in_sizes, int n_in, void* d_out, int out_size, void* d_ws, size_t ws_size, hipStream_t stream) {
    static int grid = 0;
    if (grid == 0) {
        if (n_in != 25 || (size_t)out_size != O_END || ws_size < WS_END) { fprintf(stderr, "kernel_launch: unexpected shapes (n_in %d out %d ws %zu need %zu)\n", n_in, out_size, ws_size, (size_t)WS_END); grid = -1; return; }
        int dev = 0, cus = 0, per = 0;
        if (hipGetDevice(&dev) != hipSuccess || hipDeviceGetAttribute(&cus, hipDeviceAttributeMultiprocessorCount, dev) != hipSuccess) { grid = -1; return; }
        if (hipFuncSetAttribute((const void*)fwd_mega, hipFuncAttributeMaxDynamicSharedMemorySize, LDS_BYTES) != hipSuccess) { fprintf(stderr, "hipFuncSetAttribute failed\n"); grid = -1; return; }
        if (hipOccupancyMaxActiveBlocksPerMultiprocessor(&per, (const void*)fwd_mega, 512, LDS_BYTES) != hipSuccess || per < 1) { fprintf(stderr, "occupancy query: %d\n", per); per = 1; }
        (void)hipGetLastError();
        grid = cus;
    }
    if (grid < 0) return;
    Params p{};
    for (int i = 0; i < 25; ++i) p.in[i] = (const float*)d_in[i];
    p.out = (float*)d_out; p.ws = (unsigned char*)d_ws;
    void* args[] = {&p};
    hipError_t e = hipLaunchCooperativeKernel((const void*)fwd_mega, dim3(grid), dim3(512), args, LDS_BYTES, stream);
    if (e != hipSuccess) fprintf(stderr, "cooperative launch failed: %s (grid %d)\n", hipGetErrorString(e), grid);
}
```

```cpp
#include <hip/hip_runtime.h>
#include <hip/hip_cooperative_groups.h>
#include <cstdio>
#include <cstdint>
namespace cg = cooperative_groups;
namespace pg8 {
#define PG8_LAS __attribute__((address_space(3)))
typedef unsigned short bf16_t;
typedef short bf16x8 __attribute__((ext_vector_type(8)));
typedef float f32x4 __attribute__((ext_vector_type(4)));
typedef unsigned u32x4 __attribute__((ext_vector_type(4)));
constexpr int BM = 256, BK = 64, HALF = 128, HTB = HALF * BK * 2  , STAGE_BYTES = 8 * HTB, NXCD = 8, WGM = 8;

__host__ __device__ __forceinline__ int lds_byte(int r, int c) { const int st = (r >> 4) * 2 + (c >> 5), rr = r & 15, cc = c & 31, ob = rr * 64 + cc * 2; return st * 1024 + (ob ^ (((ob >> 9) & 1) << 5)); }
__host__ __device__ __forceinline__ void stage_rc(int b, int& R, int& C) { const int st = b / 1024, sb = b % 1024, swz = sb ^ (((sb >> 9) & 1) << 5); R = (st >> 1) * 16 + swz / 64; C = (st & 1) * 32 + (swz % 64) / 2; }
__host__ __device__ __forceinline__ int perm32(int rho) { const int n = rho >> 4, i = rho & 15; return 8 * (i >> 2) + 4 * n + (i & 3); }

struct Unit { int pm, pn; };
struct Gemm { const bf16_t* A; const bf16_t* Bt; int M, N, K; };

struct StaticOrder {
    int nM, nN, nwg, G, c;
    __host__ __device__ void init(int M, int N, int G_, int c_) { nM = M / BM; nN = N / BM; nwg = nM * nN; G = G_; c = c_; }
    __host__ __device__ bool next(int i, Unit& u) const {
        const long L = (long)i * G + c; if (L >= nwg) return false;
        int wgid = (int)L; { const int q = nwg / NXCD, r = nwg % NXCD, xcd = wgid % NXCD, off = wgid / NXCD; wgid = (xcd < r ? xcd * (q + 1) : r * (q + 1) + (xcd - r) * q) + off; }
        const int nig = WGM * nN, gid = wgid / nig, fm = gid * WGM, gsz = (nM - fm) < WGM ? (nM - fm) : WGM;
        u.pm = fm + ((wgid % nig) % gsz); u.pn = (wgid % nig) / gsz; return true;
    }
    __device__ __forceinline__ void a_ready(const Unit&) const {}
    __device__ __forceinline__ void done(const Unit&) const {}
};

template <class Epi, class Sched, bool ALIGN_EPI = false, bool SP2 = false>
__device__ __forceinline__ void gemm_phase(PG8_LAS unsigned char* lds, const Gemm g, const Sched& S, const Epi& E) {
    int tid_ = threadIdx.x; asm volatile("" : "+v"(tid_));
    const int tid = tid_, wid = __builtin_amdgcn_readfirstlane(tid >> 6), lane = tid & 63, wr = wid >> 2, wc = wid & 3, fr = lane & 15, fq = lane >> 4;
    const int K = g.K, nt = K / BK;
    unsigned voffA[2], voffB[2];
#pragma unroll
    for (int i = 0; i < 2; ++i) { int R, C; stage_rc(tid * 16 + i * 8192, R, C); const int Rb = Epi::PERM ? ((R & ~31) + perm32(R & 31)) : R;
        voffA[i] = (unsigned)(R * K + C) * 2u; voffB[i] = (unsigned)(Rb * K + C) * 2u; }
    const size_t kstep = (size_t)(BK * 2);
    const size_t hstep = (size_t)HALF * K * 2;
    const size_t tstep = 2 * hstep;
    const unsigned ldsw = (unsigned)wid * 1024u;
    const int aoff = lds_byte(wr * 64 + fr, fq * 8), boff = lds_byte(wc * 32 + fr, fq * 8);
#define PG8_SA(b, h) (((b) * 2 + (h)) * HTB)
#define PG8_SB(b, h) ((4 + (b) * 2 + (h)) * HTB)
#define PG8_STAGE(bufoff, gbase, voff) do { _Pragma("unroll") for (int _i = 0; _i < 2; ++_i) \
        __builtin_amdgcn_global_load_lds((const unsigned*)((const char*)(gbase) + (voff)[_i]), (PG8_LAS unsigned*)(lds + (bufoff) + ldsw + _i * 8192), 16, 0, 0); } while (0)
#define PG8_LDA(dst, b, h) do { _Pragma("unroll") for (int m = 0; m < 4; ++m) _Pragma("unroll") for (int k = 0; k < 2; ++k) dst[m][k] = *(const PG8_LAS bf16x8*)(lds + PG8_SA(b, h) + aoff + m * 2048 + k * 1024); } while (0)
#define PG8_LDB(dst, b, h) do { _Pragma("unroll") for (int n = 0; n < 2; ++n) _Pragma("unroll") for (int k = 0; k < 2; ++k) dst[n][k] = *(const PG8_LAS bf16x8*)(lds + PG8_SB(b, h) + boff + n * 2048 + k * 1024); } while (0)
#define PG8_MMA(ai, bj, At, Bt) do { __builtin_amdgcn_s_setprio(1); _Pragma("unroll") for (int m = 0; m < 4; ++m) _Pragma("unroll") for (int n = 0; n < 2; ++n) _Pragma("unroll") for (int k = 0; k < 2; ++k) \
        acc[ai][bj][m][n] = __builtin_amdgcn_mfma_f32_16x16x32_bf16(Bt[n][k], At[m][k], acc[ai][bj][m][n], 0, 0, 0); __builtin_amdgcn_s_setprio(0); } while (0)
#define PG8_WAIT_V(n) asm volatile("s_waitcnt vmcnt(" #n ")" ::: "memory")
#define PG8_WAIT_L(n) asm volatile("s_waitcnt lgkmcnt(" #n ")" ::: "memory")
#define PG8_BAR __builtin_amdgcn_s_barrier()
#define PG8_SCHED __builtin_amdgcn_sched_barrier(0)
    Unit cur, nxt; int ui = 0;
    if (!S.next(0, cur)) return;
    f32x4 acc[2][2][4][2];
#pragma unroll
    for (int a = 0; a < 2; ++a)
#pragma unroll
        for (int b = 0; b < 2; ++b)
#pragma unroll
            for (int m = 0; m < 4; ++m)
#pragma unroll
                for (int n = 0; n < 2; ++n) acc[a][b][m][n] = (f32x4){0.f, 0.f, 0.f, 0.f};
    bf16x8 At[4][2], B0[2][2], B1[2][2];
    const char* cA = (const char*)g.A + (size_t)cur.pm * tstep; const char* cB = (const char*)g.Bt + (size_t)cur.pn * tstep;
    S.a_ready(cur);
    if constexpr (SP2) {
        PG8_STAGE(PG8_SB(0, 0), cB, voffB); PG8_STAGE(PG8_SB(0, 1), cB + hstep, voffB); PG8_STAGE(PG8_SA(0, 0), cA, voffA); PG8_STAGE(PG8_SA(0, 1), cA + hstep, voffA);
        if (wr == 1) PG8_BAR;
        PG8_WAIT_V(2); PG8_BAR;
        PG8_STAGE(PG8_SB(1, 0), cB + kstep, voffB); PG8_STAGE(PG8_SA(1, 0), cA + kstep, voffA); PG8_STAGE(PG8_SB(1, 1), cB + hstep + kstep, voffB);
        PG8_WAIT_V(6); PG8_BAR;
    } else {
        PG8_STAGE(PG8_SB(0, 0), cB, voffB); PG8_STAGE(PG8_SA(0, 0), cA, voffA); PG8_STAGE(PG8_SB(0, 1), cB + hstep, voffB); PG8_STAGE(PG8_SA(0, 1), cA + hstep, voffA);
        if (wr == 1) PG8_BAR;
        PG8_WAIT_V(4); PG8_BAR;
        PG8_STAGE(PG8_SB(1, 0), cB + kstep, voffB); PG8_STAGE(PG8_SA(1, 0), cA + kstep, voffA); PG8_STAGE(PG8_SB(1, 1), cB + hstep + kstep, voffB);
        PG8_WAIT_V(6); PG8_BAR;
    }
    for (;;) {
        const bool has_next = S.next(ui + 1, nxt);
        const char* nA = has_next ? (const char*)g.A + (size_t)nxt.pm * tstep : cA; const char* nB = has_next ? (const char*)g.Bt + (size_t)nxt.pn * tstep : cB;
        for (int t = 0; t < nt; t += 2) {
            const bool last = (t == nt - 2);
            const char* a1 = cA + (size_t)(t + 1) * kstep;
            const char* a2 = last ? nA : cA + (size_t)(t + 2) * kstep; const char* b2 = last ? nB : cB + (size_t)(t + 2) * kstep;
            const char* a3 = a2 + kstep; const char* b3 = b2 + kstep;
            if (last && has_next) S.a_ready(nxt);
            if constexpr (SP2) {
            PG8_LDB(B0, 0, 0); PG8_LDB(B1, 0, 1); PG8_SCHED; PG8_LDA(At, 0, 0); PG8_STAGE(PG8_SA(1, 1), a1 + hstep, voffA);
            PG8_WAIT_V(8); PG8_WAIT_L(0); PG8_BAR; PG8_MMA(0, 0, At, B0); PG8_MMA(0, 1, At, B1); PG8_BAR; PG8_SCHED;
            PG8_LDA(At, 0, 1); PG8_STAGE(PG8_SB(0, 0), b2, voffB); PG8_STAGE(PG8_SB(0, 1), b2 + hstep, voffB); PG8_STAGE(PG8_SA(0, 0), a2, voffA);
            PG8_WAIT_V(8); PG8_WAIT_L(0); PG8_BAR; PG8_MMA(1, 0, At, B0); PG8_MMA(1, 1, At, B1); PG8_BAR; PG8_SCHED;
            PG8_LDB(B0, 1, 0); PG8_LDB(B1, 1, 1); PG8_SCHED; PG8_LDA(At, 1, 0); PG8_STAGE(PG8_SA(0, 1), a2 + hstep, voffA);
            PG8_WAIT_V(8); PG8_WAIT_L(0); PG8_BAR; PG8_MMA(0, 0, At, B0); PG8_MMA(0, 1, At, B1); PG8_BAR; PG8_SCHED;
            PG8_LDA(At, 1, 1); PG8_STAGE(PG8_SB(1, 0), b3, voffB); PG8_STAGE(PG8_SB(1, 1), b3 + hstep, voffB); PG8_STAGE(PG8_SA(1, 0), a3, voffA);
            PG8_WAIT_V(8); PG8_WAIT_L(0); PG8_BAR; PG8_MMA(1, 0, At, B0); PG8_MMA(1, 1, At, B1); PG8_BAR; PG8_SCHED;
            } else {
            PG8_LDB(B0, 0, 0); PG8_SCHED; PG8_LDA(At, 0, 0); PG8_STAGE(PG8_SA(1, 1), a1 + hstep, voffA);
            PG8_WAIT_L(8); PG8_BAR; PG8_WAIT_L(0); PG8_MMA(0, 0, At, B0); PG8_BAR; PG8_SCHED;
            PG8_LDB(B1, 0, 1); PG8_STAGE(PG8_SB(0, 0), b2, voffB);
            PG8_BAR; PG8_WAIT_L(0); PG8_MMA(0, 1, At, B1); PG8_BAR;
            PG8_LDA(At, 0, 1); PG8_STAGE(PG8_SA(0, 0), a2, voffA);
            PG8_BAR; PG8_WAIT_L(0); PG8_MMA(1, 0, At, B0); PG8_BAR; PG8_SCHED;
            PG8_STAGE(PG8_SB(0, 1), b2 + hstep, voffB);
            PG8_WAIT_V(6); PG8_BAR; PG8_MMA(1, 1, At, B1); PG8_BAR;
            PG8_LDB(B0, 1, 0); PG8_SCHED; PG8_LDA(At, 1, 0); PG8_STAGE(PG8_SA(0, 1), a2 + hstep, voffA);
            PG8_WAIT_L(8); PG8_BAR; PG8_WAIT_L(0); PG8_MMA(0, 0, At, B0); PG8_BAR; PG8_SCHED;
            PG8_LDB(B1, 1, 1); PG8_STAGE(PG8_SB(1, 0), b3, voffB);
            PG8_BAR; PG8_WAIT_L(0); PG8_MMA(0, 1, At, B1); PG8_BAR;
            PG8_LDA(At, 1, 1); PG8_STAGE(PG8_SA(1, 0), a3, voffA);
            PG8_BAR; PG8_WAIT_L(0); PG8_MMA(1, 0, At, B0); PG8_BAR; PG8_SCHED;
            PG8_STAGE(PG8_SB(1, 1), b3 + hstep, voffB);
            PG8_WAIT_V(6); PG8_BAR; PG8_MMA(1, 1, At, B1); PG8_BAR;
            }
        }
        if constexpr (ALIGN_EPI) { if (wr == 0) PG8_BAR; }
        if constexpr (!Epi::AFTER_DRAIN) { E(acc, cur, wr, wc, fr, fq); S.done(cur); }
        if (!has_next) break;
#pragma unroll
        for (int a = 0; a < 2; ++a)
#pragma unroll
            for (int b = 0; b < 2; ++b)
#pragma unroll
                for (int m = 0; m < 4; ++m)
#pragma unroll
                    for (int n = 0; n < 2; ++n) acc[a][b][m][n] = (f32x4){0.f, 0.f, 0.f, 0.f};
        cur = nxt; cA = nA; cB = nB; ++ui;
        if constexpr (ALIGN_EPI) { if (wr == 1) PG8_BAR; }
    }
    PG8_WAIT_V(0);
    if constexpr (!ALIGN_EPI) { if (wr == 0) PG8_BAR; }
    PG8_BAR;
    if constexpr (Epi::AFTER_DRAIN) { E.fused(acc, cur, wr, wc, fr, fq, lds, wid, lane); S.done(cur); }
#undef PG8_SA
#undef PG8_SB
#undef PG8_STAGE
#undef PG8_LDA
#undef PG8_LDB
#undef PG8_MMA
#undef PG8_WAIT_V
#undef PG8_WAIT_L
#undef PG8_BAR
#undef PG8_SCHED
}
}
#define LAS __attribute__((address_space(3)))
typedef unsigned short bf16;
typedef float f32x4 __attribute__((ext_vector_type(4)));
typedef float f32x16 __attribute__((ext_vector_type(16)));
typedef short bf16x8 __attribute__((ext_vector_type(8)));
typedef short s16x4 __attribute__((ext_vector_type(4)));
typedef unsigned u32x4 __attribute__((ext_vector_type(4)));
typedef unsigned u32x2 __attribute__((ext_vector_type(2)));
typedef float f32x2_t __attribute__((ext_vector_type(2)));
typedef __bf16 bf16x2_t __attribute__((ext_vector_type(2)));

constexpr int D = 1024, LP = 2064, NPT = 8 * LP  , M = NPT + 512  , MP = 17152, DIN = 4864, DFF = 2816, DEPTH = 4;
constexpr int NTILE64 = M / 64;
constexpr float ALPHA = 1.6817928305074292f;
constexpr float LN_EPS = 1e-5f;
constexpr size_t O_YP = 0, O_YS = 16777216, O_WKP = 17301504, O_WVP = 17825792, O_CVP = 18350080, O_LRP = 18448384,
                 O_WKS = 18481152, O_WVS = 26869760, O_CVS = 35258368, O_LRS = 36831232, O_END = 37355520;
constexpr size_t OB_Q = 0, OB_ATT = (size_t)MP * 512 * 2;
constexpr size_t SZ_WIN = (size_t)DIN * D * 2, SZ_WAP = (size_t)D * 512 * 2, SZ_WLP = (size_t)D * D * 2, SZ_WOUT = SZ_WLP, SZ_WFI = (size_t)2 * DFF * D * 2, SZ_WFO = (size_t)D * DFF * 2, SZ_LW = (size_t)8 * 256 * 128 * 2;
constexpr size_t WS_WIN = 0, WS_WAP = WS_WIN + 4 * SZ_WIN, WS_WLP = WS_WAP + 4 * SZ_WAP, WS_WOUT = WS_WLP + 4 * SZ_WLP, WS_WFI = WS_WOUT + 4 * SZ_WOUT, WS_WFO = WS_WFI + 4 * SZ_WFI,
                 WS_LW = WS_WFO + 4 * SZ_WFO, WS_ROPE = WS_LW + 4 * SZ_LW, WS_AGG = WS_ROPE + 1048576, WS_X = WS_AGG + 3145728, WS_XB = WS_X + (size_t)MP * D * 4,
                 WS_R = WS_XB + (size_t)MP * D * 2;
constexpr size_t WS_KB = WS_R, WS_VT = WS_KB + (size_t)MP * 128 * 2, WS_XR = WS_VT + (size_t)MP * 128 * 2, WS_GG = WS_XR + (size_t)MP * D * 2, WS_SA = WS_GG + (size_t)MP * D * 2, WS_SL = WS_SA + (size_t)MP * D * 2,
                 WS_END = WS_SL + (size_t)MP * D * 2;
constexpr size_t WS_H = WS_R;
static_assert(WS_H + (size_t)MP * DFF * 2 <= WS_END, "H overlay");
static_assert(WS_GG == WS_XR + (size_t)MP * D * 2 && WS_SA == WS_GG + (size_t)MP * D * 2 && WS_SL == WS_SA + (size_t)MP * D * 2, "XR|GG|SA|SL consecutive");
constexpr int LDS_BYTES = 147456;

struct Params { const float* in[25]; float* out; unsigned char* ws; };
enum { I_XP = 0, I_XS, I_CK, I_CV, I_SC, I_SLRU, I_META, I_WIN, I_WAP, I_WLP, I_WOUT, I_SINK, I_CW, I_CB, I_WA, I_BA, I_WX, I_BX, I_LAM, I_L1G, I_L1B, I_WFI, I_WFO, I_L2G, I_L2B };

__device__ __forceinline__ unsigned cvtpk(float lo, float hi) { f32x2_t v = {lo, hi}; bf16x2_t b = __builtin_convertvector(v, bf16x2_t); return __builtin_bit_cast(unsigned, b); }
__device__ __forceinline__ bf16 f2bf(float f) { return (bf16)(cvtpk(f, 0.f) & 0xffffu); }
__device__ __forceinline__ float bf2f(unsigned b) { return __uint_as_float(b << 16); }
__device__ __forceinline__ float bflo(unsigned w) { return __uint_as_float(w << 16); }
__device__ __forceinline__ float bfhi(unsigned w) { return __uint_as_float(w & 0xffff0000u); }
__device__ __forceinline__ float sigmoidf_(float x) { return __builtin_amdgcn_rcpf(1.f + __expf(-x)); }
__device__ __forceinline__ float gelu_tanh(float x) { return x * sigmoidf_(1.5957691216057308f * (x + 0.044715f * x * x * x)); }
__device__ __forceinline__ u32x4 pack8(f32x4 a, f32x4 b) { u32x4 w; w.x = cvtpk(a[0], a[1]); w.y = cvtpk(a[2], a[3]); w.z = cvtpk(b[0], b[1]); w.w = cvtpk(b[2], b[3]); return w; }
__device__ __forceinline__ int opaque_tid() { int t = threadIdx.x; asm volatile("" : "+v"(t)); return t; }
__device__ __forceinline__ int crow(int reg, int h) { return (reg & 3) + 8 * (reg >> 2) + 4 * h; }
#define MFMA32(a, b, c) __builtin_amdgcn_mfma_f32_32x32x16_bf16((a), (b), (c), 0, 0, 0)
#define LDS_WAIT() asm volatile("s_waitcnt lgkmcnt(0)" ::: "memory")

struct EpiProj {
    static constexpr bool PERM = true, AFTER_DRAIN = false;
    int l; bf16 *Q, *KB, *VT, *XR; const float* rope; float* out;
    __device__ __forceinline__ static int pos_idx(int row) { return row < NPT ? row % LP : (row < M ? LP + ((row - NPT) & 3) : 0); }
    __device__ __forceinline__ void operator()(const pg8::f32x4 (&acc)[2][2][4][2], const pg8::Unit& u, int wr, int wc, int fr, int fq) const {
        const int pn = u.pn, cl = wc * 32 + 8 * fq;
        if (pn < 3) {
#pragma unroll
            for (int ai = 0; ai < 2; ++ai)
#pragma unroll
                for (int m = 0; m < 4; ++m) {
                    const int row = u.pm * 256 + ai * 128 + wr * 64 + m * 16 + fr;
                    const int pi = pos_idx(row);
                    const int d0 = (cl & 63) >> 1;
                    const f32x4 cs0 = *(const f32x4*)(rope + (size_t)pi * 64 + d0 * 2), cs1 = *(const f32x4*)(rope + (size_t)pi * 64 + d0 * 2 + 4);
#pragma unroll
                    for (int bj = 0; bj < 2; ++bj) {
                        const f32x4 v0 = acc[ai][bj][m][0], v1 = acc[ai][bj][m][1];
                        if (pn == 2 && bj == 1) {
                            const int vc = cl;
                            const f32x4 t0 = v0 + 0.f, t1 = v1 + 0.f;
                            const u32x4 w = pack8(t0, t1);
                            bf16* vt = VT + (size_t)vc * MP + row;
                            vt[0] = (bf16)(w.x & 0xffff); vt[(size_t)MP] = (bf16)(w.x >> 16); vt[(size_t)2 * MP] = (bf16)(w.y & 0xffff); vt[(size_t)3 * MP] = (bf16)(w.y >> 16);
                            vt[(size_t)4 * MP] = (bf16)(w.z & 0xffff); vt[(size_t)5 * MP] = (bf16)(w.z >> 16); vt[(size_t)6 * MP] = (bf16)(w.w & 0xffff); vt[(size_t)7 * MP] = (bf16)(w.w >> 16);
                            float* dst = nullptr;
                            if (row < NPT) { const int t = row % LP; if (t >= LP - 128) dst = out + O_WVP + ((size_t)((l * 8 + row / LP) * 128 + (t - (LP - 128)))) * 128 + vc; }
                            else if (row < M) { const int db = (row - NPT) >> 2, s = (row - NPT) & 3; dst = out + O_WVS + ((size_t)((l * 128 + db) * 128 + 124 + s)) * 128 + vc; }
                            if (dst) { *(f32x4*)dst = t0; *(f32x4*)(dst + 4) = t1; }
                        } else {
                            f32x4 y0, y1;
                            y0[0] = v0[0] * cs0[0] - v0[1] * cs0[1]; y0[1] = v0[1] * cs0[0] + v0[0] * cs0[1];
                            y0[2] = v0[2] * cs0[2] - v0[3] * cs0[3]; y0[3] = v0[3] * cs0[2] + v0[2] * cs0[3];
                            y1[0] = v1[0] * cs1[0] - v1[1] * cs1[1]; y1[1] = v1[1] * cs1[0] + v1[0] * cs1[1];
                            y1[2] = v1[2] * cs1[2] - v1[3] * cs1[3]; y1[3] = v1[3] * cs1[2] + v1[2] * cs1[3];
                            if (pn < 2) {
                                const int col = pn * 256 + bj * 128 + cl;
                                *(u32x4*)(Q + (size_t)row * 512 + col) = pack8(y0 * 0.125f, y1 * 0.125f);
                            } else {
                                *(u32x4*)(KB + (size_t)row * 128 + cl) = pack8(y0, y1);
                                float* dst = nullptr;
                                if (row < NPT) { const int t = row % LP; if (t >= LP - 128) dst = out + O_WKP + ((size_t)((l * 8 + row / LP) * 128 + (t - (LP - 128)))) * 128; }
                                else if (row < M) { const int db = (row - NPT) >> 2, s = (row - NPT) & 3; dst = out + O_WKS + ((size_t)((l * 128 + db) * 128 + 124 + s)) * 128; }
                                if (dst) { dst += (cl & 64) + d0;
                                    dst[0] = y0[0]; dst[32] = y0[1]; dst[1] = y0[2]; dst[33] = y0[3]; dst[2] = y1[0]; dst[34] = y1[1]; dst[3] = y1[2]; dst[35] = y1[3]; }
                            }
                        }
                    }
                    asm volatile("" ::: "memory");
                }
        } else {
            const int kind = (pn - 3) >> 2;
            bf16* dstb = XR + (size_t)kind * ((size_t)MP * D);
            const int cbase = ((pn - 3) & 3) * 256 + cl;
#pragma unroll
            for (int ai = 0; ai < 2; ++ai)
#pragma unroll
                for (int m = 0; m < 4; ++m) {
                    const int row = u.pm * 256 + ai * 128 + wr * 64 + m * 16 + fr;
#pragma unroll
                    for (int bj = 0; bj < 2; ++bj) {
                        f32x4 v0 = acc[ai][bj][m][0] + 0.f, v1 = acc[ai][bj][m][1] + 0.f;
                        const int c = cbase + bj * 128;
                        if (kind == 0) {
                            float* dst = nullptr;
                            if (row < NPT) { const int t = row % LP; if (t >= LP - 3) dst = out + O_CVP + ((size_t)((l * 8 + row / LP) * 3 + (t - (LP - 3)))) * 1024 + c; }
                            else if (row < M) { const int db = (row - NPT) >> 2, s = (row - NPT) & 3; if (s >= 1) dst = out + O_CVS + ((size_t)((l * 128 + db) * 3 + (s - 1))) * 1024 + c; }
                            if (dst) { *(f32x4*)dst = v0; *(f32x4*)(dst + 4) = v1; }
                        } else if (kind == 1) {
#pragma unroll
                            for (int j = 0; j < 4; ++j) { v0[j] = gelu_tanh(v0[j]); v1[j] = gelu_tanh(v1[j]); }
                        } else {
#pragma unroll
                            for (int j = 0; j < 4; ++j) { v0[j] = sigmoidf_(v0[j]); v1[j] = sigmoidf_(v1[j]); }
                        }
                        *(u32x4*)(dstb + (size_t)row * 1024 + c) = pack8(v0, v1);
                    }
                    asm volatile("" ::: "memory");
                }
        }
    }
};
template <bool ADD> struct EpiGate {
    static constexpr bool PERM = true, AFTER_DRAIN = false;
    bf16* S; const bf16* A;
    __device__ __forceinline__ void operator()(const pg8::f32x4 (&acc)[2][2][4][2], const pg8::Unit& u, int wr, int wc, int fr, int fq) const {
#pragma unroll
        for (int ai = 0; ai < 2; ++ai)
#pragma unroll
            for (int m = 0; m < 4; ++m) {
                const int row = u.pm * 256 + ai * 128 + wr * 64 + m * 16 + fr;
#pragma unroll
                for (int bj = 0; bj < 2; ++bj) {
                    const size_t off = (size_t)row * 1024 + u.pn * 256 + bj * 128 + wc * 32 + 8 * fq;
                    const u32x4 s = *(const u32x4*)(S + off);
                    f32x4 v0 = acc[ai][bj][m][0], v1 = acc[ai][bj][m][1];
                    v0[0] *= bflo(s.x); v0[1] *= bfhi(s.x); v0[2] *= bflo(s.y); v0[3] *= bfhi(s.y); v1[0] *= bflo(s.z); v1[1] *= bfhi(s.z); v1[2] *= bflo(s.w); v1[3] *= bfhi(s.w);
                    if (ADD) { const u32x4 a = *(const u32x4*)(A + off);
                        v0[0] += bflo(a.x); v0[1] += bfhi(a.x); v0[2] += bflo(a.y); v0[3] += bfhi(a.y); v1[0] += bflo(a.z); v1[1] += bfhi(a.z); v1[2] += bflo(a.w); v1[3] += bfhi(a.w); }
                    *(u32x4*)(S + off) = pack8(v0, v1);
                }
                asm volatile("" ::: "memory");
            }
    }
};
struct EpiRes {
    static constexpr bool PERM = true, AFTER_DRAIN = false;
    float* X;
    __device__ __forceinline__ void operator()(const pg8::f32x4 (&acc)[2][2][4][2], const pg8::Unit& u, int wr, int wc, int fr, int fq) const {
#pragma unroll
        for (int ai = 0; ai < 2; ++ai)
#pragma unroll
            for (int m = 0; m < 4; ++m) {
                const int row = u.pm * 256 + ai * 128 + wr * 64 + m * 16 + fr;
#pragma unroll
                for (int bj = 0; bj < 2; ++bj) {
                    float* p = X + (size_t)row * 1024 + u.pn * 256 + bj * 128 + wc * 32 + 8 * fq;
                    const f32x4 x0 = *(const f32x4*)p, x1 = *(const f32x4*)(p + 4);
                    *(f32x4*)p = x0 * ALPHA + acc[ai][bj][m][0]; *(f32x4*)(p + 4) = x1 * ALPHA + acc[ai][bj][m][1];
                }
                asm volatile("" ::: "memory");
            }
    }
};
struct EpiSwiglu {
    static constexpr bool PERM = true, AFTER_DRAIN = false;
    bf16* H;
    __device__ __forceinline__ void operator()(const pg8::f32x4 (&acc)[2][2][4][2], const pg8::Unit& u, int wr, int wc, int fr, int fq) const {
#pragma unroll
        for (int ai = 0; ai < 2; ++ai)
#pragma unroll
            for (int m = 0; m < 4; ++m) {
                const int row = u.pm * 256 + ai * 128 + wr * 64 + m * 16 + fr;
                f32x4 h0, h1;
#pragma unroll
                for (int j = 0; j < 4; ++j) { const float a = acc[ai][0][m][0][j], b = acc[ai][0][m][1][j];
                    h0[j] = a * sigmoidf_(a) * acc[ai][1][m][0][j]; h1[j] = b * sigmoidf_(b) * acc[ai][1][m][1][j]; }
                *(u32x4*)(H + (size_t)row * DFF + u.pn * 128 + wc * 32 + 8 * fq) = pack8(h0, h1);
            }
    }
};

__device__ __forceinline__ int colmap(int mode, int n) {
    if (mode == 1) { if (n < 640) { const int p = n & 63; return (n & ~63) + (p >> 1) + ((p & 1) << 5); } return n; }
    if (mode == 2) { const int pn = n >> 8, bj = (n >> 7) & 1, j = n & 127; return bj * DFF + pn * 128 + j; }
    return n;
}
__device__ __forceinline__ void transpose_item(const float* W, int K, int N, bf16* WT, int mode, LAS float* scr, int item, int lane) {
    const int nblk = N / 32, kb = item / nblk, nb = item % nblk, k0 = 64 * kb, n0 = 32 * nb;
    const int nsrc = colmap(mode, n0 + (lane & 31));
#pragma unroll 8
    for (int i = 0; i < 32; ++i) { const int kk = 2 * i + (lane >> 5); scr[kk * 33 + (lane & 31)] = W[(size_t)(k0 + kk) * N + nsrc]; }
    LDS_WAIT();
    const int c = lane & 7;
#pragma unroll
    for (int j = 0; j < 4; ++j) { const int n = (lane >> 3) + 8 * j; const LAS float* s = scr + (8 * c) * 33 + n;
        u32x4 o; o.x = cvtpk(s[0 * 33], s[1 * 33]); o.y = cvtpk(s[2 * 33], s[3 * 33]); o.z = cvtpk(s[4 * 33], s[5 * 33]); o.w = cvtpk(s[6 * 33], s[7 * 33]);
        *(u32x4*)(WT + (size_t)(n0 + n) * K + k0 + 8 * c) = o; }
    LDS_WAIT();
}
__device__ __forceinline__ void prologue(const Params& P, LAS unsigned char* lds) {
    const int tid = opaque_tid(), lane = tid & 63, wave = tid >> 6;
    const int gw = blockIdx.x * 8 + wave, NGW = gridDim.x * 8;
    LAS float* scr = (LAS float*)(lds + wave * 8704);
    unsigned char* ws = P.ws;
    constexpr int IT_IN = 16 * (DIN / 32), IT_AP = 8 * 32, IT_LP = 16 * 32, IT_OUT = 16 * 32, IT_FI = 16 * (2 * DFF / 32), IT_FO = (DFF / 64) * 32, IT_LW = 16 * 8;
    constexpr int IT_LAYER = IT_IN + IT_AP + IT_LP + IT_OUT + IT_FI + IT_FO + IT_LW;
    for (int it = gw; it < DEPTH * IT_LAYER; it += NGW) {
        const int l = it / IT_LAYER; int r = it % IT_LAYER;
        if (r < IT_IN) { transpose_item(P.in[I_WIN] + (size_t)l * D * DIN, D, DIN, (bf16*)(ws + WS_WIN + l * SZ_WIN), 1, scr, r, lane); continue; } r -= IT_IN;
        if (r < IT_AP) { transpose_item(P.in[I_WAP] + (size_t)l * 512 * D, 512, D, (bf16*)(ws + WS_WAP + l * SZ_WAP), 0, scr, r, lane); continue; } r -= IT_AP;
        if (r < IT_LP) { transpose_item(P.in[I_WLP] + (size_t)l * D * D, D, D, (bf16*)(ws + WS_WLP + l * SZ_WLP), 0, scr, r, lane); continue; } r -= IT_LP;
        if (r < IT_OUT) { transpose_item(P.in[I_WOUT] + (size_t)l * D * D, D, D, (bf16*)(ws + WS_WOUT + l * SZ_WOUT), 0, scr, r, lane); continue; } r -= IT_OUT;
        if (r < IT_FI) { transpose_item(P.in[I_WFI] + (size_t)l * D * 2 * DFF, D, 2 * DFF, (bf16*)(ws + WS_WFI + l * SZ_WFI), 2, scr, r, lane); continue; } r -= IT_FI;
        if (r < IT_FO) { transpose_item(P.in[I_WFO] + (size_t)l * DFF * D, DFF, D, (bf16*)(ws + WS_WFO + l * SZ_WFO), 0, scr, r, lane); continue; } r -= IT_FO;
        { const int mat = r >> 3, sub = r & 7, nb = mat >> 1, which = mat & 1;
          transpose_item(P.in[which ? I_WX : I_WA] + (size_t)(l * 8 + nb) * 128 * 128, 128, 128, (bf16*)(ws + WS_LW + l * SZ_LW) + (size_t)(nb * 256 + which * 128) * 128, 0, scr, sub, lane); }
    }
    float* X = (float*)(ws + WS_X); bf16* XB = (bf16*)(ws + WS_XB);
    for (int m = gw; m < MP; m += NGW) {
        const float* src = nullptr;
        if (m < NPT) { const int b = m / LP, t = m % LP; src = t < 16 ? P.in[I_META] + (size_t)t * D : P.in[I_XP] + ((size_t)b * 2048 + (t - 16)) * D; }
        else if (m < M) src = P.in[I_XS] + (size_t)(m - NPT) * D;
#pragma unroll
        for (int j = 0; j < 4; ++j) {
            f32x4 v = {0.f, 0.f, 0.f, 0.f}; if (src) v = *(const f32x4*)(src + 256 * j + 4 * lane);
            *(f32x4*)(X + (size_t)m * D + 256 * j + 4 * lane) = v;
            u32x2 w; w.x = cvtpk(v[0], v[1]); w.y = cvtpk(v[2], v[3]); *(u32x2*)(XB + (size_t)m * D + 256 * j + 4 * lane) = w;
        }
    }
    float* rope = (float*)(ws + WS_ROPE);
    for (int e = blockIdx.x * 512 + tid; e < (LP + 4) * 32; e += gridDim.x * 512) {
        const int pi = e >> 5, d = e & 31; const double pos = pi < LP ? (double)pi : (double)(8192 + pi - LP);
        const double inv = pow(10000.0, -(double)d / 32.0), ang = pos * inv;
        rope[2 * e] = (float)cos(ang); rope[2 * e + 1] = (float)sin(ang);
    }
}

template <bool FINAL> __device__ __forceinline__ void ln_pass(const Params& P, const float* g, const float* b) {
    const int tid = opaque_tid(), lane = tid & 63, wave = tid >> 6, gw = blockIdx.x * 8 + wave, NGW = gridDim.x * 8;
    float* X = (float*)(P.ws + WS_X); bf16* XB = (bf16*)(P.ws + WS_XB);
    f32x4 gv[4], bv[4];
#pragma unroll
    for (int j = 0; j < 4; ++j) { gv[j] = *(const f32x4*)(g + 256 * j + 4 * lane); bv[j] = *(const f32x4*)(b + 256 * j + 4 * lane); }
    for (int m = gw; m < M; m += NGW) {
        f32x4 v[4]; float s = 0.f;
#pragma unroll
        for (int j = 0; j < 4; ++j) { v[j] = *(const f32x4*)(X + (size_t)m * D + 256 * j + 4 * lane); s += (v[j][0] + v[j][1]) + (v[j][2] + v[j][3]); }
#pragma unroll
        for (int o = 1; o < 64; o <<= 1) s += __shfl_xor(s, o);
        const float mean = s * (1.f / D); float q = 0.f;
#pragma unroll
        for (int j = 0; j < 4; ++j) { v[j] = v[j] - mean; q += (v[j][0] * v[j][0] + v[j][1] * v[j][1]) + (v[j][2] * v[j][2] + v[j][3] * v[j][3]); }
#pragma unroll
        for (int o = 1; o < 64; o <<= 1) q += __shfl_xor(q, o);
        const float rstd = 1.f / sqrtf(q * (1.f / D) + LN_EPS);
        float* yo = nullptr;
        if (FINAL) { if (m < NPT) { const int bb = m / LP, t = m % LP; if (t >= 16) yo = P.out + O_YP + ((size_t)bb * 2048 + (t - 16)) * D; } else yo = P.out + O_YS + (size_t)(m - NPT) * D; }
#pragma unroll
        for (int j = 0; j < 4; ++j) {
            const f32x4 y = v[j] * rstd * gv[j] + bv[j];
            if (FINAL) { if (yo) *(f32x4*)(yo + 256 * j + 4 * lane) = y; }
            else { *(f32x4*)(X + (size_t)m * D + 256 * j + 4 * lane) = y;
                   u32x2 w; w.x = cvtpk(y[0], y[1]); w.y = cvtpk(y[2], y[3]); *(u32x2*)(XB + (size_t)m * D + 256 * j + 4 * lane) = w; }
        }
    }
}

template <int MODE> __device__ __forceinline__ void lru_tile(const Params& P, LAS unsigned char* lds, int l, int tile, int nb) {
    const int tid = opaque_tid(), lane = tid & 63, wid = tid >> 6;
    LAS bf16* xcb = (LAS bf16*)lds;
    LAS float* xcf = (LAS float*)(lds + 17408);
    LAS float* sa = (LAS float*)(lds + 17408 + 32768);
    LAS float* sb = (LAS float*)(lds + 17408 + 65536);
    const bf16* XR = (const bf16*)(P.ws + WS_XR);
    const int t0 = tile * 64; const bool samp = t0 >= NPT;
    for (int e = tid; e < 64 * 16; e += 512) {
        const int r = e >> 4, c8 = e & 15, m = t0 + r, c0 = nb * 128 + c8 * 8;
        const int pos = samp ? ((m - NPT) & 3) : (m % LP);
        const float* buf = P.in[I_SC] + (size_t)((l * 128 + ((m - NPT) >> 2)) * 3) * 1024 + c0;
        f32x4 a0 = *(const f32x4*)(P.in[I_CB] + l * 1024 + c0), a1 = *(const f32x4*)(P.in[I_CB] + l * 1024 + c0 + 4);
#pragma unroll
        for (int i = 0; i < 4; ++i) {
            const f32x4 w0 = *(const f32x4*)(P.in[I_CW] + (size_t)(l * 4 + 3 - i) * 1024 + c0), w1 = *(const f32x4*)(P.in[I_CW] + (size_t)(l * 4 + 3 - i) * 1024 + c0 + 4);
            f32x4 x0 = {0.f, 0.f, 0.f, 0.f}, x1 = {0.f, 0.f, 0.f, 0.f};
            if (pos - i >= 0) { const u32x4 xw = *(const u32x4*)(XR + (size_t)(m - i) * 1024 + c0);
                x0[0] = bflo(xw.x); x0[1] = bfhi(xw.x); x0[2] = bflo(xw.y); x0[3] = bfhi(xw.y); x1[0] = bflo(xw.z); x1[1] = bfhi(xw.z); x1[2] = bflo(xw.w); x1[3] = bfhi(xw.w); }
            else if (samp) { x0 = *(const f32x4*)(buf + (size_t)(3 + pos - i) * 1024); x1 = *(const f32x4*)(buf + (size_t)(3 + pos - i) * 1024 + 4); }
            a0 += w0 * x0; a1 += w1 * x1;
        }
        *(LAS f32x4*)(xcf + r * 128 + c8 * 8) = a0; *(LAS f32x4*)(xcf + r * 128 + c8 * 8 + 4) = a1;
        *(LAS u32x4*)(xcb + r * 136 + c8 * 8) = pack8(a0, a1);
    }
    __syncthreads();
    {
        const int rb = wid & 1, cb = wid >> 1, l32 = lane & 31, h = lane >> 5;
        const bf16* LW = (const bf16*)(P.ws + WS_LW + l * SZ_LW) + (size_t)(nb * 256 + cb * 32 + l32) * 128 + h * 8;
        f32x16 ar, ai;
#pragma unroll
        for (int i = 0; i < 16; ++i) { ar[i] = 0.f; ai[i] = 0.f; }
#pragma unroll
        for (int kk = 0; kk < 8; ++kk) {
            const bf16x8 a = *(const LAS bf16x8*)(xcb + (rb * 32 + l32) * 136 + kk * 16 + h * 8);
            const bf16x8 br = *(const bf16x8*)(LW + kk * 16), bi = *(const bf16x8*)(LW + 128 * 128 + kk * 16);
            ar = MFMA32(a, br, ar); ai = MFMA32(a, bi, ai);
        }
        const int c = cb * 32 + l32, cg_ = nb * 128 + c;
        const float ba = P.in[I_BA][l * 1024 + cg_], bx = P.in[I_BX][l * 1024 + cg_];
        const float sp = log1pf(expf(-P.in[I_LAM][l * 1024 + cg_]));
#pragma unroll
        for (int i = 0; i < 16; ++i) {
            const int r = rb * 32 + crow(i, h);
            const float rr = sigmoidf_(ar[i] + ba), ii = sigmoidf_(ai[i] + bx);
            const float la = -8.f * rr * sp, a = expf(la), mult = sqrtf(-expm1f(2.f * la));
            sa[r * 128 + c] = a; sb[r * 128 + c] = mult * ii * xcf[r * 128 + c];
        }
    }
    __syncthreads();
    {
        const int c = tid & 127, q = tid >> 7, cg_ = nb * 128 + c;
        LAS float* qa = (LAS float*)lds;
        LAS float* qb = qa + 512;
        LAS float* tc = qb + 512;
        float* AGG = (float*)(P.ws + WS_AGG);
        const int pos0 = samp ? 0 : ((t0 + 16 * q) % LP);
        float av[16], bv[16];
#pragma unroll
        for (int i = 0; i < 16; ++i) { av[i] = sa[(16 * q + i) * 128 + c]; bv[i] = sb[(16 * q + i) * 128 + c]; }
        float h0v[4] = {0.f, 0.f, 0.f, 0.f};
        if (samp) {
#pragma unroll
            for (int j = 0; j < 4; ++j) h0v[j] = P.in[I_SLRU][(size_t)(l * 128 + ((t0 + 16 * q - NPT) >> 2) + j) * 1024 + cg_];
        }
        const int rs = samp ? -1 : (pos0 == 0 ? 0 : (LP - pos0 < 16 ? LP - pos0 : -1));
        if (MODE == 1 && q == 0) {
            float h = 0.f;
            if (!samp && (t0 % LP) != 0) {
                const int j0 = (((t0 - 1) / LP) * LP) / 64;
                for (int j = j0; j < tile; ++j) h = AGG[(size_t)j * 2048 + cg_] * h + AGG[(size_t)j * 2048 + 1024 + cg_];
            }
            tc[c] = h;
        }
        {
            float A = 1.f, B = 0.f;
#pragma unroll
            for (int i = 0; i < 16; ++i) {
                const bool reset = samp ? ((i & 3) == 0) : (i == rs);
                if (reset) { A = 0.f; B = av[i] * (samp ? h0v[i >> 2] : 0.f) + bv[i]; } else { A *= av[i]; B = av[i] * B + bv[i]; }
            }
            qa[q * 128 + c] = A; qb[q * 128 + c] = B;
        }
        __syncthreads();
        if (MODE == 0) {
            if (q == 3) {
                float A = 1.f, B = 0.f;
#pragma unroll
                for (int j = 0; j < 4; ++j) { const float Aj = qa[j * 128 + c], Bj = qb[j * 128 + c]; B = Aj * B + Bj; A *= Aj; }
                AGG[(size_t)tile * 2048 + cg_] = A; AGG[(size_t)tile * 2048 + 1024 + cg_] = B;
            }
        } else {
            float h = tc[c];
            for (int j = 0; j < q; ++j) h = qa[j * 128 + c] * h + qb[j * 128 + c];
#pragma unroll
            for (int i = 0; i < 16; ++i) {
                const bool reset = samp ? ((i & 3) == 0) : (i == rs);
                h = reset ? av[i] * (samp ? h0v[i >> 2] : 0.f) + bv[i] : av[i] * h + bv[i];
                sb[(16 * q + i) * 128 + c] = h;
            }
            __syncthreads();
            bf16* GG = (bf16*)(P.ws + WS_GG);
            for (int e = tid; e < 64 * 16; e += 512) {
                const int r = e >> 4, c8 = e & 15, m = t0 + r;
                bf16* gp = GG + (size_t)m * 1024 + nb * 128 + c8 * 8;
                const u32x4 gw = *(const u32x4*)gp;
                const f32x4 h0 = *(const LAS f32x4*)(sb + r * 128 + c8 * 8), h1 = *(const LAS f32x4*)(sb + r * 128 + c8 * 8 + 4);
                f32x4 r0, r1;
                r0[0] = h0[0] * bflo(gw.x); r0[1] = h0[1] * bfhi(gw.x); r0[2] = h0[2] * bflo(gw.y); r0[3] = h0[3] * bfhi(gw.y);
                r1[0] = h1[0] * bflo(gw.z); r1[1] = h1[1] * bfhi(gw.z); r1[2] = h1[2] * bflo(gw.w); r1[3] = h1[3] * bfhi(gw.w);
                *(u32x4*)gp = pack8(r0, r1);
                float* so = nullptr;
                if (samp) { if ((r & 3) == 3) so = P.out + O_LRS + (size_t)(l * 128 + ((m - NPT) >> 2)) * 1024; }
                else if (m % LP == LP - 1) so = P.out + O_LRP + (size_t)(l * 8 + m / LP) * 1024;
                if (so) { *(f32x4*)(so + nb * 128 + c8 * 8) = h0; *(f32x4*)(so + nb * 128 + c8 * 8 + 4) = h1; }
            }
        }
    }
    __syncthreads();
}

__device__ __forceinline__ void attn_prompt_wave(const Params& P, int l, int qt) {
    const int tid = opaque_tid(), lane = tid & 63, l32 = lane & 31, h = lane >> 5, head = tid >> 6, kvh = head >> 2;
    const bf16* Q = (const bf16*)((const unsigned char*)P.out + OB_Q); bf16* ATT = (bf16*)((unsigned char*)P.out + OB_ATT);
    const bf16* KB = (const bf16*)(P.ws + WS_KB); const bf16* VT = (const bf16*)(P.ws + WS_VT);
    const int q0 = qt * 32, key0 = q0 - 128;
    bf16x8 qf[4];
#pragma unroll
    for (int kk = 0; kk < 4; ++kk) qf[kk] = *(const bf16x8*)(Q + (size_t)(q0 + l32) * 512 + head * 64 + kk * 16 + h * 8);
    f32x16 st[5];
#pragma unroll
    for (int kb = 0; kb < 5; ++kb) {
#pragma unroll
        for (int i = 0; i < 16; ++i) st[kb][i] = 0.f;
        int krow_ = key0 + kb * 32 + l32; krow_ = krow_ < 0 ? 0 : krow_;
        const bf16* kp = KB + (size_t)krow_ * 128 + kvh * 64 + h * 8;
#pragma unroll
        for (int kk = 0; kk < 4; ++kk) { const bf16x8 kf = *(const bf16x8*)(kp + kk * 16); st[kb] = MFMA32(kf, qf[kk], st[kb]); }
    }
    const int qi = q0 + l32, bstart = (qi / LP) * LP;
    const float sink = P.in[I_SINK][l * 8 + head];
    float mx = sink;
#pragma unroll
    for (int kb = 0; kb < 5; ++kb)
#pragma unroll
        for (int i = 0; i < 16; ++i) { const int ki = key0 + kb * 32 + crow(i, h); const bool ok = ki <= qi && ki > qi - 128 && ki >= bstart;
            st[kb][i] = ok ? st[kb][i] : -1e30f; mx = fmaxf(mx, st[kb][i]); }
    mx = fmaxf(mx, __shfl_xor(mx, 32));
    float sum = 0.f;
#pragma unroll
    for (int kb = 0; kb < 5; ++kb)
#pragma unroll
        for (int i = 0; i < 16; ++i) { const float p = st[kb][i] > -1e29f ? __expf(st[kb][i] - mx) : 0.f; st[kb][i] = p; sum += p; }
    sum += __shfl_xor(sum, 32);
    const float inv = 1.f / (sum + __expf(sink - mx));
    f32x16 o0, o1;
#pragma unroll
    for (int i = 0; i < 16; ++i) { o0[i] = 0.f; o1[i] = 0.f; }
#pragma unroll
    for (int kb = 0; kb < 5; ++kb)
#pragma unroll
        for (int s = 0; s < 2; ++s) {
            u32x4 pw; pw.x = cvtpk(st[kb][8 * s], st[kb][8 * s + 1]); pw.y = cvtpk(st[kb][8 * s + 2], st[kb][8 * s + 3]); pw.z = cvtpk(st[kb][8 * s + 4], st[kb][8 * s + 5]); pw.w = cvtpk(st[kb][8 * s + 6], st[kb][8 * s + 7]);
            const bf16x8 pf = __builtin_bit_cast(bf16x8, pw);
            int k0 = key0 + kb * 32 + 16 * s + 4 * h, k1 = k0 + 8; k0 = k0 < 0 ? 0 : k0; k1 = k1 < 0 ? 0 : k1;
#pragma unroll
            for (int db = 0; db < 2; ++db) {
                const bf16* vp = VT + (size_t)(kvh * 64 + db * 32 + l32) * MP;
                const u32x2 va = *(const u32x2*)(vp + k0), vb = *(const u32x2*)(vp + k1);
                u32x4 vw; vw.x = va.x; vw.y = va.y; vw.z = vb.x; vw.w = vb.y;
                const bf16x8 vf = __builtin_bit_cast(bf16x8, vw);
                if (db == 0) o0 = MFMA32(vf, pf, o0); else o1 = MFMA32(vf, pf, o1);
            }
        }
    bf16* op = ATT + (size_t)qi * 512 + head * 64 + 4 * h;
#pragma unroll
    for (int g = 0; g < 4; ++g) {
        u32x2 w; w.x = cvtpk(o0[4 * g] * inv, o0[4 * g + 1] * inv); w.y = cvtpk(o0[4 * g + 2] * inv, o0[4 * g + 3] * inv); *(u32x2*)(op + 8 * g) = w;
        u32x2 w2; w2.x = cvtpk(o1[4 * g] * inv, o1[4 * g + 1] * inv); w2.y = cvtpk(o1[4 * g + 2] * inv, o1[4 * g + 3] * inv); *(u32x2*)(op + 32 + 8 * g) = w2;
    }
}

__device__ __forceinline__ void attn_sample_item(const Params& P, LAS unsigned char* lds, int l, int db, int kvh) {
    const int tid = opaque_tid(), lane = tid & 63, wid = tid >> 6;
    LAS float* Ks = (LAS float*)lds;
    LAS float* Vs = Ks + 132 * 65;
    LAS float* qs = Vs + 132 * 64;
    LAS float* S = qs + 16 * 64;
    const bf16* Q = (const bf16*)((const unsigned char*)P.out + OB_Q); bf16* ATT = (bf16*)((unsigned char*)P.out + OB_ATT);
    const size_t cbase = (size_t)(l * 128 + db) * 128;
    for (int e = tid; e < 132 * 64; e += 512) {
        const int key = e >> 6, d = e & 63;
        float kv, vv;
        if (key < 128) { kv = P.in[I_CK][((cbase + key) * 2 + kvh) * 64 + d]; vv = P.in[I_CV][((cbase + key) * 2 + kvh) * 64 + d]; }
        else { kv = P.out[O_WKS + ((cbase + key - 4) * 2 + kvh) * 64 + d]; vv = P.out[O_WVS + ((cbase + key - 4) * 2 + kvh) * 64 + d]; }
        Ks[key * 65 + d] = kv; Vs[key * 64 + d] = vv;
        if (key >= 4 && key < 128) { P.out[O_WKS + ((cbase + key - 4) * 2 + kvh) * 64 + d] = kv; P.out[O_WVS + ((cbase + key - 4) * 2 + kvh) * 64 + d] = vv; }
    }
    for (int e = tid; e < 16 * 64; e += 512) {
        const int row = e >> 6, d = e & 63, g = row >> 2, s = row & 3, p = d < 32 ? 2 * d : 2 * (d - 32) + 1;
        qs[e] = bf2f(Q[(size_t)(NPT + db * 4 + s) * 512 + (kvh * 4 + g) * 64 + p]);
    }
    __syncthreads();
    for (int e = tid; e < 16 * 132; e += 512) {
        const int row = e / 132, key = e % 132, s = row & 3;
        float acc = 0.f;
#pragma unroll 16
        for (int d = 0; d < 64; ++d) acc += qs[row * 64 + d] * Ks[key * 65 + d];
        const bool ok = key < 128 ? key > s : (key - 128) <= s;
        S[e] = ok ? acc : -1e30f;
    }
    __syncthreads();
    for (int rr = 0; rr < 2; ++rr) {
        const int row = wid * 2 + rr, g = row >> 2; const float sink = P.in[I_SINK][l * 8 + kvh * 4 + g];
        float v0 = S[row * 132 + lane], v1 = S[row * 132 + 64 + lane], v2 = lane < 4 ? S[row * 132 + 128 + lane] : -1e30f;
        float mx = fmaxf(fmaxf(v0, v1), fmaxf(v2, sink));
#pragma unroll
        for (int o = 1; o < 64; o <<= 1) mx = fmaxf(mx, __shfl_xor(mx, o));
        const float p0 = v0 > -1e29f ? __expf(v0 - mx) : 0.f, p1 = v1 > -1e29f ? __expf(v1 - mx) : 0.f, p2 = v2 > -1e29f ? __expf(v2 - mx) : 0.f;
        float sum = p0 + p1 + p2;
#pragma unroll
        for (int o = 1; o < 64; o <<= 1) sum += __shfl_xor(sum, o);
        const float inv = 1.f / (sum + __expf(sink - mx));
        S[row * 132 + lane] = p0 * inv; S[row * 132 + 64 + lane] = p1 * inv; if (lane < 4) S[row * 132 + 128 + lane] = p2 * inv;
    }
    __syncthreads();
    for (int e = tid; e < 16 * 64; e += 512) {
        const int row = e >> 6, d = e & 63, g = row >> 2, s = row & 3;
        float acc = 0.f;
#pragma unroll 4
        for (int key = 0; key < 132; ++key) acc += S[row * 132 + key] * Vs[key * 64 + d];
        ATT[(size_t)(NPT + db * 4 + s) * 512 + (kvh * 4 + g) * 64 + d] = f2bf(acc);
    }
    __syncthreads();
}

__global__ void __launch_bounds__(512, 2) fwd_mega(Params P) {
    extern __shared__ __attribute__((aligned(16))) unsigned char lds_raw[];
    LAS unsigned char* lds = (LAS unsigned char*)lds_raw;
    cg::grid_group grid = cg::this_grid();
    unsigned char* ws = P.ws;
    const int G = gridDim.x, bx = blockIdx.x;
    bf16* XB = (bf16*)(ws + WS_XB); float* X = (float*)(ws + WS_X);
    bf16* Qb = (bf16*)((unsigned char*)P.out + OB_Q); bf16* ATT = (bf16*)((unsigned char*)P.out + OB_ATT);
    bf16 *KB = (bf16*)(ws + WS_KB), *VT = (bf16*)(ws + WS_VT), *XR = (bf16*)(ws + WS_XR), *GG = (bf16*)(ws + WS_GG), *SA = (bf16*)(ws + WS_SA), *SL = (bf16*)(ws + WS_SL), *H = (bf16*)(ws + WS_H);

#ifndef NO_P0
    prologue(P, lds);
#endif
    grid.sync();
    for (int l = 0; l < DEPTH; ++l) {
        {
            pg8::Gemm g{XB, (const bf16*)(ws + WS_WIN + l * SZ_WIN), MP, DIN, D}; pg8::StaticOrder S; S.init(MP, DIN, G, bx);
            EpiProj E{l, Qb, KB, VT, XR, (const float*)(ws + WS_ROPE), P.out};
#ifndef NO_G1
            pg8::gemm_phase<EpiProj, pg8::StaticOrder, true, true>(lds, g, S, E);
#endif
        }
        grid.sync();
#ifndef NO_LRU0
        for (int it = bx; it < NTILE64 * 8; it += G) lru_tile<0>(P, lds, l, it >> 3, it & 7);
#endif
        grid.sync();
        for (int it = bx; it < 516 + 256 + NTILE64 * 8; it += G) {
#ifndef NO_ATTP
            if (it < 516) { attn_prompt_wave(P, l, it); } else
#endif
#ifndef NO_ATTS
            if (it < 772) { attn_sample_item(P, lds, l, (it - 516) >> 1, (it - 516) & 1); } else
#endif
#ifndef NO_LRU1
            { const int j = it - 772; lru_tile<1>(P, lds, l, j >> 3, j & 7); }
#else
            {}
#endif
        }
        grid.sync();
        {
            pg8::Gemm g{ATT, (const bf16*)(ws + WS_WAP + l * SZ_WAP), MP, D, 512}; pg8::StaticOrder S; S.init(MP, D, G, bx);
            EpiGate<false> E{SA, nullptr};
#ifndef NO_G3
            pg8::gemm_phase<EpiGate<false>, pg8::StaticOrder, true, true>(lds, g, S, E);
#endif
        }
        grid.sync();
        {
            pg8::Gemm g{GG, (const bf16*)(ws + WS_WLP + l * SZ_WLP), MP, D, D}; pg8::StaticOrder S; S.init(MP, D, G, bx);
            EpiGate<true> E{SL, SA};
#ifndef NO_G4
            pg8::gemm_phase<EpiGate<true>, pg8::StaticOrder, true, true>(lds, g, S, E);
#endif
        }
        grid.sync();
        {
            pg8::Gemm g{SL, (const bf16*)(ws + WS_WOUT + l * SZ_WOUT), MP, D, D}; pg8::StaticOrder S; S.init(MP, D, G, bx);
            EpiRes E{X};
#ifndef NO_G5
            pg8::gemm_phase<EpiRes, pg8::StaticOrder, true, true>(lds, g, S, E);
#endif
        }
        grid.sync();
#ifndef NO_LN
        ln_pass<false>(P, P.in[I_L1G] + l * D, P.in[I_L1B] + l * D);
#endif
        grid.sync();
        {
            pg8::Gemm g{XB, (const bf16*)(ws + WS_WFI + l * SZ_WFI), MP, 2 * DFF, D}; pg8::StaticOrder S; S.init(MP, 2 * DFF, G, bx);
            EpiSwiglu E{H};
#ifndef NO_G6
            pg8::gemm_phase<EpiSwiglu, pg8::StaticOrder, true, true>(lds, g, S, E);
#endif
        }
        grid.sync();
        {
            pg8::Gemm g{H, (const bf16*)(ws + WS_WFO + l * SZ_WFO), MP, D, DFF}; pg8::StaticOrder S; S.init(MP, D, G, bx);
            EpiRes E{X};
#ifndef NO_G5
            pg8::gemm_phase<EpiRes, pg8::StaticOrder, true, true>(lds, g, S, E);
#endif
        }
        grid.sync();
        if (l < DEPTH - 1) { ln_pass<false>(P, P.in[I_L2G] + l * D, P.in[I_L2B] + l * D); grid.sync(); }
        else ln_pass<true>(P, P.in[I_L2G] + l * D, P.in[I_L2B] + l * D);
    }
}

extern "C" void kernel_launch(void* const* d_in, const int* in_sizes, int n_in, void* d_out, int out_size, void* d_ws, size_t ws_size, hipStream_t stream) {
    static int grid = 0;
    if (grid == 0) {
        if (n_in != 25 || (size_t)out_size != O_END || ws_size < WS_END) { fprintf(stderr, "kernel_launch: unexpected shapes (n_in %d out %d ws %zu need %zu)\n", n_in, out_size, ws_size, (size_t)WS_END); grid = -1; return; }
        int dev = 0, cus = 0, per = 0;
        if (hipGetDevice(&dev) != hipSuccess || hipDeviceGetAttribute(&cus, hipDeviceAttributeMultiprocessorCount, dev) != hipSuccess) { grid = -1; return; }
        if (hipFuncSetAttribute((const void*)fwd_mega, hipFuncAttributeMaxDynamicSharedMemorySize, LDS_BYTES) != hipSuccess) { fprintf(stderr, "hipFuncSetAttribute failed\n"); grid = -1; return; }
        if (hipOccupancyMaxActiveBlocksPerMultiprocessor(&per, (const void*)fwd_mega, 512, LDS_BYTES) != hipSuccess || per < 1) { fprintf(stderr, "occupancy query: %d\n", per); per = 1; }
        (void)hipGetLastError();
        grid = cus;
    }
    if (grid < 0) return;
    Params p{};
    for (int i = 0; i < 25; ++i) p.in[i] = (const float*)d_in[i];
    p.out = (float*)d_out; p.ws = (unsigned char*)d_ws;
    void* args[] = {&p};
    hipError_t e = hipLaunchCooperativeKernel((const void*)fwd_mega, dim3(grid), dim3(512), args, LDS_BYTES, stream);
    if (e != hipSuccess) fprintf(stderr, "cooperative launch failed: %s (grid %d)\n", hipGetErrorString(e), grid);
}
```

```cpp
#include <hip/hip_runtime.h>
#include <hip/hip_cooperative_groups.h>
#include <cstdio>
#include <cstdint>
namespace cg = cooperative_groups;
namespace pg8 {
#define PG8_LAS __attribute__((address_space(3)))
typedef unsigned short bf16_t;
typedef short bf16x8 __attribute__((ext_vector_type(8)));
typedef float f32x4 __attribute__((ext_vector_type(4)));
typedef unsigned u32x4 __attribute__((ext_vector_type(4)));
constexpr int BM = 256, BK = 64, HALF = 128, HTB = HALF * BK * 2  , STAGE_BYTES = 8 * HTB, NXCD = 8, WGM = 8;

__host__ __device__ __forceinline__ int lds_byte(int r, int c) { const int st = (r >> 4) * 2 + (c >> 5), rr = r & 15, cc = c & 31, ob = rr * 64 + cc * 2; return st * 1024 + (ob ^ (((ob >> 9) & 1) << 5)); }
__host__ __device__ __forceinline__ void stage_rc(int b, int& R, int& C) { const int st = b / 1024, sb = b % 1024, swz = sb ^ (((sb >> 9) & 1) << 5); R = (st >> 1) * 16 + swz / 64; C = (st & 1) * 32 + (swz % 64) / 2; }
__host__ __device__ __forceinline__ int perm32(int rho) { const int n = rho >> 4, i = rho & 15; return 8 * (i >> 2) + 4 * n + (i & 3); }

struct Unit { int pm, pn; };
struct Gemm { const bf16_t* A; const bf16_t* Bt; int M, N, K; };

struct StaticOrder {
    int nM, nN, nwg, G, c;
    __host__ __device__ void init(int M, int N, int G_, int c_) { nM = M / BM; nN = N / BM; nwg = nM * nN; G = G_; c = c_; }
    __host__ __device__ bool next(int i, Unit& u) const {
        const long L = (long)i * G + c; if (L >= nwg) return false;
        int wgid = (int)L; { const int q = nwg / NXCD, r = nwg % NXCD, xcd = wgid % NXCD, off = wgid / NXCD; wgid = (xcd < r ? xcd * (q + 1) : r * (q + 1) + (xcd - r) * q) + off; }
        const int nig = WGM * nN, gid = wgid / nig, fm = gid * WGM, gsz = (nM - fm) < WGM ? (nM - fm) : WGM;
        u.pm = fm + ((wgid % nig) % gsz); u.pn = (wgid % nig) / gsz; return true;
    }
    __device__ __forceinline__ void a_ready(const Unit&) const {}
    __device__ __forceinline__ void done(const Unit&) const {}
};

template <class Epi, class Sched, bool ALIGN_EPI = false, bool SP2 = false>
__device__ __forceinline__ void gemm_phase(PG8_LAS unsigned char* lds, const Gemm g, const Sched& S, const Epi& E) {
    int tid_ = threadIdx.x; asm volatile("" : "+v"(tid_));
    const int tid = tid_, wid = __builtin_amdgcn_readfirstlane(tid >> 6), lane = tid & 63, wr = wid >> 2, wc = wid & 3, fr = lane & 15, fq = lane >> 4;
    const int K = g.K, nt = K / BK;
    unsigned voffA[2], voffB[2];
#pragma unroll
    for (int i = 0; i < 2; ++i) { int R, C; stage_rc(tid * 16 + i * 8192, R, C); const int Rb = Epi::PERM ? ((R & ~31) + perm32(R & 31)) : R;
        voffA[i] = (unsigned)(R * K + C) * 2u; voffB[i] = (unsigned)(Rb * K + C) * 2u; }
    const size_t kstep = (size_t)(BK * 2);
    const size_t hstep = (size_t)HALF * K * 2;
    const size_t tstep = 2 * hstep;
    const unsigned ldsw = (unsigned)wid * 1024u;
    const int aoff = lds_byte(wr * 64 + fr, fq * 8), boff = lds_byte(wc * 32 + fr, fq * 8);
#define PG8_SA(b, h) (((b) * 2 + (h)) * HTB)
#define PG8_SB(b, h) ((4 + (b) * 2 + (h)) * HTB)
#define PG8_STAGE(bufoff, gbase, voff) do { _Pragma("unroll") for (int _i = 0; _i < 2; ++_i) \
        __builtin_amdgcn_global_load_lds((const unsigned*)((const char*)(gbase) + (voff)[_i]), (PG8_LAS unsigned*)(lds + (bufoff) + ldsw + _i * 8192), 16, 0, 0); } while (0)
#define PG8_LDA(dst, b, h) do { _Pragma("unroll") for (int m = 0; m < 4; ++m) _Pragma("unroll") for (int k = 0; k < 2; ++k) dst[m][k] = *(const PG8_LAS bf16x8*)(lds + PG8_SA(b, h) + aoff + m * 2048 + k * 1024); } while (0)
#define PG8_LDB(dst, b, h) do { _Pragma("unroll") for (int n = 0; n < 2; ++n) _Pragma("unroll") for (int k = 0; k < 2; ++k) dst[n][k] = *(const PG8_LAS bf16x8*)(lds + PG8_SB(b, h) + boff + n * 2048 + k * 1024); } while (0)
#define PG8_MMA(ai, bj, At, Bt) do { __builtin_amdgcn_s_setprio(1); _Pragma("unroll") for (int m = 0; m < 4; ++m) _Pragma("unroll") for (int n = 0; n < 2; ++n) _Pragma("unroll") for (int k = 0; k < 2; ++k) \
        acc[ai][bj][m][n] = __builtin_amdgcn_mfma_f32_16x16x32_bf16(Bt[n][k], At[m][k], acc[ai][bj][m][n], 0, 0, 0); __builtin_amdgcn_s_setprio(0); } while (0)
#define PG8_WAIT_V(n) asm volatile("s_waitcnt vmcnt(" #n ")" ::: "memory")
#define PG8_WAIT_L(n) asm volatile("s_waitcnt lgkmcnt(" #n ")" ::: "memory")
#define PG8_BAR __builtin_amdgcn_s_barrier()
#define PG8_SCHED __builtin_amdgcn_sched_barrier(0)
    Unit cur, nxt; int ui = 0;
    if (!S.next(0, cur)) return;
    f32x4 acc[2][2][4][2];
#pragma unroll
    for (int a = 0; a < 2; ++a)
#pragma unroll
        for (int b = 0; b < 2; ++b)
#pragma unroll
            for (int m = 0; m < 4; ++m)
#pragma unroll
                for (int n = 0; n < 2; ++n) acc[a][b][m][n] = (f32x4){0.f, 0.f, 0.f, 0.f};
    bf16x8 At[4][2], B0[2][2], B1[2][2];
    const char* cA = (const char*)g.A + (size_t)cur.pm * tstep; const char* cB = (const char*)g.Bt + (size_t)cur.pn * tstep;
    S.a_ready(cur);
    if constexpr (SP2) {
        PG8_STAGE(PG8_SB(0, 0), cB, voffB); PG8_STAGE(PG8_SB(0, 1), cB + hstep, voffB); PG8_STAGE(PG8_SA(0, 0), cA, voffA); PG8_STAGE(PG8_SA(0, 1), cA + hstep, voffA);
        if (wr == 1) PG8_BAR;
        PG8_WAIT_V(2); PG8_BAR;
        PG8_STAGE(PG8_SB(1, 0), cB + kstep, voffB); PG8_STAGE(PG8_SA(1, 0), cA + kstep, voffA); PG8_STAGE(PG8_SB(1, 1), cB + hstep + kstep, voffB);
        PG8_WAIT_V(6); PG8_BAR;
    } else {
        PG8_STAGE(PG8_SB(0, 0), cB, voffB); PG8_STAGE(PG8_SA(0, 0), cA, voffA); PG8_STAGE(PG8_SB(0, 1), cB + hstep, voffB); PG8_STAGE(PG8_SA(0, 1), cA + hstep, voffA);
        if (wr == 1) PG8_BAR;
        PG8_WAIT_V(4); PG8_BAR;
        PG8_STAGE(PG8_SB(1, 0), cB + kstep, voffB); PG8_STAGE(PG8_SA(1, 0), cA + kstep, voffA); PG8_STAGE(PG8_SB(1, 1), cB + hstep + kstep, voffB);
        PG8_WAIT_V(6); PG8_BAR;
    }
    for (;;) {
        const bool has_next = S.next(ui + 1, nxt);
        const char* nA = has_next ? (const char*)g.A + (size_t)nxt.pm * tstep : cA; const char* nB = has_next ? (const char*)g.Bt + (size_t)nxt.pn * tstep : cB;
        for (int t = 0; t < nt; t += 2) {
            const bool last = (t == nt - 2);
            const char* a1 = cA + (size_t)(t + 1) * kstep;
            const char* a2 = last ? nA : cA + (size_t)(t + 2) * kstep; const char* b2 = last ? nB : cB + (size_t)(t + 2) * kstep;
            const char* a3 = a2 + kstep; const char* b3 = b2 + kstep;
            if (last && has_next) S.a_ready(nxt);
            if constexpr (SP2) {
            PG8_LDB(B0, 0, 0); PG8_LDB(B1, 0, 1); PG8_SCHED; PG8_LDA(At, 0, 0); PG8_STAGE(PG8_SA(1, 1), a1 + hstep, voffA);
            PG8_WAIT_V(8); PG8_WAIT_L(0); PG8_BAR; PG8_MMA(0, 0, At, B0); PG8_MMA(0, 1, At, B1); PG8_BAR; PG8_SCHED;
            PG8_LDA(At, 0, 1); PG8_STAGE(PG8_SB(0, 0), b2, voffB); PG8_STAGE(PG8_SB(0, 1), b2 + hstep, voffB); PG8_STAGE(PG8_SA(0, 0), a2, voffA);
            PG8_WAIT_V(8); PG8_WAIT_L(0); PG8_BAR; PG8_MMA(1, 0, At, B0); PG8_MMA(1, 1, At, B1); PG8_BAR; PG8_SCHED;
            PG8_LDB(B0, 1, 0); PG8_LDB(B1, 1, 1); PG8_SCHED; PG8_LDA(At, 1, 0); PG8_STAGE(PG8_SA(0, 1), a2 + hstep, voffA);
            PG8_WAIT_V(8); PG8_WAIT_L(0); PG8_BAR; PG8_MMA(0, 0, At, B0); PG8_MMA(0, 1, At, B1); PG8_BAR; PG8_SCHED;
            PG8_LDA(At, 1, 1); PG8_STAGE(PG8_SB(1, 0), b3, voffB); PG8_STAGE(PG8_SB(1, 1), b3 + hstep, voffB); PG8_STAGE(PG8_SA(1, 0), a3, voffA);
            PG8_WAIT_V(8); PG8_WAIT_L(0); PG8_BAR; PG8_MMA(1, 0, At, B0); PG8_MMA(1, 1, At, B1); PG8_BAR; PG8_SCHED;
            } else {
            PG8_LDB(B0, 0, 0); PG8_SCHED; PG8_LDA(At, 0, 0); PG8_STAGE(PG8_SA(1, 1), a1 + hstep, voffA);
            PG8_WAIT_L(8); PG8_BAR; PG8_WAIT_L(0); PG8_MMA(0, 0, At, B0); PG8_BAR; PG8_SCHED;
            PG8_LDB(B1, 0, 1); PG8_STAGE(PG8_SB(0, 0), b2, voffB);
            PG8_BAR; PG8_WAIT_L(0); PG8_MMA(0, 1, At, B1); PG8_BAR;
            PG8_LDA(At, 0, 1); PG8_STAGE(PG8_SA(0, 0), a2, voffA);
            PG8_BAR; PG8_WAIT_L(0); PG8_MMA(1, 0, At, B0); PG8_BAR; PG8_SCHED;
            PG8_STAGE(PG8_SB(0, 1), b2 + hstep, voffB);
            PG8_WAIT_V(6); PG8_BAR; PG8_MMA(1, 1, At, B1); PG8_BAR;
            PG8_LDB(B0, 1, 0); PG8_SCHED; PG8_LDA(At, 1, 0); PG8_STAGE(PG8_SA(0, 1), a2 + hstep, voffA);
            PG8_WAIT_L(8); PG8_BAR; PG8_WAIT_L(0); PG8_MMA(0, 0, At, B0); PG8_BAR; PG8_SCHED;
            PG8_LDB(B1, 1, 1); PG8_STAGE(PG8_SB(1, 0), b3, voffB);
            PG8_BAR; PG8_WAIT_L(0); PG8_MMA(0, 1, At, B1); PG8_BAR;
            PG8_LDA(At, 1, 1); PG8_STAGE(PG8_SA(1, 0), a3, voffA);
            PG8_BAR; PG8_WAIT_L(0); PG8_MMA(1, 0, At, B0); PG8_BAR; PG8_SCHED;
            PG8_STAGE(PG8_SB(1, 1), b3 + hstep, voffB);
            PG8_WAIT_V(6); PG8_BAR; PG8_MMA(1, 1, At, B1); PG8_BAR;
            }
        }
        if constexpr (ALIGN_EPI) { if (wr == 0) PG8_BAR; }
        if constexpr (!Epi::AFTER_DRAIN) { E(acc, cur, wr, wc, fr, fq); S.done(cur); }
        if (!has_next) break;
#pragma unroll
        for (int a = 0; a < 2; ++a)
#pragma unroll
            for (int b = 0; b < 2; ++b)
#pragma unroll
                for (int m = 0; m < 4; ++m)
#pragma unroll
                    for (int n = 0; n < 2; ++n) acc[a][b][m][n] = (f32x4){0.f, 0.f, 0.f, 0.f};
        cur = nxt; cA = nA; cB = nB; ++ui;
        if constexpr (ALIGN_EPI) { if (wr == 1) PG8_BAR; }
    }
    PG8_WAIT_V(0);
    if constexpr (!ALIGN_EPI) { if (wr == 0) PG8_BAR; }
    PG8_BAR;
    if constexpr (Epi::AFTER_DRAIN) { E.fused(acc, cur, wr, wc, fr, fq, lds, wid, lane); S.done(cur); }
#undef PG8_SA
#undef PG8_SB
#undef PG8_STAGE
#undef PG8_LDA
#undef PG8_LDB
#undef PG8_MMA
#undef PG8_WAIT_V
#undef PG8_WAIT_L
#undef PG8_BAR
#undef PG8_SCHED
}
}
#ifndef DUP_SYNC
#define DUP_SYNC 0
#endif
#ifndef DUP_LRU0
#define DUP_LRU0 0
#endif
#ifndef DUP_ATT
#define DUP_ATT 0
#endif
#ifndef DUP_G1
#define DUP_G1 0
#endif
#ifndef DUP_P0
#define DUP_P0 0
#endif
#define GSYNC() do { xcd_barrier(xbar); if (DUP_SYNC) xcd_barrier(xbar); } while (0)
#define LAS __attribute__((address_space(3)))
typedef unsigned short bf16;
typedef float f32x4 __attribute__((ext_vector_type(4)));
typedef float f32x16 __attribute__((ext_vector_type(16)));
typedef short bf16x8 __attribute__((ext_vector_type(8)));
typedef short s16x4 __attribute__((ext_vector_type(4)));
typedef unsigned u32x4 __attribute__((ext_vector_type(4)));
typedef unsigned u32x2 __attribute__((ext_vector_type(2)));
typedef float f32x2_t __attribute__((ext_vector_type(2)));
typedef __bf16 bf16x2_t __attribute__((ext_vector_type(2)));

constexpr int D = 1024, LP = 2064, NPT = 8 * LP  , M = NPT + 512  , MP = 17152, DIN = 4864, DFF = 2816, DEPTH = 4;
constexpr int NTILE64 = M / 64;
constexpr float ALPHA = 1.6817928305074292f;
constexpr float LN_EPS = 1e-5f;
constexpr size_t O_YP = 0, O_YS = 16777216, O_WKP = 17301504, O_WVP = 17825792, O_CVP = 18350080, O_LRP = 18448384,
                 O_WKS = 18481152, O_WVS = 26869760, O_CVS = 35258368, O_LRS = 36831232, O_END = 37355520;
constexpr size_t OB_Q = 0, OB_ATT = (size_t)MP * 512 * 2;
constexpr size_t SZ_WIN = (size_t)DIN * D * 2, SZ_WAP = (size_t)D * 512 * 2, SZ_WLP = (size_t)D * D * 2, SZ_WOUT = SZ_WLP, SZ_WFI = (size_t)2 * DFF * D * 2, SZ_WFO = (size_t)D * DFF * 2, SZ_LW = (size_t)8 * 256 * 128 * 2;
constexpr size_t WS_WIN = 0, WS_WAP = WS_WIN + 4 * SZ_WIN, WS_WLP = WS_WAP + 4 * SZ_WAP, WS_WOUT = WS_WLP + 4 * SZ_WLP, WS_WFI = WS_WOUT + 4 * SZ_WOUT, WS_WFO = WS_WFI + 4 * SZ_WFI,
                 WS_LW = WS_WFO + 4 * SZ_WFO, WS_ROPE = WS_LW + 4 * SZ_LW, WS_AGG = WS_ROPE + 1048576, WS_X = WS_AGG + 3145728, WS_XB = WS_X + (size_t)MP * D * 4,
                 WS_R = WS_XB + (size_t)MP * D * 2;
constexpr size_t WS_KB = WS_R, WS_VT = WS_KB + (size_t)MP * 128 * 2, WS_XR = WS_VT + (size_t)MP * 128 * 2, WS_GG = WS_XR + (size_t)MP * D * 2, WS_SA = WS_GG + (size_t)MP * D * 2, WS_SL = WS_SA + (size_t)MP * D * 2,
                 WS_END = WS_SL + (size_t)MP * D * 2;
constexpr size_t WS_BAR = WS_END;
constexpr size_t WS_TOTAL = WS_BAR + 16384;
constexpr size_t WS_H = WS_R;
static_assert(WS_H + (size_t)MP * DFF * 2 <= WS_END, "H overlay");
static_assert(WS_GG == WS_XR + (size_t)MP * D * 2 && WS_SA == WS_GG + (size_t)MP * D * 2 && WS_SL == WS_SA + (size_t)MP * D * 2, "XR|GG|SA|SL consecutive");
constexpr int LDS_BYTES = 147456;

struct Params { const float* in[25]; float* out; unsigned char* ws; };
enum { I_XP = 0, I_XS, I_CK, I_CV, I_SC, I_SLRU, I_META, I_WIN, I_WAP, I_WLP, I_WOUT, I_SINK, I_CW, I_CB, I_WA, I_BA, I_WX, I_BX, I_LAM, I_L1G, I_L1B, I_WFI, I_WFO, I_L2G, I_L2B };

__device__ __forceinline__ unsigned cvtpk(float lo, float hi) { f32x2_t v = {lo, hi}; bf16x2_t b = __builtin_convertvector(v, bf16x2_t); return __builtin_bit_cast(unsigned, b); }
__device__ __forceinline__ bf16 f2bf(float f) { return (bf16)(cvtpk(f, 0.f) & 0xffffu); }
__device__ __forceinline__ float bf2f(unsigned b) { return __uint_as_float(b << 16); }
__device__ __forceinline__ float bflo(unsigned w) { return __uint_as_float(w << 16); }
__device__ __forceinline__ float bfhi(unsigned w) { return __uint_as_float(w & 0xffff0000u); }
__device__ __forceinline__ float sigmoidf_(float x) { return __builtin_amdgcn_rcpf(1.f + __expf(-x)); }
__device__ __forceinline__ float gelu_tanh(float x) { return x * sigmoidf_(1.5957691216057308f * (x + 0.044715f * x * x * x)); }
__device__ __forceinline__ u32x4 pack8(f32x4 a, f32x4 b) { u32x4 w; w.x = cvtpk(a[0], a[1]); w.y = cvtpk(a[2], a[3]); w.z = cvtpk(b[0], b[1]); w.w = cvtpk(b[2], b[3]); return w; }
__device__ __forceinline__ int opaque_tid() { int t = threadIdx.x; asm volatile("" : "+v"(t)); return t; }
__device__ __forceinline__ int crow(int reg, int h) { return (reg & 3) + 8 * (reg >> 2) + 4 * h; }
#define MFMA32(a, b, c) __builtin_amdgcn_mfma_f32_32x32x16_bf16((a), (b), (c), 0, 0, 0)
#define LDS_WAIT() asm volatile("s_waitcnt lgkmcnt(0)" ::: "memory")

struct EpiProj {
    static constexpr bool PERM = true, AFTER_DRAIN = false;
    int l; bf16 *Q, *KB, *VT, *XR; const float* rope; float* out;
    __device__ __forceinline__ static int pos_idx(int row) { return row < NPT ? row % LP : (row < M ? LP + ((row - NPT) & 3) : 0); }
    __device__ __forceinline__ void operator()(const pg8::f32x4 (&acc)[2][2][4][2], const pg8::Unit& u, int wr, int wc, int fr, int fq) const {
        const int pn = u.pn, cl = wc * 32 + 8 * fq;
        if (pn < 3) {
#pragma unroll
            for (int ai = 0; ai < 2; ++ai)
#pragma unroll
                for (int m = 0; m < 4; ++m) {
                    const int row = u.pm * 256 + ai * 128 + wr * 64 + m * 16 + fr;
                    const int pi = pos_idx(row);
                    const int d0 = (cl & 63) >> 1;
                    const f32x4 cs0 = *(const f32x4*)(rope + (size_t)pi * 64 + d0 * 2), cs1 = *(const f32x4*)(rope + (size_t)pi * 64 + d0 * 2 + 4);
#pragma unroll
                    for (int bj = 0; bj < 2; ++bj) {
                        const f32x4 v0 = acc[ai][bj][m][0], v1 = acc[ai][bj][m][1];
                        if (pn == 2 && bj == 1) {
                            const int vc = cl;
                            const f32x4 t0 = v0 + 0.f, t1 = v1 + 0.f;
                            const u32x4 w = pack8(t0, t1);
                            bf16* vt = VT + (size_t)vc * MP + row;
                            vt[0] = (bf16)(w.x & 0xffff); vt[(size_t)MP] = (bf16)(w.x >> 16); vt[(size_t)2 * MP] = (bf16)(w.y & 0xffff); vt[(size_t)3 * MP] = (bf16)(w.y >> 16);
                            vt[(size_t)4 * MP] = (bf16)(w.z & 0xffff); vt[(size_t)5 * MP] = (bf16)(w.z >> 16); vt[(size_t)6 * MP] = (bf16)(w.w & 0xffff); vt[(size_t)7 * MP] = (bf16)(w.w >> 16);
                            float* dst = nullptr;
                            if (row < NPT) { const int t = row % LP; if (t >= LP - 128) dst = out + O_WVP + ((size_t)((l * 8 + row / LP) * 128 + (t - (LP - 128)))) * 128 + vc; }
                            else if (row < M) { const int db = (row - NPT) >> 2, s = (row - NPT) & 3; dst = out + O_WVS + ((size_t)((l * 128 + db) * 128 + 124 + s)) * 128 + vc; }
                            if (dst) { *(f32x4*)dst = t0; *(f32x4*)(dst + 4) = t1; }
                        } else {
                            f32x4 y0, y1;
                            y0[0] = v0[0] * cs0[0] - v0[1] * cs0[1]; y0[1] = v0[1] * cs0[0] + v0[0] * cs0[1];
                            y0[2] = v0[2] * cs0[2] - v0[3] * cs0[3]; y0[3] = v0[3] * cs0[2] + v0[2] * cs0[3];
                            y1[0] = v1[0] * cs1[0] - v1[1] * cs1[1]; y1[1] = v1[1] * cs1[0] + v1[0] * cs1[1];
                            y1[2] = v1[2] * cs1[2] - v1[3] * cs1[3]; y1[3] = v1[3] * cs1[2] + v1[2] * cs1[3];
                            if (pn < 2) {
                                const int col = pn * 256 + bj * 128 + cl;
                                *(u32x4*)(Q + (size_t)row * 512 + col) = pack8(y0 * 0.125f, y1 * 0.125f);
                            } else {
                                *(u32x4*)(KB + (size_t)row * 128 + cl) = pack8(y0, y1);
                                float* dst = nullptr;
                                if (row < NPT) { const int t = row % LP; if (t >= LP - 128) dst = out + O_WKP + ((size_t)((l * 8 + row / LP) * 128 + (t - (LP - 128)))) * 128; }
                                else if (row < M) { const int db = (row - NPT) >> 2, s = (row - NPT) & 3; dst = out + O_WKS + ((size_t)((l * 128 + db) * 128 + 124 + s)) * 128; }
                                if (dst) { dst += (cl & 64) + d0;
                                    dst[0] = y0[0]; dst[32] = y0[1]; dst[1] = y0[2]; dst[33] = y0[3]; dst[2] = y1[0]; dst[34] = y1[1]; dst[3] = y1[2]; dst[35] = y1[3]; }
                            }
                        }
                    }
                    asm volatile("" ::: "memory");
                }
        } else {
            const int kind = (pn - 3) >> 2;
            bf16* dstb = XR + (size_t)kind * ((size_t)MP * D);
            const int cbase = ((pn - 3) & 3) * 256 + cl;
#pragma unroll
            for (int ai = 0; ai < 2; ++ai)
#pragma unroll
                for (int m = 0; m < 4; ++m) {
                    const int row = u.pm * 256 + ai * 128 + wr * 64 + m * 16 + fr;
#pragma unroll
                    for (int bj = 0; bj < 2; ++bj) {
                        f32x4 v0 = acc[ai][bj][m][0] + 0.f, v1 = acc[ai][bj][m][1] + 0.f;
                        const int c = cbase + bj * 128;
                        if (kind == 0) {
                            float* dst = nullptr;
                            if (row < NPT) { const int t = row % LP; if (t >= LP - 3) dst = out + O_CVP + ((size_t)((l * 8 + row / LP) * 3 + (t - (LP - 3)))) * 1024 + c; }
                            else if (row < M) { const int db = (row - NPT) >> 2, s = (row - NPT) & 3; if (s >= 1) dst = out + O_CVS + ((size_t)((l * 128 + db) * 3 + (s - 1))) * 1024 + c; }
                            if (dst) { *(f32x4*)dst = v0; *(f32x4*)(dst + 4) = v1; }
                        } else if (kind == 1) {
#pragma unroll
                            for (int j = 0; j < 4; ++j) { v0[j] = gelu_tanh(v0[j]); v1[j] = gelu_tanh(v1[j]); }
                        } else {
#pragma unroll
                            for (int j = 0; j < 4; ++j) { v0[j] = sigmoidf_(v0[j]); v1[j] = sigmoidf_(v1[j]); }
                        }
                        *(u32x4*)(dstb + (size_t)row * 1024 + c) = pack8(v0, v1);
                    }
                    asm volatile("" ::: "memory");
                }
        }
    }
};
template <bool ADD> struct EpiGate {
    static constexpr bool PERM = true, AFTER_DRAIN = false;
    bf16* S; const bf16* A;
    __device__ __forceinline__ void operator()(const pg8::f32x4 (&acc)[2][2][4][2], const pg8::Unit& u, int wr, int wc, int fr, int fq) const {
#pragma unroll
        for (int ai = 0; ai < 2; ++ai)
#pragma unroll
            for (int m = 0; m < 4; ++m) {
                const int row = u.pm * 256 + ai * 128 + wr * 64 + m * 16 + fr;
#pragma unroll
                for (int bj = 0; bj < 2; ++bj) {
                    const size_t off = (size_t)row * 1024 + u.pn * 256 + bj * 128 + wc * 32 + 8 * fq;
                    const u32x4 s = *(const u32x4*)(S + off);
                    f32x4 v0 = acc[ai][bj][m][0], v1 = acc[ai][bj][m][1];
                    v0[0] *= bflo(s.x); v0[1] *= bfhi(s.x); v0[2] *= bflo(s.y); v0[3] *= bfhi(s.y); v1[0] *= bflo(s.z); v1[1] *= bfhi(s.z); v1[2] *= bflo(s.w); v1[3] *= bfhi(s.w);
                    if (ADD) { const u32x4 a = *(const u32x4*)(A + off);
                        v0[0] += bflo(a.x); v0[1] += bfhi(a.x); v0[2] += bflo(a.y); v0[3] += bfhi(a.y); v1[0] += bflo(a.z); v1[1] += bfhi(a.z); v1[2] += bflo(a.w); v1[3] += bfhi(a.w); }
                    *(u32x4*)(S + off) = pack8(v0, v1);
                }
                asm volatile("" ::: "memory");
            }
    }
};
struct EpiRes {
    static constexpr bool PERM = true, AFTER_DRAIN = false;
    float* X;
    __device__ __forceinline__ void operator()(const pg8::f32x4 (&acc)[2][2][4][2], const pg8::Unit& u, int wr, int wc, int fr, int fq) const {
#pragma unroll
        for (int ai = 0; ai < 2; ++ai)
#pragma unroll
            for (int m = 0; m < 4; ++m) {
                const int row = u.pm * 256 + ai * 128 + wr * 64 + m * 16 + fr;
#pragma unroll
                for (int bj = 0; bj < 2; ++bj) {
                    float* p = X + (size_t)row * 1024 + u.pn * 256 + bj * 128 + wc * 32 + 8 * fq;
                    const f32x4 x0 = *(const f32x4*)p, x1 = *(const f32x4*)(p + 4);
                    *(f32x4*)p = x0 * ALPHA + acc[ai][bj][m][0]; *(f32x4*)(p + 4) = x1 * ALPHA + acc[ai][bj][m][1];
                }
                asm volatile("" ::: "memory");
            }
    }
};
struct EpiSwiglu {
    static constexpr bool PERM = true, AFTER_DRAIN = false;
    bf16* H;
    __device__ __forceinline__ void operator()(const pg8::f32x4 (&acc)[2][2][4][2], const pg8::Unit& u, int wr, int wc, int fr, int fq) const {
#pragma unroll
        for (int ai = 0; ai < 2; ++ai)
#pragma unroll
            for (int m = 0; m < 4; ++m) {
                const int row = u.pm * 256 + ai * 128 + wr * 64 + m * 16 + fr;
                f32x4 h0, h1;
#pragma unroll
                for (int j = 0; j < 4; ++j) { const float a = acc[ai][0][m][0][j], b = acc[ai][0][m][1][j];
                    h0[j] = a * sigmoidf_(a) * acc[ai][1][m][0][j]; h1[j] = b * sigmoidf_(b) * acc[ai][1][m][1][j]; }
                *(u32x4*)(H + (size_t)row * DFF + u.pn * 128 + wc * 32 + 8 * fq) = pack8(h0, h1);
            }
    }
};

__device__ __forceinline__ int colmap(int mode, int n) {
    if (mode == 1) { if (n < 640) { const int p = n & 63; return (n & ~63) + (p >> 1) + ((p & 1) << 5); } return n; }
    if (mode == 2) { const int pn = n >> 8, bj = (n >> 7) & 1, j = n & 127; return bj * DFF + pn * 128 + j; }
    return n;
}
__device__ __forceinline__ void transpose_item(const float* W, int K, int N, bf16* WT, int mode, LAS float* scr, int item, int lane) {
    const int nblk = N / 32, kb = item / nblk, nb = item % nblk, k0 = 64 * kb, n0 = 32 * nb;
    const int nsrc = colmap(mode, n0 + (lane & 31));
#pragma unroll 8
    for (int i = 0; i < 32; ++i) { const int kk = 2 * i + (lane >> 5); scr[kk * 33 + (lane & 31)] = W[(size_t)(k0 + kk) * N + nsrc]; }
    LDS_WAIT();
    const int c = lane & 7;
#pragma unroll
    for (int j = 0; j < 4; ++j) { const int n = (lane >> 3) + 8 * j; const LAS float* s = scr + (8 * c) * 33 + n;
        u32x4 o; o.x = cvtpk(s[0 * 33], s[1 * 33]); o.y = cvtpk(s[2 * 33], s[3 * 33]); o.z = cvtpk(s[4 * 33], s[5 * 33]); o.w = cvtpk(s[6 * 33], s[7 * 33]);
        *(u32x4*)(WT + (size_t)(n0 + n) * K + k0 + 8 * c) = o; }
    LDS_WAIT();
}
__device__ __forceinline__ void prologue(const Params& P, LAS unsigned char* lds) {
    const int tid = opaque_tid(), lane = tid & 63, wave = tid >> 6;
    const int gw = blockIdx.x * 8 + wave, NGW = gridDim.x * 8;
    LAS float* scr = (LAS float*)(lds + wave * 8704);
    unsigned char* ws = P.ws;
    constexpr int IT_IN = 16 * (DIN / 32), IT_AP = 8 * 32, IT_LP = 16 * 32, IT_OUT = 16 * 32, IT_FI = 16 * (2 * DFF / 32), IT_FO = (DFF / 64) * 32, IT_LW = 16 * 8;
    constexpr int IT_LAYER = IT_IN + IT_AP + IT_LP + IT_OUT + IT_FI + IT_FO + IT_LW;
    for (int it = gw; it < DEPTH * IT_LAYER; it += NGW) {
        const int l = it / IT_LAYER; int r = it % IT_LAYER;
        if (r < IT_IN) { transpose_item(P.in[I_WIN] + (size_t)l * D * DIN, D, DIN, (bf16*)(ws + WS_WIN + l * SZ_WIN), 1, scr, r, lane); continue; } r -= IT_IN;
        if (r < IT_AP) { transpose_item(P.in[I_WAP] + (size_t)l * 512 * D, 512, D, (bf16*)(ws + WS_WAP + l * SZ_WAP), 0, scr, r, lane); continue; } r -= IT_AP;
        if (r < IT_LP) { transpose_item(P.in[I_WLP] + (size_t)l * D * D, D, D, (bf16*)(ws + WS_WLP + l * SZ_WLP), 0, scr, r, lane); continue; } r -= IT_LP;
        if (r < IT_OUT) { transpose_item(P.in[I_WOUT] + (size_t)l * D * D, D, D, (bf16*)(ws + WS_WOUT + l * SZ_WOUT), 0, scr, r, lane); continue; } r -= IT_OUT;
        if (r < IT_FI) { transpose_item(P.in[I_WFI] + (size_t)l * D * 2 * DFF, D, 2 * DFF, (bf16*)(ws + WS_WFI + l * SZ_WFI), 2, scr, r, lane); continue; } r -= IT_FI;
        if (r < IT_FO) { transpose_item(P.in[I_WFO] + (size_t)l * DFF * D, DFF, D, (bf16*)(ws + WS_WFO + l * SZ_WFO), 0, scr, r, lane); continue; } r -= IT_FO;
        { const int mat = r >> 3, sub = r & 7, nb = mat >> 1, which = mat & 1;
          transpose_item(P.in[which ? I_WX : I_WA] + (size_t)(l * 8 + nb) * 128 * 128, 128, 128, (bf16*)(ws + WS_LW + l * SZ_LW) + (size_t)(nb * 256 + which * 128) * 128, 0, scr, sub, lane); }
    }
    float* X = (float*)(ws + WS_X); bf16* XB = (bf16*)(ws + WS_XB);
    for (int m = gw; m < MP; m += NGW) {
        const float* src = nullptr;
        if (m < NPT) { const int b = m / LP, t = m % LP; src = t < 16 ? P.in[I_META] + (size_t)t * D : P.in[I_XP] + ((size_t)b * 2048 + (t - 16)) * D; }
        else if (m < M) src = P.in[I_XS] + (size_t)(m - NPT) * D;
#pragma unroll
        for (int j = 0; j < 4; ++j) {
            f32x4 v = {0.f, 0.f, 0.f, 0.f}; if (src) v = *(const f32x4*)(src + 256 * j + 4 * lane);
            *(f32x4*)(X + (size_t)m * D + 256 * j + 4 * lane) = v;
            u32x2 w; w.x = cvtpk(v[0], v[1]); w.y = cvtpk(v[2], v[3]); *(u32x2*)(XB + (size_t)m * D + 256 * j + 4 * lane) = w;
        }
    }
    float* rope = (float*)(ws + WS_ROPE);
    for (int e = blockIdx.x * 512 + tid; e < (LP + 4) * 32; e += gridDim.x * 512) {
        const int pi = e >> 5, d = e & 31; const double pos = pi < LP ? (double)pi : (double)(8192 + pi - LP);
        const double inv = pow(10000.0, -(double)d / 32.0), ang = pos * inv;
        rope[2 * e] = (float)cos(ang); rope[2 * e + 1] = (float)sin(ang);
    }
}

template <bool FINAL> __device__ __forceinline__ void ln_pass(const Params& P, const float* g, const float* b) {
    const int tid = opaque_tid(), lane = tid & 63, wave = tid >> 6, gw = blockIdx.x * 8 + wave, NGW = gridDim.x * 8;
    float* X = (float*)(P.ws + WS_X); bf16* XB = (bf16*)(P.ws + WS_XB);
    f32x4 gv[4], bv[4];
#pragma unroll
    for (int j = 0; j < 4; ++j) { gv[j] = *(const f32x4*)(g + 256 * j + 4 * lane); bv[j] = *(const f32x4*)(b + 256 * j + 4 * lane); }
    for (int m = gw; m < M; m += NGW) {
        f32x4 v[4]; float s = 0.f;
#pragma unroll
        for (int j = 0; j < 4; ++j) { v[j] = *(const f32x4*)(X + (size_t)m * D + 256 * j + 4 * lane); s += (v[j][0] + v[j][1]) + (v[j][2] + v[j][3]); }
#pragma unroll
        for (int o = 1; o < 64; o <<= 1) s += __shfl_xor(s, o);
        const float mean = s * (1.f / D); float q = 0.f;
#pragma unroll
        for (int j = 0; j < 4; ++j) { v[j] = v[j] - mean; q += (v[j][0] * v[j][0] + v[j][1] * v[j][1]) + (v[j][2] * v[j][2] + v[j][3] * v[j][3]); }
#pragma unroll
        for (int o = 1; o < 64; o <<= 1) q += __shfl_xor(q, o);
        const float rstd = 1.f / sqrtf(q * (1.f / D) + LN_EPS);
        float* yo = nullptr;
        if (FINAL) { if (m < NPT) { const int bb = m / LP, t = m % LP; if (t >= 16) yo = P.out + O_YP + ((size_t)bb * 2048 + (t - 16)) * D; } else yo = P.out + O_YS + (size_t)(m - NPT) * D; }
#pragma unroll
        for (int j = 0; j < 4; ++j) {
            const f32x4 y = v[j] * rstd * gv[j] + bv[j];
            if (FINAL) { if (yo) *(f32x4*)(yo + 256 * j + 4 * lane) = y; }
            else { *(f32x4*)(X + (size_t)m * D + 256 * j + 4 * lane) = y;
                   u32x2 w; w.x = cvtpk(y[0], y[1]); w.y = cvtpk(y[2], y[3]); *(u32x2*)(XB + (size_t)m * D + 256 * j + 4 * lane) = w; }
        }
    }
}

template <int MODE> __device__ __forceinline__ void lru_tile(const Params& P, LAS unsigned char* lds, int l, int tile, int nb) {
    const int tid = opaque_tid(), lane = tid & 63, wid = tid >> 6;
    LAS bf16* xcb = (LAS bf16*)lds;
    LAS float* xcf = (LAS float*)(lds + 17408);
    LAS float* sa = (LAS float*)(lds + 17408 + 32768);
    LAS float* sb = (LAS float*)(lds + 17408 + 65536);
    const bf16* XR = (const bf16*)(P.ws + WS_XR);
    const int t0 = tile * 64; const bool samp = t0 >= NPT;
    for (int e = tid; e < 64 * 16; e += 512) {
        const int r = e >> 4, c8 = e & 15, m = t0 + r, c0 = nb * 128 + c8 * 8;
        const int pos = samp ? ((m - NPT) & 3) : (m % LP);
        const float* buf = P.in[I_SC] + (size_t)((l * 128 + ((m - NPT) >> 2)) * 3) * 1024 + c0;
        f32x4 a0 = *(const f32x4*)(P.in[I_CB] + l * 1024 + c0), a1 = *(const f32x4*)(P.in[I_CB] + l * 1024 + c0 + 4);
#pragma unroll
        for (int i = 0; i < 4; ++i) {
            const f32x4 w0 = *(const f32x4*)(P.in[I_CW] + (size_t)(l * 4 + 3 - i) * 1024 + c0), w1 = *(const f32x4*)(P.in[I_CW] + (size_t)(l * 4 + 3 - i) * 1024 + c0 + 4);
            f32x4 x0 = {0.f, 0.f, 0.f, 0.f}, x1 = {0.f, 0.f, 0.f, 0.f};
            if (pos - i >= 0) { const u32x4 xw = *(const u32x4*)(XR + (size_t)(m - i) * 1024 + c0);
                x0[0] = bflo(xw.x); x0[1] = bfhi(xw.x); x0[2] = bflo(xw.y); x0[3] = bfhi(xw.y); x1[0] = bflo(xw.z); x1[1] = bfhi(xw.z); x1[2] = bflo(xw.w); x1[3] = bfhi(xw.w); }
            else if (samp) { x0 = *(const f32x4*)(buf + (size_t)(3 + pos - i) * 1024); x1 = *(const f32x4*)(buf + (size_t)(3 + pos - i) * 1024 + 4); }
            a0 += w0 * x0; a1 += w1 * x1;
        }
        *(LAS f32x4*)(xcf + r * 128 + c8 * 8) = a0; *(LAS f32x4*)(xcf + r * 128 + c8 * 8 + 4) = a1;
        *(LAS u32x4*)(xcb + r * 136 + c8 * 8) = pack8(a0, a1);
    }
    __syncthreads();
    {
        const int rb = wid & 1, cb = wid >> 1, l32 = lane & 31, h = lane >> 5;
        const bf16* LW = (const bf16*)(P.ws + WS_LW + l * SZ_LW) + (size_t)(nb * 256 + cb * 32 + l32) * 128 + h * 8;
        f32x16 ar, ai;
#pragma unroll
        for (int i = 0; i < 16; ++i) { ar[i] = 0.f; ai[i] = 0.f; }
#pragma unroll
        for (int kk = 0; kk < 8; ++kk) {
            const bf16x8 a = *(const LAS bf16x8*)(xcb + (rb * 32 + l32) * 136 + kk * 16 + h * 8);
            const bf16x8 br = *(const bf16x8*)(LW + kk * 16), bi = *(const bf16x8*)(LW + 128 * 128 + kk * 16);
            ar = MFMA32(a, br, ar); ai = MFMA32(a, bi, ai);
        }
        const int c = cb * 32 + l32, cg_ = nb * 128 + c;
        const float ba = P.in[I_BA][l * 1024 + cg_], bx = P.in[I_BX][l * 1024 + cg_];
        const float sp = log1pf(expf(-P.in[I_LAM][l * 1024 + cg_]));
#pragma unroll
        for (int i = 0; i < 16; ++i) {
            const int r = rb * 32 + crow(i, h);
            const float rr = sigmoidf_(ar[i] + ba), ii = sigmoidf_(ai[i] + bx);
            const float la = -8.f * rr * sp, a = expf(la), mult = sqrtf(-expm1f(2.f * la));
            sa[r * 128 + c] = a; sb[r * 128 + c] = mult * ii * xcf[r * 128 + c];
        }
    }
    __syncthreads();
    {
        const int c = tid & 127, q = tid >> 7, cg_ = nb * 128 + c;
        LAS float* qa = (LAS float*)lds;
        LAS float* qb = qa + 512;
        LAS float* tc = qb + 512;
        float* AGG = (float*)(P.ws + WS_AGG);
        const int pos0 = samp ? 0 : ((t0 + 16 * q) % LP);
        float av[16], bv[16];
#pragma unroll
        for (int i = 0; i < 16; ++i) { av[i] = sa[(16 * q + i) * 128 + c]; bv[i] = sb[(16 * q + i) * 128 + c]; }
        float h0v[4] = {0.f, 0.f, 0.f, 0.f};
        if (samp) {
#pragma unroll
            for (int j = 0; j < 4; ++j) h0v[j] = P.in[I_SLRU][(size_t)(l * 128 + ((t0 + 16 * q - NPT) >> 2) + j) * 1024 + cg_];
        }
        const int rs = samp ? -1 : (pos0 == 0 ? 0 : (LP - pos0 < 16 ? LP - pos0 : -1));
        if (MODE == 1 && q == 0) {
            float h = 0.f;
            if (!samp && (t0 % LP) != 0) {
                const int j0 = (((t0 - 1) / LP) * LP) / 64;
                for (int j = j0; j < tile; ++j) h = AGG[(size_t)j * 2048 + cg_] * h + AGG[(size_t)j * 2048 + 1024 + cg_];
            }
            tc[c] = h;
        }
        {
            float A = 1.f, B = 0.f;
#pragma unroll
            for (int i = 0; i < 16; ++i) {
                const bool reset = samp ? ((i & 3) == 0) : (i == rs);
                if (reset) { A = 0.f; B = av[i] * (samp ? h0v[i >> 2] : 0.f) + bv[i]; } else { A *= av[i]; B = av[i] * B + bv[i]; }
            }
            qa[q * 128 + c] = A; qb[q * 128 + c] = B;
        }
        __syncthreads();
        if (MODE == 0) {
            if (q == 3) {
                float A = 1.f, B = 0.f;
#pragma unroll
                for (int j = 0; j < 4; ++j) { const float Aj = qa[j * 128 + c], Bj = qb[j * 128 + c]; B = Aj * B + Bj; A *= Aj; }
                AGG[(size_t)tile * 2048 + cg_] = A; AGG[(size_t)tile * 2048 + 1024 + cg_] = B;
            }
        } else {
            float h = tc[c];
            for (int j = 0; j < q; ++j) h = qa[j * 128 + c] * h + qb[j * 128 + c];
#pragma unroll
            for (int i = 0; i < 16; ++i) {
                const bool reset = samp ? ((i & 3) == 0) : (i == rs);
                h = reset ? av[i] * (samp ? h0v[i >> 2] : 0.f) + bv[i] : av[i] * h + bv[i];
                sb[(16 * q + i) * 128 + c] = h;
            }
            __syncthreads();
            bf16* GG = (bf16*)(P.ws + WS_GG);
            for (int e = tid; e < 64 * 16; e += 512) {
                const int r = e >> 4, c8 = e & 15, m = t0 + r;
                bf16* gp = GG + (size_t)m * 1024 + nb * 128 + c8 * 8;
                const u32x4 gw = *(const u32x4*)gp;
                const f32x4 h0 = *(const LAS f32x4*)(sb + r * 128 + c8 * 8), h1 = *(const LAS f32x4*)(sb + r * 128 + c8 * 8 + 4);
                f32x4 r0, r1;
                r0[0] = h0[0] * bflo(gw.x); r0[1] = h0[1] * bfhi(gw.x); r0[2] = h0[2] * bflo(gw.y); r0[3] = h0[3] * bfhi(gw.y);
                r1[0] = h1[0] * bflo(gw.z); r1[1] = h1[1] * bfhi(gw.z); r1[2] = h1[2] * bflo(gw.w); r1[3] = h1[3] * bfhi(gw.w);
                *(u32x4*)gp = pack8(r0, r1);
                float* so = nullptr;
                if (samp) { if ((r & 3) == 3) so = P.out + O_LRS + (size_t)(l * 128 + ((m - NPT) >> 2)) * 1024; }
                else if (m % LP == LP - 1) so = P.out + O_LRP + (size_t)(l * 8 + m / LP) * 1024;
                if (so) { *(f32x4*)(so + nb * 128 + c8 * 8) = h0; *(f32x4*)(so + nb * 128 + c8 * 8 + 4) = h1; }
            }
        }
    }
    __syncthreads();
}

__device__ __forceinline__ void attn_prompt_wave(const Params& P, int l, int qt) {
    const int tid = opaque_tid(), lane = tid & 63, l32 = lane & 31, h = lane >> 5, head = tid >> 6, kvh = head >> 2;
    const bf16* Q = (const bf16*)((const unsigned char*)P.out + OB_Q); bf16* ATT = (bf16*)((unsigned char*)P.out + OB_ATT);
    const bf16* KB = (const bf16*)(P.ws + WS_KB); const bf16* VT = (const bf16*)(P.ws + WS_VT);
    const int q0 = qt * 32, key0 = q0 - 128;
    bf16x8 qf[4];
#pragma unroll
    for (int kk = 0; kk < 4; ++kk) qf[kk] = *(const bf16x8*)(Q + (size_t)(q0 + l32) * 512 + head * 64 + kk * 16 + h * 8);
    f32x16 st[5];
#pragma unroll
    for (int kb = 0; kb < 5; ++kb) {
#pragma unroll
        for (int i = 0; i < 16; ++i) st[kb][i] = 0.f;
        int krow_ = key0 + kb * 32 + l32; krow_ = krow_ < 0 ? 0 : krow_;
        const bf16* kp = KB + (size_t)krow_ * 128 + kvh * 64 + h * 8;
#pragma unroll
        for (int kk = 0; kk < 4; ++kk) { const bf16x8 kf = *(const bf16x8*)(kp + kk * 16); st[kb] = MFMA32(kf, qf[kk], st[kb]); }
    }
    const int qi = q0 + l32, bstart = (qi / LP) * LP;
    const float sink = P.in[I_SINK][l * 8 + head];
    float mx = sink;
#pragma unroll
    for (int kb = 0; kb < 5; ++kb)
#pragma unroll
        for (int i = 0; i < 16; ++i) { const int ki = key0 + kb * 32 + crow(i, h); const bool ok = ki <= qi && ki > qi - 128 && ki >= bstart;
            st[kb][i] = ok ? st[kb][i] : -1e30f; mx = fmaxf(mx, st[kb][i]); }
    mx = fmaxf(mx, __shfl_xor(mx, 32));
    float sum = 0.f;
#pragma unroll
    for (int kb = 0; kb < 5; ++kb)
#pragma unroll
        for (int i = 0; i < 16; ++i) { const float p = st[kb][i] > -1e29f ? __expf(st[kb][i] - mx) : 0.f; st[kb][i] = p; sum += p; }
    sum += __shfl_xor(sum, 32);
    const float inv = 1.f / (sum + __expf(sink - mx));
    f32x16 o0, o1;
#pragma unroll
    for (int i = 0; i < 16; ++i) { o0[i] = 0.f; o1[i] = 0.f; }
#pragma unroll
    for (int kb = 0; kb < 5; ++kb)
#pragma unroll
        for (int s = 0; s < 2; ++s) {
            u32x4 pw; pw.x = cvtpk(st[kb][8 * s], st[kb][8 * s + 1]); pw.y = cvtpk(st[kb][8 * s + 2], st[kb][8 * s + 3]); pw.z = cvtpk(st[kb][8 * s + 4], st[kb][8 * s + 5]); pw.w = cvtpk(st[kb][8 * s + 6], st[kb][8 * s + 7]);
            const bf16x8 pf = __builtin_bit_cast(bf16x8, pw);
            int k0 = key0 + kb * 32 + 16 * s + 4 * h, k1 = k0 + 8; k0 = k0 < 0 ? 0 : k0; k1 = k1 < 0 ? 0 : k1;
#pragma unroll
            for (int db = 0; db < 2; ++db) {
                const bf16* vp = VT + (size_t)(kvh * 64 + db * 32 + l32) * MP;
                const u32x2 va = *(const u32x2*)(vp + k0), vb = *(const u32x2*)(vp + k1);
                u32x4 vw; vw.x = va.x; vw.y = va.y; vw.z = vb.x; vw.w = vb.y;
                const bf16x8 vf = __builtin_bit_cast(bf16x8, vw);
                if (db == 0) o0 = MFMA32(vf, pf, o0); else o1 = MFMA32(vf, pf, o1);
            }
        }
    bf16* op = ATT + (size_t)qi * 512 + head * 64 + 4 * h;
#pragma unroll
    for (int g = 0; g < 4; ++g) {
        u32x2 w; w.x = cvtpk(o0[4 * g] * inv, o0[4 * g + 1] * inv); w.y = cvtpk(o0[4 * g + 2] * inv, o0[4 * g + 3] * inv); *(u32x2*)(op + 8 * g) = w;
        u32x2 w2; w2.x = cvtpk(o1[4 * g] * inv, o1[4 * g + 1] * inv); w2.y = cvtpk(o1[4 * g + 2] * inv, o1[4 * g + 3] * inv); *(u32x2*)(op + 32 + 8 * g) = w2;
    }
}

__device__ __forceinline__ void attn_sample_item(const Params& P, LAS unsigned char* lds, int l, int db, int kvh) {
    const int tid = opaque_tid(), lane = tid & 63, wid = tid >> 6;
    LAS float* Ks = (LAS float*)lds;
    LAS float* Vs = Ks + 132 * 65;
    LAS float* qs = Vs + 132 * 64;
    LAS float* S = qs + 16 * 64;
    const bf16* Q = (const bf16*)((const unsigned char*)P.out + OB_Q); bf16* ATT = (bf16*)((unsigned char*)P.out + OB_ATT);
    const size_t cbase = (size_t)(l * 128 + db) * 128;
    for (int e = tid; e < 132 * 64; e += 512) {
        const int key = e >> 6, d = e & 63;
        float kv, vv;
        if (key < 128) { kv = P.in[I_CK][((cbase + key) * 2 + kvh) * 64 + d]; vv = P.in[I_CV][((cbase + key) * 2 + kvh) * 64 + d]; }
        else { kv = P.out[O_WKS + ((cbase + key - 4) * 2 + kvh) * 64 + d]; vv = P.out[O_WVS + ((cbase + key - 4) * 2 + kvh) * 64 + d]; }
        Ks[key * 65 + d] = kv; Vs[key * 64 + d] = vv;
        if (key >= 4 && key < 128) { P.out[O_WKS + ((cbase + key - 4) * 2 + kvh) * 64 + d] = kv; P.out[O_WVS + ((cbase + key - 4) * 2 + kvh) * 64 + d] = vv; }
    }
    for (int e = tid; e < 16 * 64; e += 512) {
        const int row = e >> 6, d = e & 63, g = row >> 2, s = row & 3, p = d < 32 ? 2 * d : 2 * (d - 32) + 1;
        qs[e] = bf2f(Q[(size_t)(NPT + db * 4 + s) * 512 + (kvh * 4 + g) * 64 + p]);
    }
    __syncthreads();
    for (int e = tid; e < 16 * 132; e += 512) {
        const int row = e / 132, key = e % 132, s = row & 3;
        float acc = 0.f;
#pragma unroll 16
        for (int d = 0; d < 64; ++d) acc += qs[row * 64 + d] * Ks[key * 65 + d];
        const bool ok = key < 128 ? key > s : (key - 128) <= s;
        S[e] = ok ? acc : -1e30f;
    }
    __syncthreads();
    for (int rr = 0; rr < 2; ++rr) {
        const int row = wid * 2 + rr, g = row >> 2; const float sink = P.in[I_SINK][l * 8 + kvh * 4 + g];
        float v0 = S[row * 132 + lane], v1 = S[row * 132 + 64 + lane], v2 = lane < 4 ? S[row * 132 + 128 + lane] : -1e30f;
        float mx = fmaxf(fmaxf(v0, v1), fmaxf(v2, sink));
#pragma unroll
        for (int o = 1; o < 64; o <<= 1) mx = fmaxf(mx, __shfl_xor(mx, o));
        const float p0 = v0 > -1e29f ? __expf(v0 - mx) : 0.f, p1 = v1 > -1e29f ? __expf(v1 - mx) : 0.f, p2 = v2 > -1e29f ? __expf(v2 - mx) : 0.f;
        float sum = p0 + p1 + p2;
#pragma unroll
        for (int o = 1; o < 64; o <<= 1) sum += __shfl_xor(sum, o);
        const float inv = 1.f / (sum + __expf(sink - mx));
        S[row * 132 + lane] = p0 * inv; S[row * 132 + 64 + lane] = p1 * inv; if (lane < 4) S[row * 132 + 128 + lane] = p2 * inv;
    }
    __syncthreads();
    for (int e = tid; e < 16 * 64; e += 512) {
        const int row = e >> 6, d = e & 63, g = row >> 2, s = row & 3;
        float acc = 0.f;
#pragma unroll 4
        for (int key = 0; key < 132; ++key) acc += S[row * 132 + key] * Vs[key * 64 + d];
        ATT[(size_t)(NPT + db * 4 + s) * 512 + (kvh * 4 + g) * 64 + d] = f2bf(acc);
    }
    __syncthreads();
}

#define XB_TMO      128
#define XB_XCNT(j)  (256  + 64 * (j))
#define XB_XSUB(j)  (1280 + 64 * (j))
#define XB_XGEN(j)  (2304 + 64 * (j))
#define XB_TOP      3328
#define XB_TOPGEN   3392
#define XCD_BAR_WORDS 3456
#define XB_SPIN_CAP (1u << 18)

__device__ __forceinline__ unsigned xb_ld(unsigned* p)              { return __hip_atomic_load(p, __ATOMIC_RELAXED, __HIP_MEMORY_SCOPE_AGENT); }
__device__ __forceinline__ unsigned xb_add(unsigned* p, unsigned v) { return __hip_atomic_fetch_add(p, v, __ATOMIC_RELAXED, __HIP_MEMORY_SCOPE_AGENT); }
__device__ __forceinline__ unsigned xb_xcc_id() { return (unsigned)__builtin_amdgcn_s_getreg((3 << 11) | 20) & 0xFu; }
#define XB_SPIN(cond, bar) do { unsigned _sp = 0; while (cond) { __builtin_amdgcn_s_sleep(1); \
    if ((++_sp & 255u) == 0u) { if (xb_ld(&(bar)[XB_TMO])) break; if (_sp > XB_SPIN_CAP) { atomicAdd(&(bar)[XB_TMO], 1u); break; } } } } while (0)

struct XcdBarrier {
    unsigned* bar; unsigned x;
    volatile LAS unsigned* st;
};

__device__ __forceinline__ XcdBarrier xcd_barrier_post(unsigned* bar, volatile LAS unsigned* st) {
    XcdBarrier b; b.bar = bar; b.x = xb_xcc_id(); b.st = st;
    if (threadIdx.x == 0) (void)xb_add(&bar[XB_XCNT(b.x)], 1u);
    return b;
}
__device__ __forceinline__ void xcd_barrier_complete(unsigned* bar, unsigned x, unsigned& nloc, unsigned& nx) {
    const unsigned G = gridDim.x * gridDim.y * gridDim.z;
    unsigned sum, cnt, mine, sp = 0u;
    for (;;) {
        sum = 0u; cnt = 0u; mine = 0u;
#pragma unroll
        for (unsigned j = 0; j < 16; ++j) { const unsigned c = xb_ld(&bar[XB_XCNT(j)]); sum += c; cnt += (c > 0u) ? 1u : 0u; mine = (j == x) ? c : mine; }
        if (sum == G) break;
        __builtin_amdgcn_s_sleep(1);
        if ((++sp & 255u) == 0u) { if (xb_ld(&bar[XB_TMO])) break; if (sp > XB_SPIN_CAP) { atomicAdd(&bar[XB_TMO], 1u); break; } }
    }
    nloc = mine > 0u ? mine : 1u; nx = cnt > 0u ? cnt : 1u;
}

__device__ __forceinline__ void xcd_barrier(const XcdBarrier& b) {
    asm volatile("s_waitcnt vmcnt(0)" ::: "memory");
    __syncthreads();
    if (threadIdx.x == 0) {
        unsigned* bar = b.bar;
        __builtin_amdgcn_s_waitcnt(0);
        unsigned nloc = b.st[0], nx = b.st[1];
        if (nloc == 0u) { xcd_barrier_complete(bar, b.x, nloc, nx); b.st[0] = nloc; b.st[1] = nx; }
        const unsigned old = xb_add(&bar[XB_XSUB(b.x)], 1u);
        const unsigned gen = old / nloc;
        if (old + 1u == (gen + 1u) * nloc) {
            __builtin_amdgcn_fence(__ATOMIC_RELEASE, "agent");
            asm volatile("s_waitcnt vmcnt(0)" ::: "memory");
            const unsigned og = xb_add(&bar[XB_TOP], 1u);
            const unsigned tg = og / nx;
            if (og + 1u == (tg + 1u) * nx) xb_add(&bar[XB_TOPGEN], 1u);
            else XB_SPIN(xb_ld(&bar[XB_TOPGEN]) == tg, bar);
            __builtin_amdgcn_fence(__ATOMIC_ACQUIRE, "agent");
            xb_add(&bar[XB_XGEN(b.x)], 1u);
            asm volatile("s_waitcnt vmcnt(0)" ::: "memory");
        } else {
            XB_SPIN(xb_ld(&bar[XB_XGEN(b.x)]) == gen, bar);
            __builtin_amdgcn_fence(__ATOMIC_ACQUIRE, "agent");
            asm volatile("s_waitcnt vmcnt(0)" ::: "memory");
        }
    }
    __syncthreads();
}

__global__ void __launch_bounds__(512, 2) fwd_mega(Params P) {
    extern __shared__ __attribute__((aligned(16))) unsigned char lds_raw[];
    LAS unsigned char* lds = (LAS unsigned char*)lds_raw;
    cg::grid_group grid = cg::this_grid();
    unsigned char* ws = P.ws;
    const int G = gridDim.x, bx = blockIdx.x;
    bf16* XB = (bf16*)(ws + WS_XB); float* X = (float*)(ws + WS_X);
    bf16* Qb = (bf16*)((unsigned char*)P.out + OB_Q); bf16* ATT = (bf16*)((unsigned char*)P.out + OB_ATT);
    bf16 *KB = (bf16*)(ws + WS_KB), *VT = (bf16*)(ws + WS_VT), *XR = (bf16*)(ws + WS_XR), *GG = (bf16*)(ws + WS_GG), *SA = (bf16*)(ws + WS_SA), *SL = (bf16*)(ws + WS_SL), *H = (bf16*)(ws + WS_H);

    { unsigned* bw = (unsigned*)(ws + WS_BAR); if (bx == 0) for (int i = threadIdx.x; i < XCD_BAR_WORDS; i += 512) bw[i] = 0u;
      if (threadIdx.x < 4) ((volatile LAS unsigned*)(lds + 135168))[threadIdx.x] = 0u; }
#ifndef NO_P0
    prologue(P, lds);
    if (DUP_P0) { __syncthreads(); prologue(P, lds); }
#endif
    grid.sync();
    const XcdBarrier xbar = xcd_barrier_post((unsigned*)(ws + WS_BAR), (volatile LAS unsigned*)(lds + 135168));
    for (int l = 0; l < DEPTH; ++l) {
        {
            pg8::Gemm g{XB, (const bf16*)(ws + WS_WIN + l * SZ_WIN), MP, DIN, D}; pg8::StaticOrder S; S.init(MP, DIN, G, bx);
            EpiProj E{l, Qb, KB, VT, XR, (const float*)(ws + WS_ROPE), P.out};
#ifndef NO_G1
            pg8::gemm_phase<EpiProj, pg8::StaticOrder, true, true>(lds, g, S, E);
            if (DUP_G1) { __syncthreads(); pg8::gemm_phase<EpiProj, pg8::StaticOrder, true, true>(lds, g, S, E); }
#endif
        }
        GSYNC();
#ifndef NO_LRU0
        for (int rep = 0; rep < 1 + DUP_LRU0; ++rep) for (int it = bx; it < NTILE64 * 8; it += G) lru_tile<0>(P, lds, l, it >> 3, it & 7);
#endif
        GSYNC();
        if (DUP_ATT) { for (int it = bx; it < 772; it += G) { if (it < 516) attn_prompt_wave(P, l, it); else attn_sample_item(P, lds, l, (it - 516) >> 1, (it - 516) & 1); } __syncthreads(); }
        for (int it = bx; it < 516 + 256 + NTILE64 * 8; it += G) {
#ifndef NO_ATTP
            if (it < 516) { attn_prompt_wave(P, l, it); } else
#endif
#ifndef NO_ATTS
            if (it < 772) { attn_sample_item(P, lds, l, (it - 516) >> 1, (it - 516) & 1); } else
#endif
#ifndef NO_LRU1
            { const int j = it - 772; lru_tile<1>(P, lds, l, j >> 3, j & 7); }
#else
            {}
#endif
        }
        GSYNC();
        {
            pg8::Gemm g{ATT, (const bf16*)(ws + WS_WAP + l * SZ_WAP), MP, D, 512}; pg8::StaticOrder S; S.init(MP, D, G, bx);
            EpiGate<false> E{SA, nullptr};
#ifndef NO_G3
            pg8::gemm_phase<EpiGate<false>, pg8::StaticOrder, true, true>(lds, g, S, E);
#endif
        }
        GSYNC();
        {
            pg8::Gemm g{GG, (const bf16*)(ws + WS_WLP + l * SZ_WLP), MP, D, D}; pg8::StaticOrder S; S.init(MP, D, G, bx);
            EpiGate<true> E{SL, SA};
#ifndef NO_G4
            pg8::gemm_phase<EpiGate<true>, pg8::StaticOrder, true, true>(lds, g, S, E);
#endif
        }
        GSYNC();
        {
            pg8::Gemm g{SL, (const bf16*)(ws + WS_WOUT + l * SZ_WOUT), MP, D, D}; pg8::StaticOrder S; S.init(MP, D, G, bx);
            EpiRes E{X};
#ifndef NO_G5
            pg8::gemm_phase<EpiRes, pg8::StaticOrder, true, true>(lds, g, S, E);
#endif
        }
        GSYNC();
#ifndef NO_LN
        ln_pass<false>(P, P.in[I_L1G] + l * D, P.in[I_L1B] + l * D);
#endif
        GSYNC();
        {
            pg8::Gemm g{XB, (const bf16*)(ws + WS_WFI + l * SZ_WFI), MP, 2 * DFF, D}; pg8::StaticOrder S; S.init(MP, 2 * DFF, G, bx);
            EpiSwiglu E{H};
#ifndef NO_G6
            pg8::gemm_phase<EpiSwiglu, pg8::StaticOrder, true, true>(lds, g, S, E);
#endif
        }
        GSYNC();
        {
            pg8::Gemm g{H, (const bf16*)(ws + WS_WFO + l * SZ_WFO), MP, D, DFF}; pg8::StaticOrder S; S.init(MP, D, G, bx);
            EpiRes E{X};
#ifndef NO_G5
            pg8::gemm_phase<EpiRes, pg8::StaticOrder, true, true>(lds, g, S, E);
#endif
        }
        GSYNC();
        if (l < DEPTH - 1) { ln_pass<false>(P, P.in[I_L2G] + l * D, P.in[I_L2B] + l * D); GSYNC(); }
        else ln_pass<true>(P, P.in[I_L2G] + l * D, P.in[I_L2B] + l * D);
    }
}

extern "C" void kernel_launch(void* const* d_in, const int* in_sizes, int n_in, void* d_out, int out_size, void* d_ws, size_t ws_size, hipStream_t stream) {
    static int grid = 0;
    if (grid == 0) {
        if (n_in != 25 || (size_t)out_size != O_END || ws_size < WS_TOTAL) { fprintf(stderr, "kernel_launch: unexpected shapes (n_in %d out %d ws %zu need %zu)\n", n_in, out_size, ws_size, (size_t)WS_TOTAL); grid = -1; return; }
        int dev = 0, cus = 0, per = 0;
        if (hipGetDevice(&dev) != hipSuccess || hipDeviceGetAttribute(&cus, hipDeviceAttributeMultiprocessorCount, dev) != hipSuccess) { grid = -1; return; }
        if (hipFuncSetAttribute((const void*)fwd_mega, hipFuncAttributeMaxDynamicSharedMemorySize, LDS_BYTES) != hipSuccess) { fprintf(stderr, "hipFuncSetAttribute failed\n"); grid = -1; return; }
        if (hipOccupancyMaxActiveBlocksPerMultiprocessor(&per, (const void*)fwd_mega, 512, LDS_BYTES) != hipSuccess || per < 1) { fprintf(stderr, "occupancy query: %d\n", per); per = 1; }
        (void)hipGetLastError();
        grid = cus;
    }
    if (grid < 0) return;
    Params p{};
    for (int i = 0; i < 25; ++i) p.in[i] = (const float*)d_in[i];
    p.out = (float*)d_out; p.ws = (unsigned char*)d_ws;
    void* args[] = {&p};
    hipError_t e = hipLaunchCooperativeKernel((const void*)fwd_mega, dim3(grid), dim3(512), args, LDS_BYTES, stream);
    if (e != hipSuccess) fprintf(stderr, "cooperative launch failed: %s (grid %d)\n", hipGetErrorString(e), grid);
}
```

```cpp
#include <hip/hip_runtime.h>
#include <hip/hip_cooperative_groups.h>
#include <cstdio>
#include <cstdint>
namespace cg = cooperative_groups;
namespace pg8 {
#define PG8_LAS __attribute__((address_space(3)))
typedef unsigned short bf16_t;
typedef short bf16x8 __attribute__((ext_vector_type(8)));
typedef float f32x4 __attribute__((ext_vector_type(4)));
typedef unsigned u32x4 __attribute__((ext_vector_type(4)));
constexpr int BM = 256, BK = 64, HALF = 128, HTB = HALF * BK * 2  , STAGE_BYTES = 8 * HTB, NXCD = 8, WGM = 8;

__host__ __device__ __forceinline__ int lds_byte(int r, int c) { const int st = (r >> 4) * 2 + (c >> 5), rr = r & 15, cc = c & 31, ob = rr * 64 + cc * 2; return st * 1024 + (ob ^ (((ob >> 9) & 1) << 5)); }
__host__ __device__ __forceinline__ void stage_rc(int b, int& R, int& C) { const int st = b / 1024, sb = b % 1024, swz = sb ^ (((sb >> 9) & 1) << 5); R = (st >> 1) * 16 + swz / 64; C = (st & 1) * 32 + (swz % 64) / 2; }
__host__ __device__ __forceinline__ int perm32(int rho) { const int n = rho >> 4, i = rho & 15; return 8 * (i >> 2) + 4 * n + (i & 3); }

struct Unit { int pm, pn; };
struct Gemm { const bf16_t* A; const bf16_t* Bt; int M, N, K; };

struct StaticOrder {
    int nM, nN, nwg, G, c;
    __host__ __device__ void init(int M, int N, int G_, int c_) { nM = M / BM; nN = N / BM; nwg = nM * nN; G = G_; c = c_; }
    __host__ __device__ bool next(int i, Unit& u) const {
        const long L = (long)i * G + c; if (L >= nwg) return false;
        int wgid = (int)L; { const int q = nwg / NXCD, r = nwg % NXCD, xcd = wgid % NXCD, off = wgid / NXCD; wgid = (xcd < r ? xcd * (q + 1) : r * (q + 1) + (xcd - r) * q) + off; }
        const int nig = WGM * nN, gid = wgid / nig, fm = gid * WGM, gsz = (nM - fm) < WGM ? (nM - fm) : WGM;
        u.pm = fm + ((wgid % nig) % gsz); u.pn = (wgid % nig) / gsz; return true;
    }
    __device__ __forceinline__ void a_ready(const Unit&) const {}
    __device__ __forceinline__ void done(const Unit&) const {}
};

template <class Epi, class Sched, bool ALIGN_EPI = false, bool SP2 = false>
__device__ __forceinline__ void gemm_phase(PG8_LAS unsigned char* lds, const Gemm g, const Sched& S, const Epi& E, int tid_in) {
    int tid_ = tid_in; asm volatile("" : "+v"(tid_));
    const int tid = tid_, wid = __builtin_amdgcn_readfirstlane(tid >> 6), lane = tid & 63, wr = wid >> 2, wc = wid & 3, fr = lane & 15, fq = lane >> 4;
    const int K = g.K, nt = K / BK;
    unsigned voffA[2], voffB[2];
#pragma unroll
    for (int i = 0; i < 2; ++i) { int R, C; stage_rc(tid * 16 + i * 8192, R, C); const int Rb = Epi::PERM ? ((R & ~31) + perm32(R & 31)) : R;
        voffA[i] = (unsigned)(R * K + C) * 2u; voffB[i] = (unsigned)(Rb * K + C) * 2u; }
    const size_t kstep = (size_t)(BK * 2);
    const size_t hstep = (size_t)HALF * K * 2;
    const size_t tstep = 2 * hstep;
    const unsigned ldsw = (unsigned)wid * 1024u;
    const int aoff = lds_byte(wr * 64 + fr, fq * 8), boff = lds_byte(wc * 32 + fr, fq * 8);
#define PG8_SA(b, h) (((b) * 2 + (h)) * HTB)
#define PG8_SB(b, h) ((4 + (b) * 2 + (h)) * HTB)
#define PG8_STAGE(bufoff, gbase, voff) do { _Pragma("unroll") for (int _i = 0; _i < 2; ++_i) \
        __builtin_amdgcn_global_load_lds((const unsigned*)((const char*)(gbase) + (voff)[_i]), (PG8_LAS unsigned*)(lds + (bufoff) + ldsw + _i * 8192), 16, 0, 0); } while (0)
#define PG8_LDA(dst, b, h) do { _Pragma("unroll") for (int m = 0; m < 4; ++m) _Pragma("unroll") for (int k = 0; k < 2; ++k) dst[m][k] = *(const PG8_LAS bf16x8*)(lds + PG8_SA(b, h) + aoff + m * 2048 + k * 1024); } while (0)
#define PG8_LDB(dst, b, h) do { _Pragma("unroll") for (int n = 0; n < 2; ++n) _Pragma("unroll") for (int k = 0; k < 2; ++k) dst[n][k] = *(const PG8_LAS bf16x8*)(lds + PG8_SB(b, h) + boff + n * 2048 + k * 1024); } while (0)
#define PG8_MMA(ai, bj, At, Bt) do { __builtin_amdgcn_s_setprio(1); _Pragma("unroll") for (int m = 0; m < 4; ++m) _Pragma("unroll") for (int n = 0; n < 2; ++n) _Pragma("unroll") for (int k = 0; k < 2; ++k) \
        acc[ai][bj][m][n] = __builtin_amdgcn_mfma_f32_16x16x32_bf16(Bt[n][k], At[m][k], acc[ai][bj][m][n], 0, 0, 0); __builtin_amdgcn_s_setprio(0); } while (0)
#define PG8_WAIT_V(n) asm volatile("s_waitcnt vmcnt(" #n ")" ::: "memory")
#define PG8_WAIT_L(n) asm volatile("s_waitcnt lgkmcnt(" #n ")" ::: "memory")
#define PG8_BAR __builtin_amdgcn_s_barrier()
#define PG8_SCHED __builtin_amdgcn_sched_barrier(0)
    Unit cur, nxt; int ui = 0;
    if (!S.next(0, cur)) return;
    f32x4 acc[2][2][4][2];
#pragma unroll
    for (int a = 0; a < 2; ++a)
#pragma unroll
        for (int b = 0; b < 2; ++b)
#pragma unroll
            for (int m = 0; m < 4; ++m)
#pragma unroll
                for (int n = 0; n < 2; ++n) acc[a][b][m][n] = (f32x4){0.f, 0.f, 0.f, 0.f};
    bf16x8 At[4][2], B0[2][2], B1[2][2];
    const char* cA = (const char*)g.A + (size_t)cur.pm * tstep; const char* cB = (const char*)g.Bt + (size_t)cur.pn * tstep;
    S.a_ready(cur);
    if constexpr (SP2) {
        PG8_STAGE(PG8_SB(0, 0), cB, voffB); PG8_STAGE(PG8_SB(0, 1), cB + hstep, voffB); PG8_STAGE(PG8_SA(0, 0), cA, voffA); PG8_STAGE(PG8_SA(0, 1), cA + hstep, voffA);
        if (wr == 1) PG8_BAR;
        PG8_WAIT_V(2); PG8_BAR;
        PG8_STAGE(PG8_SB(1, 0), cB + kstep, voffB); PG8_STAGE(PG8_SA(1, 0), cA + kstep, voffA); PG8_STAGE(PG8_SB(1, 1), cB + hstep + kstep, voffB);
        PG8_WAIT_V(6); PG8_BAR;
    } else {
        PG8_STAGE(PG8_SB(0, 0), cB, voffB); PG8_STAGE(PG8_SA(0, 0), cA, voffA); PG8_STAGE(PG8_SB(0, 1), cB + hstep, voffB); PG8_STAGE(PG8_SA(0, 1), cA + hstep, voffA);
        if (wr == 1) PG8_BAR;
        PG8_WAIT_V(4); PG8_BAR;
        PG8_STAGE(PG8_SB(1, 0), cB + kstep, voffB); PG8_STAGE(PG8_SA(1, 0), cA + kstep, voffA); PG8_STAGE(PG8_SB(1, 1), cB + hstep + kstep, voffB);
        PG8_WAIT_V(6); PG8_BAR;
    }
    for (;;) {
        const bool has_next = S.next(ui + 1, nxt);
        const char* nA = has_next ? (const char*)g.A + (size_t)nxt.pm * tstep : cA; const char* nB = has_next ? (const char*)g.Bt + (size_t)nxt.pn * tstep : cB;
        for (int t = 0; t < nt; t += 2) {
            const bool last = (t == nt - 2);
            const char* a1 = cA + (size_t)(t + 1) * kstep;
            const char* a2 = last ? nA : cA + (size_t)(t + 2) * kstep; const char* b2 = last ? nB : cB + (size_t)(t + 2) * kstep;
            const char* a3 = a2 + kstep; const char* b3 = b2 + kstep;
            if (last && has_next) S.a_ready(nxt);
            if constexpr (SP2) {
            PG8_LDB(B0, 0, 0); PG8_LDB(B1, 0, 1); PG8_SCHED; PG8_LDA(At, 0, 0); PG8_STAGE(PG8_SA(1, 1), a1 + hstep, voffA);
            PG8_WAIT_V(8); PG8_WAIT_L(0); PG8_BAR; PG8_MMA(0, 0, At, B0); PG8_MMA(0, 1, At, B1); PG8_BAR; PG8_SCHED;
            PG8_LDA(At, 0, 1); PG8_STAGE(PG8_SB(0, 0), b2, voffB); PG8_STAGE(PG8_SB(0, 1), b2 + hstep, voffB); PG8_STAGE(PG8_SA(0, 0), a2, voffA);
            PG8_WAIT_V(8); PG8_WAIT_L(0); PG8_BAR; PG8_MMA(1, 0, At, B0); PG8_MMA(1, 1, At, B1); PG8_BAR; PG8_SCHED;
            PG8_LDB(B0, 1, 0); PG8_LDB(B1, 1, 1); PG8_SCHED; PG8_LDA(At, 1, 0); PG8_STAGE(PG8_SA(0, 1), a2 + hstep, voffA);
            PG8_WAIT_V(8); PG8_WAIT_L(0); PG8_BAR; PG8_MMA(0, 0, At, B0); PG8_MMA(0, 1, At, B1); PG8_BAR; PG8_SCHED;
            PG8_LDA(At, 1, 1); PG8_STAGE(PG8_SB(1, 0), b3, voffB); PG8_STAGE(PG8_SB(1, 1), b3 + hstep, voffB); PG8_STAGE(PG8_SA(1, 0), a3, voffA);
            PG8_WAIT_V(8); PG8_WAIT_L(0); PG8_BAR; PG8_MMA(1, 0, At, B0); PG8_MMA(1, 1, At, B1); PG8_BAR; PG8_SCHED;
            } else {
            PG8_LDB(B0, 0, 0); PG8_SCHED; PG8_LDA(At, 0, 0); PG8_STAGE(PG8_SA(1, 1), a1 + hstep, voffA);
            PG8_WAIT_L(8); PG8_BAR; PG8_WAIT_L(0); PG8_MMA(0, 0, At, B0); PG8_BAR; PG8_SCHED;
            PG8_LDB(B1, 0, 1); PG8_STAGE(PG8_SB(0, 0), b2, voffB);
            PG8_BAR; PG8_WAIT_L(0); PG8_MMA(0, 1, At, B1); PG8_BAR;
            PG8_LDA(At, 0, 1); PG8_STAGE(PG8_SA(0, 0), a2, voffA);
            PG8_BAR; PG8_WAIT_L(0); PG8_MMA(1, 0, At, B0); PG8_BAR; PG8_SCHED;
            PG8_STAGE(PG8_SB(0, 1), b2 + hstep, voffB);
            PG8_WAIT_V(6); PG8_BAR; PG8_MMA(1, 1, At, B1); PG8_BAR;
            PG8_LDB(B0, 1, 0); PG8_SCHED; PG8_LDA(At, 1, 0); PG8_STAGE(PG8_SA(0, 1), a2 + hstep, voffA);
            PG8_WAIT_L(8); PG8_BAR; PG8_WAIT_L(0); PG8_MMA(0, 0, At, B0); PG8_BAR; PG8_SCHED;
            PG8_LDB(B1, 1, 1); PG8_STAGE(PG8_SB(1, 0), b3, voffB);
            PG8_BAR; PG8_WAIT_L(0); PG8_MMA(0, 1, At, B1); PG8_BAR;
            PG8_LDA(At, 1, 1); PG8_STAGE(PG8_SA(1, 0), a3, voffA);
            PG8_BAR; PG8_WAIT_L(0); PG8_MMA(1, 0, At, B0); PG8_BAR; PG8_SCHED;
            PG8_STAGE(PG8_SB(1, 1), b3 + hstep, voffB);
            PG8_WAIT_V(6); PG8_BAR; PG8_MMA(1, 1, At, B1); PG8_BAR;
            }
        }
        if constexpr (ALIGN_EPI) { if (wr == 0) PG8_BAR; }
        if constexpr (!Epi::AFTER_DRAIN) { E(acc, cur, wr, wc, fr, fq); S.done(cur); }
        if (!has_next) break;
#pragma unroll
        for (int a = 0; a < 2; ++a)
#pragma unroll
            for (int b = 0; b < 2; ++b)
#pragma unroll
                for (int m = 0; m < 4; ++m)
#pragma unroll
                    for (int n = 0; n < 2; ++n) acc[a][b][m][n] = (f32x4){0.f, 0.f, 0.f, 0.f};
        cur = nxt; cA = nA; cB = nB; ++ui;
        if constexpr (ALIGN_EPI) { if (wr == 1) PG8_BAR; }
    }
    PG8_WAIT_V(0);
    if constexpr (!ALIGN_EPI) { if (wr == 0) PG8_BAR; }
    PG8_BAR;
    if constexpr (Epi::AFTER_DRAIN) { E.fused(acc, cur, wr, wc, fr, fq, lds, wid, lane); S.done(cur); }
#undef PG8_SA
#undef PG8_SB
#undef PG8_STAGE
#undef PG8_LDA
#undef PG8_LDB
#undef PG8_MMA
#undef PG8_WAIT_V
#undef PG8_WAIT_L
#undef PG8_BAR
#undef PG8_SCHED
}
}
#ifndef DUP_SYNC
#define DUP_SYNC 0
#endif
#ifndef DUP_LRU0
#define DUP_LRU0 0
#endif
#ifndef DUP_ATT
#define DUP_ATT 0
#endif
#ifndef DUP_G1
#define DUP_G1 0
#endif
#ifndef DUP_P0
#define DUP_P0 0
#endif
#define GSYNC() do { xcd_barrier(xbar, mk_tid(wv)); if (DUP_SYNC) xcd_barrier(xbar, mk_tid(wv)); } while (0)
#define LAS __attribute__((address_space(3)))
typedef unsigned short bf16;
typedef float f32x4 __attribute__((ext_vector_type(4)));
typedef float f32x16 __attribute__((ext_vector_type(16)));
typedef short bf16x8 __attribute__((ext_vector_type(8)));
typedef short s16x4 __attribute__((ext_vector_type(4)));
typedef unsigned u32x4 __attribute__((ext_vector_type(4)));
typedef unsigned u32x2 __attribute__((ext_vector_type(2)));
typedef float f32x2_t __attribute__((ext_vector_type(2)));
typedef __bf16 bf16x2_t __attribute__((ext_vector_type(2)));

constexpr int D = 1024, LP = 2064, NPT = 8 * LP  , M = NPT + 512  , MP = 17152, DIN = 4864, DFF = 2816, DEPTH = 4;
constexpr int NTILE64 = M / 64;
constexpr float ALPHA = 1.6817928305074292f;
constexpr float LN_EPS = 1e-5f;
constexpr size_t O_YP = 0, O_YS = 16777216, O_WKP = 17301504, O_WVP = 17825792, O_CVP = 18350080, O_LRP = 18448384,
                 O_WKS = 18481152, O_WVS = 26869760, O_CVS = 35258368, O_LRS = 36831232, O_END = 37355520;
constexpr size_t OB_Q = 0, OB_ATT = (size_t)MP * 512 * 2;
constexpr size_t SZ_WIN = (size_t)DIN * D * 2, SZ_WAP = (size_t)D * 512 * 2, SZ_WLP = (size_t)D * D * 2, SZ_WOUT = SZ_WLP, SZ_WFI = (size_t)2 * DFF * D * 2, SZ_WFO = (size_t)D * DFF * 2, SZ_LW = (size_t)8 * 256 * 128 * 2;
constexpr size_t WS_WIN = 0, WS_WAP = WS_WIN + 4 * SZ_WIN, WS_WLP = WS_WAP + 4 * SZ_WAP, WS_WOUT = WS_WLP + 4 * SZ_WLP, WS_WFI = WS_WOUT + 4 * SZ_WOUT, WS_WFO = WS_WFI + 4 * SZ_WFI,
                 WS_LW = WS_WFO + 4 * SZ_WFO, WS_ROPE = WS_LW + 4 * SZ_LW, WS_AGG = WS_ROPE + 1048576, WS_X = WS_AGG + 3145728, WS_XB = WS_X + (size_t)MP * D * 4,
                 WS_R = WS_XB + (size_t)MP * D * 2;
constexpr size_t WS_KB = WS_R, WS_VT = WS_KB + (size_t)MP * 128 * 2, WS_XR = WS_VT + (size_t)MP * 128 * 2, WS_GG = WS_XR + (size_t)MP * D * 2, WS_SA = WS_GG + (size_t)MP * D * 2, WS_SL = WS_SA + (size_t)MP * D * 2,
                 WS_END = WS_SL + (size_t)MP * D * 2;
constexpr size_t WS_BAR = WS_END;
constexpr size_t WS_TOTAL = WS_BAR + 16384;
constexpr size_t WS_H = WS_R;
static_assert(WS_H + (size_t)MP * DFF * 2 <= WS_END, "H overlay");
static_assert(WS_GG == WS_XR + (size_t)MP * D * 2 && WS_SA == WS_GG + (size_t)MP * D * 2 && WS_SL == WS_SA + (size_t)MP * D * 2, "XR|GG|SA|SL consecutive");
constexpr int LDS_BYTES = 147456;

struct Params { const float* in[25]; float* out; unsigned char* ws; };
enum { I_XP = 0, I_XS, I_CK, I_CV, I_SC, I_SLRU, I_META, I_WIN, I_WAP, I_WLP, I_WOUT, I_SINK, I_CW, I_CB, I_WA, I_BA, I_WX, I_BX, I_LAM, I_L1G, I_L1B, I_WFI, I_WFO, I_L2G, I_L2B };

__device__ __forceinline__ unsigned cvtpk(float lo, float hi) { f32x2_t v = {lo, hi}; bf16x2_t b = __builtin_convertvector(v, bf16x2_t); return __builtin_bit_cast(unsigned, b); }
__device__ __forceinline__ bf16 f2bf(float f) { return (bf16)(cvtpk(f, 0.f) & 0xffffu); }
__device__ __forceinline__ float bf2f(unsigned b) { return __uint_as_float(b << 16); }
__device__ __forceinline__ float bflo(unsigned w) { return __uint_as_float(w << 16); }
__device__ __forceinline__ float bfhi(unsigned w) { return __uint_as_float(w & 0xffff0000u); }
__device__ __forceinline__ float sigmoidf_(float x) { return __builtin_amdgcn_rcpf(1.f + __expf(-x)); }
__device__ __forceinline__ float gelu_tanh(float x) { return x * sigmoidf_(1.5957691216057308f * (x + 0.044715f * x * x * x)); }
__device__ __forceinline__ u32x4 pack8(f32x4 a, f32x4 b) { u32x4 w; w.x = cvtpk(a[0], a[1]); w.y = cvtpk(a[2], a[3]); w.z = cvtpk(b[0], b[1]); w.w = cvtpk(b[2], b[3]); return w; }
__device__ __forceinline__ int mk_tid(int wv) { int t = wv * 64 + (int)__builtin_amdgcn_mbcnt_hi(~0u, __builtin_amdgcn_mbcnt_lo(~0u, 0u)); asm volatile("" : "+v"(t)); return t; }
__device__ __forceinline__ int crow(int reg, int h) { return (reg & 3) + 8 * (reg >> 2) + 4 * h; }
#define MFMA32(a, b, c) __builtin_amdgcn_mfma_f32_32x32x16_bf16((a), (b), (c), 0, 0, 0)
#define LDS_WAIT() asm volatile("s_waitcnt lgkmcnt(0)" ::: "memory")

struct EpiProj {
    static constexpr bool PERM = true, AFTER_DRAIN = false;
    int l; bf16 *Q, *KB, *VT, *XR; const float* rope; float* out;
    __device__ __forceinline__ static int pos_idx(int row) { return row < NPT ? row % LP : (row < M ? LP + ((row - NPT) & 3) : 0); }
    __device__ __forceinline__ void operator()(const pg8::f32x4 (&acc)[2][2][4][2], const pg8::Unit& u, int wr, int wc, int fr, int fq) const {
        const int pn = u.pn, cl = wc * 32 + 8 * fq;
        if (pn < 3) {
#pragma unroll
            for (int ai = 0; ai < 2; ++ai)
#pragma unroll
                for (int m = 0; m < 4; ++m) {
                    const int row = u.pm * 256 + ai * 128 + wr * 64 + m * 16 + fr;
                    const int pi = pos_idx(row);
                    const int d0 = (cl & 63) >> 1;
                    const f32x4 cs0 = *(const f32x4*)(rope + (size_t)pi * 64 + d0 * 2), cs1 = *(const f32x4*)(rope + (size_t)pi * 64 + d0 * 2 + 4);
#pragma unroll
                    for (int bj = 0; bj < 2; ++bj) {
                        const f32x4 v0 = acc[ai][bj][m][0], v1 = acc[ai][bj][m][1];
                        if (pn == 2 && bj == 1) {
                            const int vc = cl;
                            const f32x4 t0 = v0 + 0.f, t1 = v1 + 0.f;
                            const u32x4 w = pack8(t0, t1);
                            bf16* vt = VT + (size_t)vc * MP + row;
                            vt[0] = (bf16)(w.x & 0xffff); vt[(size_t)MP] = (bf16)(w.x >> 16); vt[(size_t)2 * MP] = (bf16)(w.y & 0xffff); vt[(size_t)3 * MP] = (bf16)(w.y >> 16);
                            vt[(size_t)4 * MP] = (bf16)(w.z & 0xffff); vt[(size_t)5 * MP] = (bf16)(w.z >> 16); vt[(size_t)6 * MP] = (bf16)(w.w & 0xffff); vt[(size_t)7 * MP] = (bf16)(w.w >> 16);
                            float* dst = nullptr;
                            if (row < NPT) { const int t = row % LP; if (t >= LP - 128) dst = out + O_WVP + ((size_t)((l * 8 + row / LP) * 128 + (t - (LP - 128)))) * 128 + vc; }
                            else if (row < M) { const int db = (row - NPT) >> 2, s = (row - NPT) & 3; dst = out + O_WVS + ((size_t)((l * 128 + db) * 128 + 124 + s)) * 128 + vc; }
                            if (dst) { *(f32x4*)dst = t0; *(f32x4*)(dst + 4) = t1; }
                        } else {
                            f32x4 y0, y1;
                            y0[0] = v0[0] * cs0[0] - v0[1] * cs0[1]; y0[1] = v0[1] * cs0[0] + v0[0] * cs0[1];
                            y0[2] = v0[2] * cs0[2] - v0[3] * cs0[3]; y0[3] = v0[3] * cs0[2] + v0[2] * cs0[3];
                            y1[0] = v1[0] * cs1[0] - v1[1] * cs1[1]; y1[1] = v1[1] * cs1[0] + v1[0] * cs1[1];
                            y1[2] = v1[2] * cs1[2] - v1[3] * cs1[3]; y1[3] = v1[3] * cs1[2] + v1[2] * cs1[3];
                            if (pn < 2) {
                                const int col = pn * 256 + bj * 128 + cl;
                                *(u32x4*)(Q + (size_t)row * 512 + col) = pack8(y0 * 0.125f, y1 * 0.125f);
                            } else {
                                *(u32x4*)(KB + (size_t)row * 128 + cl) = pack8(y0, y1);
                                float* dst = nullptr;
                                if (row < NPT) { const int t = row % LP; if (t >= LP - 128) dst = out + O_WKP + ((size_t)((l * 8 + row / LP) * 128 + (t - (LP - 128)))) * 128; }
                                else if (row < M) { const int db = (row - NPT) >> 2, s = (row - NPT) & 3; dst = out + O_WKS + ((size_t)((l * 128 + db) * 128 + 124 + s)) * 128; }
                                if (dst) { dst += (cl & 64) + d0;
                                    dst[0] = y0[0]; dst[32] = y0[1]; dst[1] = y0[2]; dst[33] = y0[3]; dst[2] = y1[0]; dst[34] = y1[1]; dst[3] = y1[2]; dst[35] = y1[3]; }
                            }
                        }
                    }
                    asm volatile("" ::: "memory");
                }
        } else {
            const int kind = (pn - 3) >> 2;
            bf16* dstb = XR + (size_t)kind * ((size_t)MP * D);
            const int cbase = ((pn - 3) & 3) * 256 + cl;
#pragma unroll
            for (int ai = 0; ai < 2; ++ai)
#pragma unroll
                for (int m = 0; m < 4; ++m) {
                    const int row = u.pm * 256 + ai * 128 + wr * 64 + m * 16 + fr;
#pragma unroll
                    for (int bj = 0; bj < 2; ++bj) {
                        f32x4 v0 = acc[ai][bj][m][0] + 0.f, v1 = acc[ai][bj][m][1] + 0.f;
                        const int c = cbase + bj * 128;
                        if (kind == 0) {
                            float* dst = nullptr;
                            if (row < NPT) { const int t = row % LP; if (t >= LP - 3) dst = out + O_CVP + ((size_t)((l * 8 + row / LP) * 3 + (t - (LP - 3)))) * 1024 + c; }
                            else if (row < M) { const int db = (row - NPT) >> 2, s = (row - NPT) & 3; if (s >= 1) dst = out + O_CVS + ((size_t)((l * 128 + db) * 3 + (s - 1))) * 1024 + c; }
                            if (dst) { *(f32x4*)dst = v0; *(f32x4*)(dst + 4) = v1; }
                        } else if (kind == 1) {
#pragma unroll
                            for (int j = 0; j < 4; ++j) { v0[j] = gelu_tanh(v0[j]); v1[j] = gelu_tanh(v1[j]); }
                        } else {
#pragma unroll
                            for (int j = 0; j < 4; ++j) { v0[j] = sigmoidf_(v0[j]); v1[j] = sigmoidf_(v1[j]); }
                        }
                        *(u32x4*)(dstb + (size_t)row * 1024 + c) = pack8(v0, v1);
                    }
                    asm volatile("" ::: "memory");
                }
        }
    }
};
template <bool ADD> struct EpiGate {
    static constexpr bool PERM = true, AFTER_DRAIN = false;
    bf16* S; const bf16* A;
    __device__ __forceinline__ void operator()(const pg8::f32x4 (&acc)[2][2][4][2], const pg8::Unit& u, int wr, int wc, int fr, int fq) const {
#pragma unroll
        for (int ai = 0; ai < 2; ++ai)
#pragma unroll
            for (int m = 0; m < 4; ++m) {
                const int row = u.pm * 256 + ai * 128 + wr * 64 + m * 16 + fr;
#pragma unroll
                for (int bj = 0; bj < 2; ++bj) {
                    const size_t off = (size_t)row * 1024 + u.pn * 256 + bj * 128 + wc * 32 + 8 * fq;
                    const u32x4 s = *(const u32x4*)(S + off);
                    f32x4 v0 = acc[ai][bj][m][0], v1 = acc[ai][bj][m][1];
                    v0[0] *= bflo(s.x); v0[1] *= bfhi(s.x); v0[2] *= bflo(s.y); v0[3] *= bfhi(s.y); v1[0] *= bflo(s.z); v1[1] *= bfhi(s.z); v1[2] *= bflo(s.w); v1[3] *= bfhi(s.w);
                    if (ADD) { const u32x4 a = *(const u32x4*)(A + off);
                        v0[0] += bflo(a.x); v0[1] += bfhi(a.x); v0[2] += bflo(a.y); v0[3] += bfhi(a.y); v1[0] += bflo(a.z); v1[1] += bfhi(a.z); v1[2] += bflo(a.w); v1[3] += bfhi(a.w); }
                    *(u32x4*)(S + off) = pack8(v0, v1);
                }
                asm volatile("" ::: "memory");
            }
    }
};
struct EpiRes {
    static constexpr bool PERM = true, AFTER_DRAIN = false;
    float* X;
    __device__ __forceinline__ void operator()(const pg8::f32x4 (&acc)[2][2][4][2], const pg8::Unit& u, int wr, int wc, int fr, int fq) const {
#pragma unroll
        for (int ai = 0; ai < 2; ++ai)
#pragma unroll
            for (int m = 0; m < 4; ++m) {
                const int row = u.pm * 256 + ai * 128 + wr * 64 + m * 16 + fr;
#pragma unroll
                for (int bj = 0; bj < 2; ++bj) {
                    float* p = X + (size_t)row * 1024 + u.pn * 256 + bj * 128 + wc * 32 + 8 * fq;
                    const f32x4 x0 = *(const f32x4*)p, x1 = *(const f32x4*)(p + 4);
                    *(f32x4*)p = x0 * ALPHA + acc[ai][bj][m][0]; *(f32x4*)(p + 4) = x1 * ALPHA + acc[ai][bj][m][1];
                }
                asm volatile("" ::: "memory");
            }
    }
};
struct EpiSwiglu {
    static constexpr bool PERM = true, AFTER_DRAIN = false;
    bf16* H;
    __device__ __forceinline__ void operator()(const pg8::f32x4 (&acc)[2][2][4][2], const pg8::Unit& u, int wr, int wc, int fr, int fq) const {
#pragma unroll
        for (int ai = 0; ai < 2; ++ai)
#pragma unroll
            for (int m = 0; m < 4; ++m) {
                const int row = u.pm * 256 + ai * 128 + wr * 64 + m * 16 + fr;
                f32x4 h0, h1;
#pragma unroll
                for (int j = 0; j < 4; ++j) { const float a = acc[ai][0][m][0][j], b = acc[ai][0][m][1][j];
                    h0[j] = a * sigmoidf_(a) * acc[ai][1][m][0][j]; h1[j] = b * sigmoidf_(b) * acc[ai][1][m][1][j]; }
                *(u32x4*)(H + (size_t)row * DFF + u.pn * 128 + wc * 32 + 8 * fq) = pack8(h0, h1);
            }
    }
};

__device__ __forceinline__ int colmap(int mode, int n) {
    if (mode == 1) { if (n < 640) { const int p = n & 63; return (n & ~63) + (p >> 1) + ((p & 1) << 5); } return n; }
    if (mode == 2) { const int pn = n >> 8, bj = (n >> 7) & 1, j = n & 127; return bj * DFF + pn * 128 + j; }
    return n;
}
__device__ __forceinline__ void transpose_item(const float* W, int K, int N, bf16* WT, int mode, LAS float* scr, int item, int lane) {
    const int nblk = N / 32, kb = item / nblk, nb = item % nblk, k0 = 64 * kb, n0 = 32 * nb;
    const int nsrc = colmap(mode, n0 + (lane & 31));
#pragma unroll 8
    for (int i = 0; i < 32; ++i) { const int kk = 2 * i + (lane >> 5); scr[kk * 33 + (lane & 31)] = W[(size_t)(k0 + kk) * N + nsrc]; }
    LDS_WAIT();
    const int c = lane & 7;
#pragma unroll
    for (int j = 0; j < 4; ++j) { const int n = (lane >> 3) + 8 * j; const LAS float* s = scr + (8 * c) * 33 + n;
        u32x4 o; o.x = cvtpk(s[0 * 33], s[1 * 33]); o.y = cvtpk(s[2 * 33], s[3 * 33]); o.z = cvtpk(s[4 * 33], s[5 * 33]); o.w = cvtpk(s[6 * 33], s[7 * 33]);
        *(u32x4*)(WT + (size_t)(n0 + n) * K + k0 + 8 * c) = o; }
    LDS_WAIT();
}
__device__ __forceinline__ void prologue(const Params& P, LAS unsigned char* lds, int tid_in) {
    const int tid = tid_in, lane = tid & 63, wave = tid >> 6;
    const int gw = blockIdx.x * 8 + wave, NGW = gridDim.x * 8;
    LAS float* scr = (LAS float*)(lds + wave * 8704);
    unsigned char* ws = P.ws;
    constexpr int IT_IN = 16 * (DIN / 32), IT_AP = 8 * 32, IT_LP = 16 * 32, IT_OUT = 16 * 32, IT_FI = 16 * (2 * DFF / 32), IT_FO = (DFF / 64) * 32, IT_LW = 16 * 8;
    constexpr int IT_LAYER = IT_IN + IT_AP + IT_LP + IT_OUT + IT_FI + IT_FO + IT_LW;
    for (int it = gw; it < DEPTH * IT_LAYER; it += NGW) {
        const int l = it / IT_LAYER; int r = it % IT_LAYER;
        if (r < IT_IN) { transpose_item(P.in[I_WIN] + (size_t)l * D * DIN, D, DIN, (bf16*)(ws + WS_WIN + l * SZ_WIN), 1, scr, r, lane); continue; } r -= IT_IN;
        if (r < IT_AP) { transpose_item(P.in[I_WAP] + (size_t)l * 512 * D, 512, D, (bf16*)(ws + WS_WAP + l * SZ_WAP), 0, scr, r, lane); continue; } r -= IT_AP;
        if (r < IT_LP) { transpose_item(P.in[I_WLP] + (size_t)l * D * D, D, D, (bf16*)(ws + WS_WLP + l * SZ_WLP), 0, scr, r, lane); continue; } r -= IT_LP;
        if (r < IT_OUT) { transpose_item(P.in[I_WOUT] + (size_t)l * D * D, D, D, (bf16*)(ws + WS_WOUT + l * SZ_WOUT), 0, scr, r, lane); continue; } r -= IT_OUT;
        if (r < IT_FI) { transpose_item(P.in[I_WFI] + (size_t)l * D * 2 * DFF, D, 2 * DFF, (bf16*)(ws + WS_WFI + l * SZ_WFI), 2, scr, r, lane); continue; } r -= IT_FI;
        if (r < IT_FO) { transpose_item(P.in[I_WFO] + (size_t)l * DFF * D, DFF, D, (bf16*)(ws + WS_WFO + l * SZ_WFO), 0, scr, r, lane); continue; } r -= IT_FO;
        { const int mat = r >> 3, sub = r & 7, nb = mat >> 1, which = mat & 1;
          transpose_item(P.in[which ? I_WX : I_WA] + (size_t)(l * 8 + nb) * 128 * 128, 128, 128, (bf16*)(ws + WS_LW + l * SZ_LW) + (size_t)(nb * 256 + which * 128) * 128, 0, scr, sub, lane); }
    }
    float* X = (float*)(ws + WS_X); bf16* XB = (bf16*)(ws + WS_XB);
    for (int m = gw; m < MP; m += NGW) {
        const float* src = nullptr;
        if (m < NPT) { const int b = m / LP, t = m % LP; src = t < 16 ? P.in[I_META] + (size_t)t * D : P.in[I_XP] + ((size_t)b * 2048 + (t - 16)) * D; }
        else if (m < M) src = P.in[I_XS] + (size_t)(m - NPT) * D;
#pragma unroll
        for (int j = 0; j < 4; ++j) {
            f32x4 v = {0.f, 0.f, 0.f, 0.f}; if (src) v = *(const f32x4*)(src + 256 * j + 4 * lane);
            *(f32x4*)(X + (size_t)m * D + 256 * j + 4 * lane) = v;
            u32x2 w; w.x = cvtpk(v[0], v[1]); w.y = cvtpk(v[2], v[3]); *(u32x2*)(XB + (size_t)m * D + 256 * j + 4 * lane) = w;
        }
    }
    float* rope = (float*)(ws + WS_ROPE);
    for (int e = blockIdx.x * 512 + tid; e < (LP + 4) * 32; e += gridDim.x * 512) {
        const int pi = e >> 5, d = e & 31; const double pos = pi < LP ? (double)pi : (double)(8192 + pi - LP);
        const double inv = pow(10000.0, -(double)d / 32.0), ang = pos * inv;
        rope[2 * e] = (float)cos(ang); rope[2 * e + 1] = (float)sin(ang);
    }
}

template <bool FINAL> __device__ __forceinline__ void ln_pass(const Params& P, const float* g, const float* b, int tid_in) {
    const int tid = tid_in, lane = tid & 63, wave = tid >> 6, gw = blockIdx.x * 8 + wave, NGW = gridDim.x * 8;
    float* X = (float*)(P.ws + WS_X); bf16* XB = (bf16*)(P.ws + WS_XB);
    f32x4 gv[4], bv[4];
#pragma unroll
    for (int j = 0; j < 4; ++j) { gv[j] = *(const f32x4*)(g + 256 * j + 4 * lane); bv[j] = *(const f32x4*)(b + 256 * j + 4 * lane); }
    for (int m = gw; m < M; m += NGW) {
        f32x4 v[4]; float s = 0.f;
#pragma unroll
        for (int j = 0; j < 4; ++j) { v[j] = *(const f32x4*)(X + (size_t)m * D + 256 * j + 4 * lane); s += (v[j][0] + v[j][1]) + (v[j][2] + v[j][3]); }
#pragma unroll
        for (int o = 1; o < 64; o <<= 1) s += __shfl_xor(s, o);
        const float mean = s * (1.f / D); float q = 0.f;
#pragma unroll
        for (int j = 0; j < 4; ++j) { v[j] = v[j] - mean; q += (v[j][0] * v[j][0] + v[j][1] * v[j][1]) + (v[j][2] * v[j][2] + v[j][3] * v[j][3]); }
#pragma unroll
        for (int o = 1; o < 64; o <<= 1) q += __shfl_xor(q, o);
        const float rstd = 1.f / sqrtf(q * (1.f / D) + LN_EPS);
        float* yo = nullptr;
        if (FINAL) { if (m < NPT) { const int bb = m / LP, t = m % LP; if (t >= 16) yo = P.out + O_YP + ((size_t)bb * 2048 + (t - 16)) * D; } else yo = P.out + O_YS + (size_t)(m - NPT) * D; }
#pragma unroll
        for (int j = 0; j < 4; ++j) {
            const f32x4 y = v[j] * rstd * gv[j] + bv[j];
            if (FINAL) { if (yo) *(f32x4*)(yo + 256 * j + 4 * lane) = y; }
            else { *(f32x4*)(X + (size_t)m * D + 256 * j + 4 * lane) = y;
                   u32x2 w; w.x = cvtpk(y[0], y[1]); w.y = cvtpk(y[2], y[3]); *(u32x2*)(XB + (size_t)m * D + 256 * j + 4 * lane) = w; }
        }
    }
}

#define BAR_LDS() do { asm volatile("s_waitcnt lgkmcnt(0)" ::: "memory"); __builtin_amdgcn_s_barrier(); asm volatile("" ::: "memory"); } while (0)
__device__ __forceinline__ void lru_load_rows(const Params& P, int l, int tile, int r0, int c0, u32x4 (&xr)[2][4]) {
    const bf16* XR = (const bf16*)(P.ws + WS_XR);
    const bool samp = tile * 64 >= NPT;
#pragma unroll
    for (int j = 0; j < 2; ++j) {
        const int m = tile * 64 + r0 + 32 * j;
        const int pos = samp ? ((m - NPT) & 3) : (m % LP);
#pragma unroll
        for (int i = 0; i < 4; ++i) {
            u32x4 v = {0u, 0u, 0u, 0u};
            if (pos - i >= 0) v = *(const u32x4*)(XR + (size_t)(m - i) * 1024 + c0);
            else if (samp) { const float* buf = P.in[I_SC] + ((size_t)((l * 128 + ((m - NPT) >> 2)) * 3) + (3 + pos - i)) * 1024 + c0; v = pack8(*(const f32x4*)buf, *(const f32x4*)(buf + 4)); }
            xr[j][i] = v;
        }
    }
}
template <int MODE> __device__ __forceinline__ void lru_phase(const Params& P, LAS unsigned char* lds, int l, int tid_in) {
    const int tid = tid_in, lane = tid & 63, wid = tid >> 6;
    LAS bf16* xcb = (LAS bf16*)lds;
    LAS float* xcf = (LAS float*)(lds + 17408);
    LAS float* sa = (LAS float*)(lds + 17408 + 32768);
    LAS float* sb = (LAS float*)(lds + 17408 + 65536);
    LAS float* qa = (LAS float*)lds; LAS float* qb = qa + 512; LAS float* tc = qb + 512;
    const int nb = blockIdx.x & 7, tstride = gridDim.x >> 3;
    const int c8 = tid & 15, r0 = tid >> 4, c0 = nb * 128 + c8 * 8;
    LAS float* cwl = (LAS float*)(lds + 115712);
    for (int e = tid; e < 640; e += 512) { const int i = e >> 7, cc = e & 127; cwl[e] = i < 4 ? P.in[I_CW][(size_t)(l * 4 + 3 - i) * 1024 + nb * 128 + cc] : P.in[I_CB][l * 1024 + nb * 128 + cc]; }
    const int rb = wid & 1, cb = wid >> 1, l32 = lane & 31, h = lane >> 5;
    bf16x8 br[8], bi[8];
    { const bf16* LW = (const bf16*)(P.ws + WS_LW + l * SZ_LW) + (size_t)(nb * 256 + cb * 32 + l32) * 128 + h * 8;
#pragma unroll
      for (int kk = 0; kk < 8; ++kk) { br[kk] = *(const bf16x8*)(LW + kk * 16); bi[kk] = *(const bf16x8*)(LW + 128 * 128 + kk * 16); } }
    const int cgate = cb * 32 + l32;
    const float ba = P.in[I_BA][l * 1024 + nb * 128 + cgate], bx = P.in[I_BX][l * 1024 + nb * 128 + cgate];
    const float sp = log1pf(expf(-P.in[I_LAM][l * 1024 + nb * 128 + cgate]));
    const int cs = tid & 127, q = tid >> 7, cgs = nb * 128 + cs;
    float* AGG = (float*)(P.ws + WS_AGG);
    bf16* GG = (bf16*)(P.ws + WS_GG);
    u32x4 xr[2][4];
    int tile = blockIdx.x >> 3;
    BAR_LDS();
    if (tile < NTILE64) lru_load_rows(P, l, tile, r0, c0, xr);
    for (; tile < NTILE64; tile += tstride) {
        const int t0 = tile * 64; const bool samp = t0 >= NPT;
#pragma unroll
        for (int j = 0; j < 2; ++j) {
            f32x4 a0 = *(const LAS f32x4*)(cwl + 512 + c8 * 8), a1 = *(const LAS f32x4*)(cwl + 512 + c8 * 8 + 4);
#pragma unroll
            for (int i = 0; i < 4; ++i) { const u32x4 xw = xr[j][i]; f32x4 x0, x1; const f32x4 w0 = *(const LAS f32x4*)(cwl + i * 128 + c8 * 8), w1 = *(const LAS f32x4*)(cwl + i * 128 + c8 * 8 + 4);
                x0[0] = bflo(xw.x); x0[1] = bfhi(xw.x); x0[2] = bflo(xw.y); x0[3] = bfhi(xw.y); x1[0] = bflo(xw.z); x1[1] = bfhi(xw.z); x1[2] = bflo(xw.w); x1[3] = bfhi(xw.w);
                a0 += w0 * x0; a1 += w1 * x1; }
            const int r = r0 + 32 * j;
            *(LAS f32x4*)(xcf + r * 128 + c8 * 8) = a0; *(LAS f32x4*)(xcf + r * 128 + c8 * 8 + 4) = a1;
            *(LAS u32x4*)(xcb + r * 136 + c8 * 8) = pack8(a0, a1);
        }
        if (tile + tstride < NTILE64) lru_load_rows(P, l, tile + tstride, r0, c0, xr);
        u32x4 gw[2];
        float tcar = 0.f;
        if (MODE == 1) {
#pragma unroll
            for (int j = 0; j < 2; ++j) gw[j] = *(const u32x4*)(GG + (size_t)(t0 + r0 + 32 * j) * 1024 + c0);
            if (q == 0 && !samp && (t0 % LP) != 0) {
                const int j0 = (((t0 - 1) / LP) * LP) / 64;
                for (int j = j0; j < tile; ++j) tcar = AGG[(size_t)j * 2048 + cgs] * tcar + AGG[(size_t)j * 2048 + 1024 + cgs];
            }
        }
        BAR_LDS();
        {
            f32x16 ar, ai;
#pragma unroll
            for (int i = 0; i < 16; ++i) { ar[i] = 0.f; ai[i] = 0.f; }
#pragma unroll
            for (int kk = 0; kk < 8; ++kk) {
                const bf16x8 a = *(const LAS bf16x8*)(xcb + (rb * 32 + l32) * 136 + kk * 16 + h * 8);
                ar = MFMA32(a, br[kk], ar); ai = MFMA32(a, bi[kk], ai);
            }
#pragma unroll
            for (int i = 0; i < 16; ++i) {
                const int r = rb * 32 + crow(i, h);
                const float rr = sigmoidf_(ar[i] + ba), ii = sigmoidf_(ai[i] + bx);
                const float la = -8.f * rr * sp, a = __expf(la), mult = sqrtf(fmaxf(1.f - a * a, 0.f));
                sa[r * 128 + cgate] = a; sb[r * 128 + cgate] = mult * ii * xcf[r * 128 + cgate];
            }
        }
        BAR_LDS();
        {
            const int pos0 = samp ? 0 : ((t0 + 16 * q) % LP);
            float av[16], bv[16];
#pragma unroll
            for (int i = 0; i < 16; ++i) { av[i] = sa[(16 * q + i) * 128 + cs]; bv[i] = sb[(16 * q + i) * 128 + cs]; }
            float h0v[4] = {0.f, 0.f, 0.f, 0.f};
            if (samp) {
#pragma unroll
                for (int j = 0; j < 4; ++j) h0v[j] = P.in[I_SLRU][(size_t)(l * 128 + ((t0 + 16 * q - NPT) >> 2) + j) * 1024 + cgs];
            }
            const int rs = samp ? -1 : (pos0 == 0 ? 0 : (LP - pos0 < 16 ? LP - pos0 : -1));
            if (MODE == 1 && q == 0) tc[cs] = tcar;
            {
                float A = 1.f, B = 0.f;
#pragma unroll
                for (int i = 0; i < 16; ++i) {
                    const bool reset = samp ? ((i & 3) == 0) : (i == rs);
                    if (reset) { A = 0.f; B = av[i] * (samp ? h0v[i >> 2] : 0.f) + bv[i]; } else { A *= av[i]; B = av[i] * B + bv[i]; }
                }
                qa[q * 128 + cs] = A; qb[q * 128 + cs] = B;
            }
            BAR_LDS();
            if (MODE == 0) {
                if (q == 3) {
                    float A = 1.f, B = 0.f;
#pragma unroll
                    for (int j = 0; j < 4; ++j) { const float Aj = qa[j * 128 + cs], Bj = qb[j * 128 + cs]; B = Aj * B + Bj; A *= Aj; }
                    AGG[(size_t)tile * 2048 + cgs] = A; AGG[(size_t)tile * 2048 + 1024 + cgs] = B;
                }
            } else {
                float hh = tc[cs];
                for (int j = 0; j < q; ++j) hh = qa[j * 128 + cs] * hh + qb[j * 128 + cs];
#pragma unroll
                for (int i = 0; i < 16; ++i) {
                    const bool reset = samp ? ((i & 3) == 0) : (i == rs);
                    hh = reset ? av[i] * (samp ? h0v[i >> 2] : 0.f) + bv[i] : av[i] * hh + bv[i];
                    sb[(16 * q + i) * 128 + cs] = hh;
                }
                BAR_LDS();
#pragma unroll
                for (int j = 0; j < 2; ++j) {
                    const int r = r0 + 32 * j, m = t0 + r;
                    const f32x4 h0 = *(const LAS f32x4*)(sb + r * 128 + c8 * 8), h1 = *(const LAS f32x4*)(sb + r * 128 + c8 * 8 + 4);
                    f32x4 q0, q1;
                    q0[0] = h0[0] * bflo(gw[j].x); q0[1] = h0[1] * bfhi(gw[j].x); q0[2] = h0[2] * bflo(gw[j].y); q0[3] = h0[3] * bfhi(gw[j].y);
                    q1[0] = h1[0] * bflo(gw[j].z); q1[1] = h1[1] * bfhi(gw[j].z); q1[2] = h1[2] * bflo(gw[j].w); q1[3] = h1[3] * bfhi(gw[j].w);
                    *(u32x4*)(GG + (size_t)m * 1024 + c0) = pack8(q0, q1);
                    float* so = nullptr;
                    if (samp) { if ((r & 3) == 3) so = P.out + O_LRS + (size_t)(l * 128 + ((m - NPT) >> 2)) * 1024; }
                    else if (m % LP == LP - 1) so = P.out + O_LRP + (size_t)(l * 8 + m / LP) * 1024;
                    if (so) { *(f32x4*)(so + c0) = h0; *(f32x4*)(so + c0 + 4) = h1; }
                }
            }
        }
        BAR_LDS();
    }
}

__device__ __forceinline__ void attn_prompt_wave(const Params& P, int l, int qt, int tid_in) {
    const int tid = tid_in, lane = tid & 63, l32 = lane & 31, h = lane >> 5, head = tid >> 6, kvh = head >> 2;
    const bf16* Q = (const bf16*)((const unsigned char*)P.out + OB_Q); bf16* ATT = (bf16*)((unsigned char*)P.out + OB_ATT);
    const bf16* KB = (const bf16*)(P.ws + WS_KB); const bf16* VT = (const bf16*)(P.ws + WS_VT);
    const int q0 = qt * 32, key0 = q0 - 128;
    bf16x8 qf[4];
#pragma unroll
    for (int kk = 0; kk < 4; ++kk) qf[kk] = *(const bf16x8*)(Q + (size_t)(q0 + l32) * 512 + head * 64 + kk * 16 + h * 8);
    f32x16 st[5];
#pragma unroll
    for (int kb = 0; kb < 5; ++kb) {
#pragma unroll
        for (int i = 0; i < 16; ++i) st[kb][i] = 0.f;
        int krow_ = key0 + kb * 32 + l32; krow_ = krow_ < 0 ? 0 : krow_;
        const bf16* kp = KB + (size_t)krow_ * 128 + kvh * 64 + h * 8;
#pragma unroll
        for (int kk = 0; kk < 4; ++kk) { const bf16x8 kf = *(const bf16x8*)(kp + kk * 16); st[kb] = MFMA32(kf, qf[kk], st[kb]); }
    }
    const int qi = q0 + l32, bstart = (qi / LP) * LP;
    const float sink = P.in[I_SINK][l * 8 + head];
    float mx = sink;
#pragma unroll
    for (int kb = 0; kb < 5; ++kb)
#pragma unroll
        for (int i = 0; i < 16; ++i) { const int ki = key0 + kb * 32 + crow(i, h); const bool ok = ki <= qi && ki > qi - 128 && ki >= bstart;
            st[kb][i] = ok ? st[kb][i] : -1e30f; mx = fmaxf(mx, st[kb][i]); }
    mx = fmaxf(mx, __shfl_xor(mx, 32));
    float sum = 0.f;
#pragma unroll
    for (int kb = 0; kb < 5; ++kb)
#pragma unroll
        for (int i = 0; i < 16; ++i) { const float p = st[kb][i] > -1e29f ? __expf(st[kb][i] - mx) : 0.f; st[kb][i] = p; sum += p; }
    sum += __shfl_xor(sum, 32);
    const float inv = 1.f / (sum + __expf(sink - mx));
    f32x16 o0, o1;
#pragma unroll
    for (int i = 0; i < 16; ++i) { o0[i] = 0.f; o1[i] = 0.f; }
#pragma unroll
    for (int kb = 0; kb < 5; ++kb)
#pragma unroll
        for (int s = 0; s < 2; ++s) {
            u32x4 pw; pw.x = cvtpk(st[kb][8 * s], st[kb][8 * s + 1]); pw.y = cvtpk(st[kb][8 * s + 2], st[kb][8 * s + 3]); pw.z = cvtpk(st[kb][8 * s + 4], st[kb][8 * s + 5]); pw.w = cvtpk(st[kb][8 * s + 6], st[kb][8 * s + 7]);
            const bf16x8 pf = __builtin_bit_cast(bf16x8, pw);
            int k0 = key0 + kb * 32 + 16 * s + 4 * h, k1 = k0 + 8; k0 = k0 < 0 ? 0 : k0; k1 = k1 < 0 ? 0 : k1;
#pragma unroll
            for (int db = 0; db < 2; ++db) {
                const bf16* vp = VT + (size_t)(kvh * 64 + db * 32 + l32) * MP;
                const u32x2 va = *(const u32x2*)(vp + k0), vb = *(const u32x2*)(vp + k1);
                u32x4 vw; vw.x = va.x; vw.y = va.y; vw.z = vb.x; vw.w = vb.y;
                const bf16x8 vf = __builtin_bit_cast(bf16x8, vw);
                if (db == 0) o0 = MFMA32(vf, pf, o0); else o1 = MFMA32(vf, pf, o1);
            }
        }
    bf16* op = ATT + (size_t)qi * 512 + head * 64 + 4 * h;
#pragma unroll
    for (int g = 0; g < 4; ++g) {
        u32x2 w; w.x = cvtpk(o0[4 * g] * inv, o0[4 * g + 1] * inv); w.y = cvtpk(o0[4 * g + 2] * inv, o0[4 * g + 3] * inv); *(u32x2*)(op + 8 * g) = w;
        u32x2 w2; w2.x = cvtpk(o1[4 * g] * inv, o1[4 * g + 1] * inv); w2.y = cvtpk(o1[4 * g + 2] * inv, o1[4 * g + 3] * inv); *(u32x2*)(op + 32 + 8 * g) = w2;
    }
}

__device__ __forceinline__ void attn_sample_item(const Params& P, LAS unsigned char* lds, int l, int db, int kvh, int tid_in) {
    const int tid = tid_in, lane = tid & 63, wid = tid >> 6;
    LAS float* Ks = (LAS float*)lds;
    LAS float* Vs = Ks + 132 * 65;
    LAS float* qs = Vs + 132 * 64;
    LAS float* S = qs + 16 * 64;
    const bf16* Q = (const bf16*)((const unsigned char*)P.out + OB_Q); bf16* ATT = (bf16*)((unsigned char*)P.out + OB_ATT);
    const size_t cbase = (size_t)(l * 128 + db) * 128;
#pragma unroll
    for (int k = 0; k < 5; ++k) {
        const int e = tid + 512 * k;
        if (e < 132 * 16) {
            const int key = e >> 4, d4 = (e & 15) * 4;
            f32x4 kv, vv;
            if (key < 128) { kv = *(const f32x4*)(P.in[I_CK] + ((cbase + key) * 2 + kvh) * 64 + d4); vv = *(const f32x4*)(P.in[I_CV] + ((cbase + key) * 2 + kvh) * 64 + d4); }
            else { kv = *(const f32x4*)(P.out + O_WKS + ((cbase + key - 4) * 2 + kvh) * 64 + d4); vv = *(const f32x4*)(P.out + O_WVS + ((cbase + key - 4) * 2 + kvh) * 64 + d4); }
            Ks[key * 65 + d4] = kv[0]; Ks[key * 65 + d4 + 1] = kv[1]; Ks[key * 65 + d4 + 2] = kv[2]; Ks[key * 65 + d4 + 3] = kv[3];
            *(LAS f32x4*)(Vs + key * 64 + d4) = vv;
            if (key >= 4 && key < 128) { *(f32x4*)(P.out + O_WKS + ((cbase + key - 4) * 2 + kvh) * 64 + d4) = kv; *(f32x4*)(P.out + O_WVS + ((cbase + key - 4) * 2 + kvh) * 64 + d4) = vv; }
        }
    }
    for (int e = tid; e < 16 * 64; e += 512) {
        const int row = e >> 6, d = e & 63, g = row >> 2, s = row & 3, p = d < 32 ? 2 * d : 2 * (d - 32) + 1;
        qs[e] = bf2f(Q[(size_t)(NPT + db * 4 + s) * 512 + (kvh * 4 + g) * 64 + p]);
    }
    __syncthreads();
    for (int e = tid; e < 16 * 132; e += 512) {
        const int row = e / 132, key = e % 132, s = row & 3;
        float acc = 0.f;
#pragma unroll 16
        for (int d = 0; d < 64; ++d) acc += qs[row * 64 + d] * Ks[key * 65 + d];
        const bool ok = key < 128 ? key > s : (key - 128) <= s;
        S[e] = ok ? acc : -1e30f;
    }
    __syncthreads();
    for (int rr = 0; rr < 2; ++rr) {
        const int row = wid * 2 + rr, g = row >> 2; const float sink = P.in[I_SINK][l * 8 + kvh * 4 + g];
        float v0 = S[row * 132 + lane], v1 = S[row * 132 + 64 + lane], v2 = lane < 4 ? S[row * 132 + 128 + lane] : -1e30f;
        float mx = fmaxf(fmaxf(v0, v1), fmaxf(v2, sink));
#pragma unroll
        for (int o = 1; o < 64; o <<= 1) mx = fmaxf(mx, __shfl_xor(mx, o));
        const float p0 = v0 > -1e29f ? __expf(v0 - mx) : 0.f, p1 = v1 > -1e29f ? __expf(v1 - mx) : 0.f, p2 = v2 > -1e29f ? __expf(v2 - mx) : 0.f;
        float sum = p0 + p1 + p2;
#pragma unroll
        for (int o = 1; o < 64; o <<= 1) sum += __shfl_xor(sum, o);
        const float inv = 1.f / (sum + __expf(sink - mx));
        S[row * 132 + lane] = p0 * inv; S[row * 132 + 64 + lane] = p1 * inv; if (lane < 4) S[row * 132 + 128 + lane] = p2 * inv;
    }
    __syncthreads();
    for (int e = tid; e < 16 * 64; e += 512) {
        const int row = e >> 6, d = e & 63, g = row >> 2, s = row & 3;
        float acc = 0.f;
#pragma unroll 4
        for (int key = 0; key < 132; ++key) acc += S[row * 132 + key] * Vs[key * 64 + d];
        ATT[(size_t)(NPT + db * 4 + s) * 512 + (kvh * 4 + g) * 64 + d] = f2bf(acc);
    }
    __syncthreads();
}

#define XB_TMO      128
#define XB_XCNT(j)  (256  + 64 * (j))
#define XB_XSUB(j)  (1280 + 64 * (j))
#define XB_XGEN(j)  (2304 + 64 * (j))
#define XB_TOP      3328
#define XB_TOPGEN   3392
#define XCD_BAR_WORDS 3456
#define XB_SPIN_CAP (1u << 18)

__device__ __forceinline__ unsigned xb_ld(unsigned* p)              { return __hip_atomic_load(p, __ATOMIC_RELAXED, __HIP_MEMORY_SCOPE_AGENT); }
__device__ __forceinline__ unsigned xb_add(unsigned* p, unsigned v) { return __hip_atomic_fetch_add(p, v, __ATOMIC_RELAXED, __HIP_MEMORY_SCOPE_AGENT); }
__device__ __forceinline__ unsigned xb_xcc_id() { return (unsigned)__builtin_amdgcn_s_getreg((3 << 11) | 20) & 0xFu; }
#define XB_SPIN(cond, bar) do { unsigned _sp = 0; while (cond) { __builtin_amdgcn_s_sleep(1); \
    if ((++_sp & 255u) == 0u) { if (xb_ld(&(bar)[XB_TMO])) break; if (_sp > XB_SPIN_CAP) { atomicAdd(&(bar)[XB_TMO], 1u); break; } } } } while (0)

struct XcdBarrier {
    unsigned* bar; unsigned x;
    volatile LAS unsigned* st;
};

__device__ __forceinline__ XcdBarrier xcd_barrier_post(unsigned* bar, volatile LAS unsigned* st, int xb_tid) {
    XcdBarrier b; b.bar = bar; b.x = xb_xcc_id(); b.st = st;
    if (xb_tid == 0) (void)xb_add(&bar[XB_XCNT(b.x)], 1u);
    return b;
}
__device__ __forceinline__ void xcd_barrier_complete(unsigned* bar, unsigned x, unsigned& nloc, unsigned& nx) {
    const unsigned G = gridDim.x * gridDim.y * gridDim.z;
    unsigned sum, cnt, mine, sp = 0u;
    for (;;) {
        sum = 0u; cnt = 0u; mine = 0u;
#pragma unroll
        for (unsigned j = 0; j < 16; ++j) { const unsigned c = xb_ld(&bar[XB_XCNT(j)]); sum += c; cnt += (c > 0u) ? 1u : 0u; mine = (j == x) ? c : mine; }
        if (sum == G) break;
        __builtin_amdgcn_s_sleep(1);
        if ((++sp & 255u) == 0u) { if (xb_ld(&bar[XB_TMO])) break; if (sp > XB_SPIN_CAP) { atomicAdd(&bar[XB_TMO], 1u); break; } }
    }
    nloc = mine > 0u ? mine : 1u; nx = cnt > 0u ? cnt : 1u;
}

__device__ __forceinline__ void xcd_barrier(const XcdBarrier& b, int xb_tid) {
    asm volatile("s_waitcnt vmcnt(0)" ::: "memory");
    __syncthreads();
    if (xb_tid == 0) {
        unsigned* bar = b.bar;
        __builtin_amdgcn_s_waitcnt(0);
        unsigned nloc = b.st[0], nx = b.st[1];
        if (nloc == 0u) { xcd_barrier_complete(bar, b.x, nloc, nx); b.st[0] = nloc; b.st[1] = nx; }
        const unsigned old = xb_add(&bar[XB_XSUB(b.x)], 1u);
        const unsigned gen = old / nloc;
        if (old + 1u == (gen + 1u) * nloc) {
            __builtin_amdgcn_fence(__ATOMIC_RELEASE, "agent");
            asm volatile("s_waitcnt vmcnt(0)" ::: "memory");
            const unsigned og = xb_add(&bar[XB_TOP], 1u);
            const unsigned tg = og / nx;
            if (og + 1u == (tg + 1u) * nx) xb_add(&bar[XB_TOPGEN], 1u);
            else XB_SPIN(xb_ld(&bar[XB_TOPGEN]) == tg, bar);
            __builtin_amdgcn_fence(__ATOMIC_ACQUIRE, "agent");
            xb_add(&bar[XB_XGEN(b.x)], 1u);
            asm volatile("s_waitcnt vmcnt(0)" ::: "memory");
        } else {
            XB_SPIN(xb_ld(&bar[XB_XGEN(b.x)]) == gen, bar);
            __builtin_amdgcn_fence(__ATOMIC_ACQUIRE, "agent");
            asm volatile("s_waitcnt vmcnt(0)" ::: "memory");
        }
    }
    __syncthreads();
}

__global__ void __launch_bounds__(512, 2) fwd_mega(Params P) {
    extern __shared__ __attribute__((aligned(16))) unsigned char lds_raw[];
    LAS unsigned char* lds = (LAS unsigned char*)lds_raw;
    cg::grid_group grid = cg::this_grid();
    unsigned char* ws = P.ws;
    const int G = gridDim.x, bx = blockIdx.x;
    const int wv = __builtin_amdgcn_readfirstlane((int)(threadIdx.x >> 6));
    bf16* XB = (bf16*)(ws + WS_XB); float* X = (float*)(ws + WS_X);
    bf16* Qb = (bf16*)((unsigned char*)P.out + OB_Q); bf16* ATT = (bf16*)((unsigned char*)P.out + OB_ATT);
    bf16 *KB = (bf16*)(ws + WS_KB), *VT = (bf16*)(ws + WS_VT), *XR = (bf16*)(ws + WS_XR), *GG = (bf16*)(ws + WS_GG), *SA = (bf16*)(ws + WS_SA), *SL = (bf16*)(ws + WS_SL), *H = (bf16*)(ws + WS_H);

    { unsigned* bw = (unsigned*)(ws + WS_BAR); if (bx == 0) for (int i = threadIdx.x; i < XCD_BAR_WORDS; i += 512) bw[i] = 0u;
      if (threadIdx.x < 4) ((volatile LAS unsigned*)(lds + 135168))[threadIdx.x] = 0u; }
#ifndef NO_P0
    prologue(P, lds, mk_tid(wv));
    if (DUP_P0) { __syncthreads(); prologue(P, lds, mk_tid(wv)); }
#endif
    grid.sync();
    const XcdBarrier xbar = xcd_barrier_post((unsigned*)(ws + WS_BAR), (volatile LAS unsigned*)(lds + 135168), mk_tid(wv));
    for (int l = 0; l < DEPTH; ++l) {
        {
            pg8::Gemm g{XB, (const bf16*)(ws + WS_WIN + l * SZ_WIN), MP, DIN, D}; pg8::StaticOrder S; S.init(MP, DIN, G, bx);
            EpiProj E{l, Qb, KB, VT, XR, (const float*)(ws + WS_ROPE), P.out};
#ifndef NO_G1
            pg8::gemm_phase<EpiProj, pg8::StaticOrder, true, true>(lds, g, S, E, mk_tid(wv));
            if (DUP_G1) { __syncthreads(); pg8::gemm_phase<EpiProj, pg8::StaticOrder, true, true>(lds, g, S, E, mk_tid(wv)); }
#endif
        }
        GSYNC();
#ifndef NO_LRU0
        for (int rep = 0; rep < 1 + DUP_LRU0; ++rep) lru_phase<0>(P, lds, l, mk_tid(wv));
#endif
        GSYNC();
        if (DUP_ATT) { for (int it = bx; it < 772; it += G) { if (it < 516) attn_prompt_wave(P, l, it, mk_tid(wv)); else attn_sample_item(P, lds, l, (it - 516) >> 1, (it - 516) & 1, mk_tid(wv)); } __syncthreads(); }
        for (int it = bx; it < 772; it += G) { if (it < 516) attn_prompt_wave(P, l, it, mk_tid(wv)); else attn_sample_item(P, lds, l, (it - 516) >> 1, (it - 516) & 1, mk_tid(wv)); }
        __syncthreads();
#ifndef NO_LRU1
        lru_phase<1>(P, lds, l, mk_tid(wv));
#endif
        GSYNC();
        {
            pg8::Gemm g{ATT, (const bf16*)(ws + WS_WAP + l * SZ_WAP), MP, D, 512}; pg8::StaticOrder S; S.init(MP, D, G, bx);
            EpiGate<false> E{SA, nullptr};
#ifndef NO_G3
            pg8::gemm_phase<EpiGate<false>, pg8::StaticOrder, true, true>(lds, g, S, E, mk_tid(wv));
#endif
        }
        GSYNC();
        {
            pg8::Gemm g{GG, (const bf16*)(ws + WS_WLP + l * SZ_WLP), MP, D, D}; pg8::StaticOrder S; S.init(MP, D, G, bx);
            EpiGate<true> E{SL, SA};
#ifndef NO_G4
            pg8::gemm_phase<EpiGate<true>, pg8::StaticOrder, true, true>(lds, g, S, E, mk_tid(wv));
#endif
        }
        GSYNC();
        {
            pg8::Gemm g{SL, (const bf16*)(ws + WS_WOUT + l * SZ_WOUT), MP, D, D}; pg8::StaticOrder S; S.init(MP, D, G, bx);
            EpiRes E{X};
#ifndef NO_G5
            pg8::gemm_phase<EpiRes, pg8::StaticOrder, true, true>(lds, g, S, E, mk_tid(wv));
#endif
        }
        GSYNC();
#ifndef NO_LN
        ln_pass<false>(P, P.in[I_L1G] + l * D, P.in[I_L1B] + l * D, mk_tid(wv));
#endif
        GSYNC();
        {
            pg8::Gemm g{XB, (const bf16*)(ws + WS_WFI + l * SZ_WFI), MP, 2 * DFF, D}; pg8::StaticOrder S; S.init(MP, 2 * DFF, G, bx);
            EpiSwiglu E{H};
#ifndef NO_G6
            pg8::gemm_phase<EpiSwiglu, pg8::StaticOrder, true, true>(lds, g, S, E, mk_tid(wv));
#endif
        }
        GSYNC();
        {
            pg8::Gemm g{H, (const bf16*)(ws + WS_WFO + l * SZ_WFO), MP, D, DFF}; pg8::StaticOrder S; S.init(MP, D, G, bx);
            EpiRes E{X};
#ifndef NO_G5
            pg8::gemm_phase<EpiRes, pg8::StaticOrder, true, true>(lds, g, S, E, mk_tid(wv));
#endif
        }
        GSYNC();
        if (l < DEPTH - 1) { ln_pass<false>(P, P.in[I_L2G] + l * D, P.in[I_L2B] + l * D, mk_tid(wv)); GSYNC(); }
        else ln_pass<true>(P, P.in[I_L2G] + l * D, P.in[I_L2B] + l * D, mk_tid(wv));
    }
}

extern "C" void kernel_launch(void* const* d_in, const int* in_sizes, int n_in, void* d_out, int out_size, void* d_ws, size_t ws_size, hipStream_t stream) {
    static int grid = 0;
    if (grid == 0) {
        if (n_in != 25 || (size_t)out_size != O_END || ws_size < WS_TOTAL) { fprintf(stderr, "kernel_launch: unexpected shapes (n_in %d out %d ws %zu need %zu)\n", n_in, out_size, ws_size, (size_t)WS_TOTAL); grid = -1; return; }
        int dev = 0, cus = 0, per = 0;
        if (hipGetDevice(&dev) != hipSuccess || hipDeviceGetAttribute(&cus, hipDeviceAttributeMultiprocessorCount, dev) != hipSuccess) { grid = -1; return; }
        if (hipFuncSetAttribute((const void*)fwd_mega, hipFuncAttributeMaxDynamicSharedMemorySize, LDS_BYTES) != hipSuccess) { fprintf(stderr, "hipFuncSetAttribute failed\n"); grid = -1; return; }
        if (hipOccupancyMaxActiveBlocksPerMultiprocessor(&per, (const void*)fwd_mega, 512, LDS_BYTES) != hipSuccess || per < 1) { fprintf(stderr, "occupancy query: %d\n", per); per = 1; }
        (void)hipGetLastError();
        grid = cus;
    }
    if (grid < 0) return;
    Params p{};
    for (int i = 0; i < 25; ++i) p.in[i] = (const float*)d_in[i];
    p.out = (float*)d_out; p.ws = (unsigned char*)d_ws;
    void* args[] = {&p};
    hipError_t e = hipLaunchCooperativeKernel((const void*)fwd_mega, dim3(grid), dim3(512), args, LDS_BYTES, stream);
    if (e != hipSuccess) fprintf(stderr, "cooperative launch failed: %s (grid %d)\n", hipGetErrorString(e), grid);
}
```

```cpp
#include <hip/hip_runtime.h>
#include <hip/hip_cooperative_groups.h>
#include <cstdio>
#include <cstdint>
namespace cg = cooperative_groups;
namespace pg8 {
#define PG8_LAS __attribute__((address_space(3)))
typedef unsigned short bf16_t;
typedef short bf16x8 __attribute__((ext_vector_type(8)));
typedef float f32x4 __attribute__((ext_vector_type(4)));
typedef unsigned u32x4 __attribute__((ext_vector_type(4)));
constexpr int BM = 256, BK = 64, HALF = 128, HTB = HALF * BK * 2  , STAGE_BYTES = 8 * HTB, NXCD = 8, WGM = 8;

__host__ __device__ __forceinline__ int lds_byte(int r, int c) { const int st = (r >> 4) * 2 + (c >> 5), rr = r & 15, cc = c & 31, ob = rr * 64 + cc * 2; return st * 1024 + (ob ^ (((ob >> 9) & 1) << 5)); }
__host__ __device__ __forceinline__ void stage_rc(int b, int& R, int& C) { const int st = b / 1024, sb = b % 1024, swz = sb ^ (((sb >> 9) & 1) << 5); R = (st >> 1) * 16 + swz / 64; C = (st & 1) * 32 + (swz % 64) / 2; }
__host__ __device__ __forceinline__ int perm32(int rho) { const int n = rho >> 4, i = rho & 15; return 8 * (i >> 2) + 4 * n + (i & 3); }

struct Unit { int pm, pn; };
struct Gemm { const bf16_t* A; const bf16_t* Bt; int M, N, K; };

struct StaticOrder {
    int nM, nN, nwg, G, c;
    __host__ __device__ void init(int M, int N, int G_, int c_) { nM = M / BM; nN = N / BM; nwg = nM * nN; G = G_; c = c_; }
    __host__ __device__ bool next(int i, Unit& u) const {
        const long L = (long)i * G + c; if (L >= nwg) return false;
        int wgid = (int)L; { const int q = nwg / NXCD, r = nwg % NXCD, xcd = wgid % NXCD, off = wgid / NXCD; wgid = (xcd < r ? xcd * (q + 1) : r * (q + 1) + (xcd - r) * q) + off; }
        const int nig = WGM * nN, gid = wgid / nig, fm = gid * WGM, gsz = (nM - fm) < WGM ? (nM - fm) : WGM;
        u.pm = fm + ((wgid % nig) % gsz); u.pn = (wgid % nig) / gsz; return true;
    }
    __device__ __forceinline__ void a_ready(const Unit&) const {}
    __device__ __forceinline__ void done(const Unit&) const {}
};

template <class Epi, class Sched, bool ALIGN_EPI = false, bool SP2 = false>
__device__ __forceinline__ void gemm_phase(PG8_LAS unsigned char* lds, const Gemm g, const Sched& S, const Epi& E, int tid_in) {
    int tid_ = tid_in; asm volatile("" : "+v"(tid_));
    const int tid = tid_, wid = __builtin_amdgcn_readfirstlane(tid >> 6), lane = tid & 63, wr = wid >> 2, wc = wid & 3, fr = lane & 15, fq = lane >> 4;
    const int K = g.K, nt = K / BK;
    unsigned voffA[2], voffB[2];
#pragma unroll
    for (int i = 0; i < 2; ++i) { int R, C; stage_rc(tid * 16 + i * 8192, R, C); const int Rb = Epi::PERM ? ((R & ~31) + perm32(R & 31)) : R;
        voffA[i] = (unsigned)(R * K + C) * 2u; voffB[i] = (unsigned)(Rb * K + C) * 2u; }
    const size_t kstep = (size_t)(BK * 2);
    const size_t hstep = (size_t)HALF * K * 2;
    const size_t tstep = 2 * hstep;
    const unsigned ldsw = (unsigned)wid * 1024u;
    const int aoff = lds_byte(wr * 64 + fr, fq * 8), boff = lds_byte(wc * 32 + fr, fq * 8);
#define PG8_SA(b, h) (((b) * 2 + (h)) * HTB)
#define PG8_SB(b, h) ((4 + (b) * 2 + (h)) * HTB)
#define PG8_STAGE(bufoff, gbase, voff) do { _Pragma("unroll") for (int _i = 0; _i < 2; ++_i) \
        __builtin_amdgcn_global_load_lds((const unsigned*)((const char*)(gbase) + (voff)[_i]), (PG8_LAS unsigned*)(lds + (bufoff) + ldsw + _i * 8192), 16, 0, 0); } while (0)
#define PG8_LDA(dst, b, h) do { _Pragma("unroll") for (int m = 0; m < 4; ++m) _Pragma("unroll") for (int k = 0; k < 2; ++k) dst[m][k] = *(const PG8_LAS bf16x8*)(lds + PG8_SA(b, h) + aoff + m * 2048 + k * 1024); } while (0)
#define PG8_LDB(dst, b, h) do { _Pragma("unroll") for (int n = 0; n < 2; ++n) _Pragma("unroll") for (int k = 0; k < 2; ++k) dst[n][k] = *(const PG8_LAS bf16x8*)(lds + PG8_SB(b, h) + boff + n * 2048 + k * 1024); } while (0)
#define PG8_MMA(ai, bj, At, Bt) do { __builtin_amdgcn_s_setprio(1); _Pragma("unroll") for (int m = 0; m < 4; ++m) _Pragma("unroll") for (int n = 0; n < 2; ++n) _Pragma("unroll") for (int k = 0; k < 2; ++k) \
        acc[ai][bj][m][n] = __builtin_amdgcn_mfma_f32_16x16x32_bf16(Bt[n][k], At[m][k], acc[ai][bj][m][n], 0, 0, 0); __builtin_amdgcn_s_setprio(0); } while (0)
#define PG8_WAIT_V(n) asm volatile("s_waitcnt vmcnt(" #n ")" ::: "memory")
#define PG8_WAIT_L(n) asm volatile("s_waitcnt lgkmcnt(" #n ")" ::: "memory")
#define PG8_BAR __builtin_amdgcn_s_barrier()
#define PG8_SCHED __builtin_amdgcn_sched_barrier(0)
    Unit cur, nxt; int ui = 0;
    if (!S.next(0, cur)) return;
    f32x4 acc[2][2][4][2];
#pragma unroll
    for (int a = 0; a < 2; ++a)
#pragma unroll
        for (int b = 0; b < 2; ++b)
#pragma unroll
            for (int m = 0; m < 4; ++m)
#pragma unroll
                for (int n = 0; n < 2; ++n) acc[a][b][m][n] = (f32x4){0.f, 0.f, 0.f, 0.f};
    bf16x8 At[4][2], B0[2][2], B1[2][2];
    const char* cA = (const char*)g.A + (size_t)cur.pm * tstep; const char* cB = (const char*)g.Bt + (size_t)cur.pn * tstep;
    S.a_ready(cur);
    if constexpr (SP2) {
        PG8_STAGE(PG8_SB(0, 0), cB, voffB); PG8_STAGE(PG8_SB(0, 1), cB + hstep, voffB); PG8_STAGE(PG8_SA(0, 0), cA, voffA); PG8_STAGE(PG8_SA(0, 1), cA + hstep, voffA);
        if (wr == 1) PG8_BAR;
        PG8_WAIT_V(2); PG8_BAR;
        PG8_STAGE(PG8_SB(1, 0), cB + kstep, voffB); PG8_STAGE(PG8_SA(1, 0), cA + kstep, voffA); PG8_STAGE(PG8_SB(1, 1), cB + hstep + kstep, voffB);
        PG8_WAIT_V(6); PG8_BAR;
    } else {
        PG8_STAGE(PG8_SB(0, 0), cB, voffB); PG8_STAGE(PG8_SA(0, 0), cA, voffA); PG8_STAGE(PG8_SB(0, 1), cB + hstep, voffB); PG8_STAGE(PG8_SA(0, 1), cA + hstep, voffA);
        if (wr == 1) PG8_BAR;
        PG8_WAIT_V(4); PG8_BAR;
        PG8_STAGE(PG8_SB(1, 0), cB + kstep, voffB); PG8_STAGE(PG8_SA(1, 0), cA + kstep, voffA); PG8_STAGE(PG8_SB(1, 1), cB + hstep + kstep, voffB);
        PG8_WAIT_V(6); PG8_BAR;
    }
    for (;;) {
        const bool has_next = S.next(ui + 1, nxt);
        const char* nA = has_next ? (const char*)g.A + (size_t)nxt.pm * tstep : cA; const char* nB = has_next ? (const char*)g.Bt + (size_t)nxt.pn * tstep : cB;
        for (int t = 0; t < nt; t += 2) {
            const bool last = (t == nt - 2);
            const char* a1 = cA + (size_t)(t + 1) * kstep;
            const char* a2 = last ? nA : cA + (size_t)(t + 2) * kstep; const char* b2 = last ? nB : cB + (size_t)(t + 2) * kstep;
            const char* a3 = a2 + kstep; const char* b3 = b2 + kstep;
            if (last && has_next) S.a_ready(nxt);
            if constexpr (SP2) {
            PG8_LDB(B0, 0, 0); PG8_LDB(B1, 0, 1); PG8_SCHED; PG8_LDA(At, 0, 0); PG8_STAGE(PG8_SA(1, 1), a1 + hstep, voffA);
            PG8_WAIT_V(8); PG8_WAIT_L(0); PG8_BAR; PG8_MMA(0, 0, At, B0); PG8_MMA(0, 1, At, B1); PG8_BAR; PG8_SCHED;
            PG8_LDA(At, 0, 1); PG8_STAGE(PG8_SB(0, 0), b2, voffB); PG8_STAGE(PG8_SB(0, 1), b2 + hstep, voffB); PG8_STAGE(PG8_SA(0, 0), a2, voffA);
            PG8_WAIT_V(8); PG8_WAIT_L(0); PG8_BAR; PG8_MMA(1, 0, At, B0); PG8_MMA(1, 1, At, B1); PG8_BAR; PG8_SCHED;
            PG8_LDB(B0, 1, 0); PG8_LDB(B1, 1, 1); PG8_SCHED; PG8_LDA(At, 1, 0); PG8_STAGE(PG8_SA(0, 1), a2 + hstep, voffA);
            PG8_WAIT_V(8); PG8_WAIT_L(0); PG8_BAR; PG8_MMA(0, 0, At, B0); PG8_MMA(0, 1, At, B1); PG8_BAR; PG8_SCHED;
            PG8_LDA(At, 1, 1); PG8_STAGE(PG8_SB(1, 0), b3, voffB); PG8_STAGE(PG8_SB(1, 1), b3 + hstep, voffB); PG8_STAGE(PG8_SA(1, 0), a3, voffA);
            PG8_WAIT_V(8); PG8_WAIT_L(0); PG8_BAR; PG8_MMA(1, 0, At, B0); PG8_MMA(1, 1, At, B1); PG8_BAR; PG8_SCHED;
            } else {
            PG8_LDB(B0, 0, 0); PG8_SCHED; PG8_LDA(At, 0, 0); PG8_STAGE(PG8_SA(1, 1), a1 + hstep, voffA);
            PG8_WAIT_L(8); PG8_BAR; PG8_WAIT_L(0); PG8_MMA(0, 0, At, B0); PG8_BAR; PG8_SCHED;
            PG8_LDB(B1, 0, 1); PG8_STAGE(PG8_SB(0, 0), b2, voffB);
            PG8_BAR; PG8_WAIT_L(0); PG8_MMA(0, 1, At, B1); PG8_BAR;
            PG8_LDA(At, 0, 1); PG8_STAGE(PG8_SA(0, 0), a2, voffA);
            PG8_BAR; PG8_WAIT_L(0); PG8_MMA(1, 0, At, B0); PG8_BAR; PG8_SCHED;
            PG8_STAGE(PG8_SB(0, 1), b2 + hstep, voffB);
            PG8_WAIT_V(6); PG8_BAR; PG8_MMA(1, 1, At, B1); PG8_BAR;
            PG8_LDB(B0, 1, 0); PG8_SCHED; PG8_LDA(At, 1, 0); PG8_STAGE(PG8_SA(0, 1), a2 + hstep, voffA);
            PG8_WAIT_L(8); PG8_BAR; PG8_WAIT_L(0); PG8_MMA(0, 0, At, B0); PG8_BAR; PG8_SCHED;
            PG8_LDB(B1, 1, 1); PG8_STAGE(PG8_SB(1, 0), b3, voffB);
            PG8_BAR; PG8_WAIT_L(0); PG8_MMA(0, 1, At, B1); PG8_BAR;
            PG8_LDA(At, 1, 1); PG8_STAGE(PG8_SA(1, 0), a3, voffA);
            PG8_BAR; PG8_WAIT_L(0); PG8_MMA(1, 0, At, B0); PG8_BAR; PG8_SCHED;
            PG8_STAGE(PG8_SB(1, 1), b3 + hstep, voffB);
            PG8_WAIT_V(6); PG8_BAR; PG8_MMA(1, 1, At, B1); PG8_BAR;
            }
        }
        if constexpr (ALIGN_EPI) { if (wr == 0) PG8_BAR; }
        if constexpr (!Epi::AFTER_DRAIN) { E(acc, cur, wr, wc, fr, fq); S.done(cur); }
        if (!has_next) break;
#pragma unroll
        for (int a = 0; a < 2; ++a)
#pragma unroll
            for (int b = 0; b < 2; ++b)
#pragma unroll
                for (int m = 0; m < 4; ++m)
#pragma unroll
                    for (int n = 0; n < 2; ++n) acc[a][b][m][n] = (f32x4){0.f, 0.f, 0.f, 0.f};
        cur = nxt; cA = nA; cB = nB; ++ui;
        if constexpr (ALIGN_EPI) { if (wr == 1) PG8_BAR; }
    }
    PG8_WAIT_V(0);
    if constexpr (!ALIGN_EPI) { if (wr == 0) PG8_BAR; }
    PG8_BAR;
    if constexpr (Epi::AFTER_DRAIN) { E.fused(acc, cur, wr, wc, fr, fq, lds, wid, lane); S.done(cur); }
#undef PG8_SA
#undef PG8_SB
#undef PG8_STAGE
#undef PG8_LDA
#undef PG8_LDB
#undef PG8_MMA
#undef PG8_WAIT_V
#undef PG8_WAIT_L
#undef PG8_BAR
#undef PG8_SCHED
}
}
#ifndef DUP_SYNC
#define DUP_SYNC 0
#endif
#ifndef DUP_LRU0
#define DUP_LRU0 0
#endif
#ifndef DUP_ATT
#define DUP_ATT 0
#endif
#ifndef DUP_G1
#define DUP_G1 0
#endif
#ifndef DUP_P0
#define DUP_P0 0
#endif
#ifndef DUP_G6
#define DUP_G6 0
#endif
#ifndef DUP_G7
#define DUP_G7 0
#endif
#define GSYNC() do { xcd_barrier(xbar, mk_tid(wv)); if (DUP_SYNC) xcd_barrier(xbar, mk_tid(wv)); } while (0)
#define LAS __attribute__((address_space(3)))
typedef unsigned short bf16;
typedef float f32x4 __attribute__((ext_vector_type(4)));
typedef float f32x16 __attribute__((ext_vector_type(16)));
typedef short bf16x8 __attribute__((ext_vector_type(8)));
typedef short s16x4 __attribute__((ext_vector_type(4)));
typedef unsigned u32x4 __attribute__((ext_vector_type(4)));
typedef unsigned u32x2 __attribute__((ext_vector_type(2)));
typedef float f32x2_t __attribute__((ext_vector_type(2)));
typedef __bf16 bf16x2_t __attribute__((ext_vector_type(2)));

constexpr int D = 1024, LP = 2064, NPT = 8 * LP  , M = NPT + 512  , MP = 17152, DIN = 4864, DFF = 2816, DEPTH = 4;
constexpr int NTILE64 = M / 64;
constexpr float ALPHA = 1.6817928305074292f;
constexpr float LN_EPS = 1e-5f;
constexpr size_t O_YP = 0, O_YS = 16777216, O_WKP = 17301504, O_WVP = 17825792, O_CVP = 18350080, O_LRP = 18448384,
                 O_WKS = 18481152, O_WVS = 26869760, O_CVS = 35258368, O_LRS = 36831232, O_END = 37355520;
constexpr size_t OB_Q = 0, OB_ATT = (size_t)MP * 512 * 2;
constexpr size_t SZ_WIN = (size_t)DIN * D * 2, SZ_WAP = (size_t)D * 512 * 2, SZ_WLP = (size_t)D * D * 2, SZ_WOUT = SZ_WLP, SZ_WFI = (size_t)2 * DFF * D * 2, SZ_WFO = (size_t)D * DFF * 2, SZ_LW = (size_t)8 * 256 * 128 * 2;
constexpr size_t WS_WIN = 0, WS_WAP = WS_WIN + 4 * SZ_WIN, WS_WLP = WS_WAP + 4 * SZ_WAP, WS_WOUT = WS_WLP + 4 * SZ_WLP, WS_WFI = WS_WOUT + 4 * SZ_WOUT, WS_WFO = WS_WFI + 4 * SZ_WFI,
                 WS_LW = WS_WFO + 4 * SZ_WFO, WS_ROPE = WS_LW + 4 * SZ_LW, WS_AGG = WS_ROPE + 1048576, WS_X = WS_AGG + 4 * 2359296,     WS_XB = WS_X + (size_t)MP * D * 4,
                 WS_R = WS_XB + (size_t)MP * D * 2;
constexpr size_t WS_KB = WS_R, WS_VT = WS_KB + (size_t)MP * 128 * 2, WS_XR = WS_VT + (size_t)MP * 128 * 2, WS_GG = WS_XR + (size_t)MP * D * 2, WS_SA = WS_GG + (size_t)MP * D * 2, WS_SL = WS_SA + (size_t)MP * D * 2,
                 WS_END = WS_SL + (size_t)MP * D * 2;
constexpr size_t WS_BAR = WS_END;
constexpr size_t WS_SS = WS_BAR + 16384;
constexpr size_t SS_INST = (size_t)MP * 32;
constexpr size_t WS_C12 = WS_SS + 3 * SS_INST * 4;
constexpr int NC12 = DIN + 2 * DFF;
constexpr size_t WS_PART = WS_SS;
static_assert((size_t)DEPTH * 16 * NC12 * 2 * 4 <= 3 * SS_INST * 4, "partials fit in the statistics region");
constexpr size_t WS_TOTAL = WS_C12 + (size_t)DEPTH * NC12 * 2 * 4;
static_assert(WS_TOTAL <= 405000000, "workspace budget (ws_size >= sum of inputs = 409.2 MB)");
constexpr size_t WS_H = WS_R;
static_assert(WS_H + (size_t)MP * DFF * 2 <= WS_END, "H overlay");
static_assert(WS_GG == WS_XR + (size_t)MP * D * 2 && WS_SA == WS_GG + (size_t)MP * D * 2 && WS_SL == WS_SA + (size_t)MP * D * 2, "XR|GG|SA|SL consecutive");
constexpr int LDS_BYTES = 159744;
constexpr int LDS_ST = 155648;
constexpr size_t AGG_LAYER = 2359296 / 4;
constexpr unsigned AGG_SENTINEL = 0x7fc0deadu;

struct Params { const float* in[25]; float* out; unsigned char* ws; };
enum { I_XP = 0, I_XS, I_CK, I_CV, I_SC, I_SLRU, I_META, I_WIN, I_WAP, I_WLP, I_WOUT, I_SINK, I_CW, I_CB, I_WA, I_BA, I_WX, I_BX, I_LAM, I_L1G, I_L1B, I_WFI, I_WFO, I_L2G, I_L2B };

__device__ __forceinline__ unsigned cvtpk(float lo, float hi) { f32x2_t v = {lo, hi}; bf16x2_t b = __builtin_convertvector(v, bf16x2_t); return __builtin_bit_cast(unsigned, b); }
__device__ __forceinline__ bf16 f2bf(float f) { return (bf16)(cvtpk(f, 0.f) & 0xffffu); }
__device__ __forceinline__ float bf2f(unsigned b) { return __uint_as_float(b << 16); }
__device__ __forceinline__ float bflo(unsigned w) { return __uint_as_float(w << 16); }
__device__ __forceinline__ float bfhi(unsigned w) { return __uint_as_float(w & 0xffff0000u); }
__device__ __forceinline__ float sigmoidf_(float x) { return __builtin_amdgcn_rcpf(1.f + __expf(-x)); }
__device__ __forceinline__ float gelu_tanh(float x) { return x * sigmoidf_(1.5957691216057308f * (x + 0.044715f * x * x * x)); }
__device__ __forceinline__ u32x4 pack8(f32x4 a, f32x4 b) { u32x4 w; w.x = cvtpk(a[0], a[1]); w.y = cvtpk(a[2], a[3]); w.z = cvtpk(b[0], b[1]); w.w = cvtpk(b[2], b[3]); return w; }
__device__ __forceinline__ int mk_tid(int wv) { int t = wv * 64 + (int)__builtin_amdgcn_mbcnt_hi(~0u, __builtin_amdgcn_mbcnt_lo(~0u, 0u)); asm volatile("" : "+v"(t)); return t; }
__device__ __forceinline__ int crow(int reg, int h) { return (reg & 3) + 8 * (reg >> 2) + 4 * h; }
#define MFMA32(a, b, c) __builtin_amdgcn_mfma_f32_32x32x16_bf16((a), (b), (c), 0, 0, 0)
#define LDS_WAIT() asm volatile("s_waitcnt lgkmcnt(0)" ::: "memory")

__device__ __forceinline__ void ln_table(const float* st, int pm, int key, int wr, int wc, int fr, int fq) {
    typedef float f32x2v __attribute__((ext_vector_type(2)));
    LAS f32x2v* tab = (LAS f32x2v*)((LAS unsigned char*)0 + 131072);
    volatile LAS int* kw = (volatile LAS int*)((LAS unsigned char*)0 + LDS_ST + 8);
    const int t = (wr * 4 + wc) * 64 + fq * 16 + fr;
    if (st) {
        const int want = key * 128 + pm + 1;
        if (__builtin_amdgcn_readfirstlane(*kw) != want) {
            if (t < 256) {
                const f32x4* p = (const f32x4*)(st + ((size_t)(pm * 256 + t)) * 32);
                float s = 0.f, q = 0.f;
#pragma unroll
                for (int i = 0; i < 8; ++i) { const f32x4 v = p[i]; s += v[0] + v[2]; q += v[1] + v[3]; }
                const float mu = s * (1.f / D);
                tab[t] = (f32x2v){mu, __builtin_amdgcn_rsqf(fmaxf(q * (1.f / D) - mu * mu, 0.f) + LN_EPS)};
            }
            asm volatile("s_waitcnt lgkmcnt(0)" ::: "memory"); __builtin_amdgcn_s_barrier(); asm volatile("" ::: "memory");
            if (t == 0) *kw = want;
        }
    }
}
__device__ __forceinline__ void ln_row_stats(const float* st, int rloc, float& mu, float& rstd) {
    typedef float f32x2v __attribute__((ext_vector_type(2)));
    const f32x2v v = ((const LAS f32x2v*)((LAS unsigned char*)0 + 131072))[rloc]; mu = v.x; rstd = v.y;
}
struct EpiProj {
    static constexpr bool PERM = true, AFTER_DRAIN = false;
    int l; bf16 *Q, *KB, *VT, *XR; const float* rope; float* out; const float* st; const float* c12; int key;
    __device__ __forceinline__ static int pos_idx(int row) { return row < NPT ? row % LP : (row < M ? LP + ((row - NPT) & 3) : 0); }
    __device__ __forceinline__ void operator()(const pg8::f32x4 (&acc)[2][2][4][2], const pg8::Unit& u, int wr, int wc, int fr, int fq) const {
        asm volatile("" : "+v"(fr), "+v"(fq));
        const int pn = u.pn, cl = wc * 32 + 8 * fq;
        ln_table(st, u.pm, key, wr, wc, fr, fq);
        if (pn < 3) {
            const int d0 = (cl & 63) >> 1;
#pragma unroll
            for (int bj = 0; bj < 2; ++bj) {
                f32x4 c1a = {0.f, 0.f, 0.f, 0.f}, c1b = c1a, c2a = c1a, c2b = c1a;
                if (st) { const float* cp = c12 + (size_t)(pn * 256 + bj * 128 + cl) * 2; const f32x4 ca = *(const f32x4*)cp, cb = *(const f32x4*)(cp + 4), cc = *(const f32x4*)(cp + 8), cd = *(const f32x4*)(cp + 12);
                    c1a = (f32x4){ca[0], ca[2], cb[0], cb[2]}; c2a = (f32x4){ca[1], ca[3], cb[1], cb[3]}; c1b = (f32x4){cc[0], cc[2], cd[0], cd[2]}; c2b = (f32x4){cc[1], cc[3], cd[1], cd[3]}; }
#pragma unroll
                for (int ai = 0; ai < 2; ++ai)
#pragma unroll
                for (int mp = 0; mp < 2; ++mp) {
                    f32x4 cs0[2], cs1[2];
#pragma unroll
                    for (int mm = 0; mm < 2; ++mm) { const int pi = pos_idx(u.pm * 256 + ai * 128 + wr * 64 + (2 * mp + mm) * 16 + fr); cs0[mm] = *(const f32x4*)(rope + (size_t)pi * 64 + d0 * 2); cs1[mm] = *(const f32x4*)(rope + (size_t)pi * 64 + d0 * 2 + 4); }
#pragma unroll
                    for (int mm = 0; mm < 2; ++mm) {
                        const int m = 2 * mp + mm;
                        const int rloc = ai * 128 + wr * 64 + m * 16 + fr, row = u.pm * 256 + rloc;
                        float mu = 0.f, rstd = 1.f; if (st) ln_row_stats(st, rloc, mu, rstd);
                        const f32x4 v0 = (acc[ai][bj][m][0] - c1a * mu) * rstd + c2a, v1 = (acc[ai][bj][m][1] - c1b * mu) * rstd + c2b;
                        if (pn == 2 && bj == 1) {
                            const int vc = cl;
                            const u32x4 w = pack8(v0, v1);
                            bf16* vt = VT + ((size_t)((vc >> 6) * (MP / 4) + (row >> 2)) * 64 + (vc & 63)) * 4 + (row & 3);
                            vt[0] = (bf16)(w.x & 0xffff); vt[4] = (bf16)(w.x >> 16); vt[8] = (bf16)(w.y & 0xffff); vt[12] = (bf16)(w.y >> 16);
                            vt[16] = (bf16)(w.z & 0xffff); vt[20] = (bf16)(w.z >> 16); vt[24] = (bf16)(w.w & 0xffff); vt[28] = (bf16)(w.w >> 16);
                            float* dst = nullptr;
                            if (row < NPT) { const int t = row % LP; if (t >= LP - 128) dst = out + O_WVP + ((size_t)((l * 8 + row / LP) * 128 + (t - (LP - 128)))) * 128 + vc; }
                            else if (row < M) { const int db = (row - NPT) >> 2, s = (row - NPT) & 3; dst = out + O_WVS + ((size_t)((l * 128 + db) * 128 + 124 + s)) * 128 + vc; }
                            if (dst) { *(f32x4*)dst = v0; *(f32x4*)(dst + 4) = v1; }
                        } else {
                            const f32x4 c0 = cs0[mm], c1 = cs1[mm];
                            f32x4 y0, y1;
                            y0[0] = v0[0] * c0[0] - v0[1] * c0[1]; y0[1] = v0[1] * c0[0] + v0[0] * c0[1];
                            y0[2] = v0[2] * c0[2] - v0[3] * c0[3]; y0[3] = v0[3] * c0[2] + v0[2] * c0[3];
                            y1[0] = v1[0] * c1[0] - v1[1] * c1[1]; y1[1] = v1[1] * c1[0] + v1[0] * c1[1];
                            y1[2] = v1[2] * c1[2] - v1[3] * c1[3]; y1[3] = v1[3] * c1[2] + v1[2] * c1[3];
                            if (pn < 2) {
                                const int col = pn * 256 + bj * 128 + cl;
                                *(u32x4*)(Q + (size_t)row * 512 + col) = pack8(y0 * 0.125f, y1 * 0.125f);
                            } else {
                                *(u32x4*)(KB + (size_t)row * 128 + cl) = pack8(y0, y1);
                                float* dst = nullptr;
                                if (row < NPT) { const int t = row % LP; if (t >= LP - 128) dst = out + O_WKP + ((size_t)((l * 8 + row / LP) * 128 + (t - (LP - 128)))) * 128; }
                                else if (row < M) { const int db = (row - NPT) >> 2, s = (row - NPT) & 3; dst = out + O_WKS + ((size_t)((l * 128 + db) * 128 + 124 + s)) * 128; }
                                if (dst) { dst += (cl & 64) + d0;
                                    dst[0] = y0[0]; dst[32] = y0[1]; dst[1] = y0[2]; dst[33] = y0[3]; dst[2] = y1[0]; dst[34] = y1[1]; dst[3] = y1[2]; dst[35] = y1[3]; }
                            }
                        }
                    }
                    asm volatile("" ::: "memory");
                }
            }
        } else {
            const int kind = (pn - 3) >> 2;
            bf16* dstb = XR + (size_t)kind * ((size_t)MP * D);
            const int cbase = ((pn - 3) & 3) * 256 + cl;
#pragma unroll
            for (int bj = 0; bj < 2; ++bj) {
                f32x4 c1a = {0.f, 0.f, 0.f, 0.f}, c1b = c1a, c2a = c1a, c2b = c1a;
                if (st) { const float* cp = c12 + (size_t)(pn * 256 + bj * 128 + cl) * 2; const f32x4 ca = *(const f32x4*)cp, cb = *(const f32x4*)(cp + 4), cc = *(const f32x4*)(cp + 8), cd = *(const f32x4*)(cp + 12);
                    c1a = (f32x4){ca[0], ca[2], cb[0], cb[2]}; c2a = (f32x4){ca[1], ca[3], cb[1], cb[3]}; c1b = (f32x4){cc[0], cc[2], cd[0], cd[2]}; c2b = (f32x4){cc[1], cc[3], cd[1], cd[3]}; }
                const int c = cbase + bj * 128;
#pragma unroll
                for (int ai = 0; ai < 2; ++ai)
#pragma unroll
                    for (int m = 0; m < 4; ++m) {
                        const int rloc = ai * 128 + wr * 64 + m * 16 + fr, row = u.pm * 256 + rloc;
                        float mu = 0.f, rstd = 1.f; if (st) ln_row_stats(st, rloc, mu, rstd);
                        f32x4 v0 = (acc[ai][bj][m][0] - c1a * mu) * rstd + c2a, v1 = (acc[ai][bj][m][1] - c1b * mu) * rstd + c2b;
                        if (kind == 0) {
                            float* dst = nullptr;
                            if (row < NPT) { const int t = row % LP; if (t >= LP - 3) dst = out + O_CVP + ((size_t)((l * 8 + row / LP) * 3 + (t - (LP - 3)))) * 1024 + c; }
                            else if (row < M) { const int db = (row - NPT) >> 2, s = (row - NPT) & 3; if (s >= 1) dst = out + O_CVS + ((size_t)((l * 128 + db) * 3 + (s - 1))) * 1024 + c; }
                            if (dst) { *(f32x4*)dst = v0; *(f32x4*)(dst + 4) = v1; }
                        } else if (kind == 1) {
#pragma unroll
                            for (int j = 0; j < 4; ++j) { v0[j] = gelu_tanh(v0[j]); v1[j] = gelu_tanh(v1[j]); }
                        } else {
#pragma unroll
                            for (int j = 0; j < 4; ++j) { v0[j] = sigmoidf_(v0[j]); v1[j] = sigmoidf_(v1[j]); }
                        }
                        *(u32x4*)(dstb + (size_t)row * 1024 + c) = pack8(v0, v1);
                    }
            }
        }
    }
};
template <bool ADD> struct EpiGate {
    static constexpr bool PERM = true, AFTER_DRAIN = false;
    bf16* S; const bf16* A;
    __device__ __forceinline__ void operator()(const pg8::f32x4 (&acc)[2][2][4][2], const pg8::Unit& u, int wr, int wc, int fr, int fq) const {
        asm volatile("" : "+v"(fr), "+v"(fq));
#pragma unroll
        for (int ai = 0; ai < 2; ++ai) {
            u32x4 sv[4][2], av[4][2];
            const size_t off0 = (size_t)(u.pm * 256 + ai * 128 + wr * 64 + fr) * 1024 + u.pn * 256 + wc * 32 + 8 * fq;
#pragma unroll
            for (int m = 0; m < 4; ++m)
#pragma unroll
                for (int bj = 0; bj < 2; ++bj) { sv[m][bj] = *(const u32x4*)(S + off0 + (size_t)m * 16 * 1024 + bj * 128); if (ADD) av[m][bj] = *(const u32x4*)(A + off0 + (size_t)m * 16 * 1024 + bj * 128); }
#pragma unroll
            for (int m = 0; m < 4; ++m)
#pragma unroll
                for (int bj = 0; bj < 2; ++bj) {
                    const u32x4 s = sv[m][bj];
                    f32x4 v0 = acc[ai][bj][m][0], v1 = acc[ai][bj][m][1];
                    v0[0] *= bflo(s.x); v0[1] *= bfhi(s.x); v0[2] *= bflo(s.y); v0[3] *= bfhi(s.y); v1[0] *= bflo(s.z); v1[1] *= bfhi(s.z); v1[2] *= bflo(s.w); v1[3] *= bfhi(s.w);
                    if (ADD) { const u32x4 a = av[m][bj];
                        v0[0] += bflo(a.x); v0[1] += bfhi(a.x); v0[2] += bflo(a.y); v0[3] += bfhi(a.y); v1[0] += bflo(a.z); v1[1] += bfhi(a.z); v1[2] += bflo(a.w); v1[3] += bfhi(a.w); }
                    *(u32x4*)(S + off0 + (size_t)m * 16 * 1024 + bj * 128) = pack8(v0, v1);
                }
            asm volatile("" ::: "memory");
        }
    }
};
struct EpiRes {
    static constexpr bool PERM = true, AFTER_DRAIN = false;
    float* Z; bf16* ZB; const float* pst; const float* pg; const float* pb; float* ost; int key;
    __device__ __forceinline__ void operator()(const pg8::f32x4 (&acc)[2][2][4][2], const pg8::Unit& u, int wr, int wc, int fr, int fq) const {
        asm volatile("" : "+v"(fr), "+v"(fq));
        ln_table(pst, u.pm, key, wr, wc, fr, fq);
        const int col0 = u.pn * 256 + wc * 32 + 8 * fq;
#pragma unroll
        for (int ai = 0; ai < 2; ++ai) {
            u32x4 zx[4][2];
#pragma unroll
            for (int m = 0; m < 4; ++m)
#pragma unroll
                for (int bj = 0; bj < 2; ++bj) zx[m][bj] = *(const u32x4*)(ZB + (size_t)(u.pm * 256 + ai * 128 + wr * 64 + m * 16 + fr) * 1024 + col0 + bj * 128);
#pragma unroll
            for (int m = 0; m < 4; ++m) {
                const int rloc = ai * 128 + wr * 64 + m * 16 + fr, row = u.pm * 256 + rloc;
                float mu = 0.f, rstd = 1.f; if (pst) ln_row_stats(pst, rloc, mu, rstd);
                float s = 0.f, q = 0.f;
#pragma unroll
                for (int bj = 0; bj < 2; ++bj) {
                    const int col = col0 + bj * 128;
                    const u32x4 zw = zx[m][bj];
                    f32x4 x0 = {bflo(zw.x), bfhi(zw.x), bflo(zw.y), bfhi(zw.y)}, x1 = {bflo(zw.z), bfhi(zw.z), bflo(zw.w), bfhi(zw.w)};
                    if (pst) { const f32x4 g0 = *(const f32x4*)(pg + col), g1 = *(const f32x4*)(pg + col + 4), b0 = *(const f32x4*)(pb + col), b1 = *(const f32x4*)(pb + col + 4);
                        x0 = (x0 - mu) * rstd * g0 + b0; x1 = (x1 - mu) * rstd * g1 + b1; }
                    x0 = x0 * ALPHA + acc[ai][bj][m][0]; x1 = x1 * ALPHA + acc[ai][bj][m][1];
                    if (Z) { float* p = Z + (size_t)row * 1024 + col; *(f32x4*)p = x0; *(f32x4*)(p + 4) = x1; }
                    *(u32x4*)(ZB + (size_t)row * 1024 + col) = pack8(x0, x1);
                    s += ((x0[0] + x0[1]) + (x0[2] + x0[3])) + ((x1[0] + x1[1]) + (x1[2] + x1[3]));
                    q += ((x0[0] * x0[0] + x0[1] * x0[1]) + (x0[2] * x0[2] + x0[3] * x0[3])) + ((x1[0] * x1[0] + x1[1] * x1[1]) + (x1[2] * x1[2] + x1[3] * x1[3]));
                }
                s += __shfl_xor(s, 16); q += __shfl_xor(q, 16); s += __shfl_xor(s, 32); q += __shfl_xor(q, 32);
                if (fq == 0) { typedef float f32x2v __attribute__((ext_vector_type(2))); *(f32x2v*)(ost + (size_t)row * 32 + (u.pn * 4 + wc) * 2) = (f32x2v){s, q}; }
            }
            asm volatile("" ::: "memory");
        }
    }
};
struct EpiSwiglu {
    static constexpr bool PERM = true, AFTER_DRAIN = false;
    bf16* H; const float* st; const float* c12; int key;
    __device__ __forceinline__ void operator()(const pg8::f32x4 (&acc)[2][2][4][2], const pg8::Unit& u, int wr, int wc, int fr, int fq) const {
        asm volatile("" : "+v"(fr), "+v"(fq));
        const int cl = wc * 32 + 8 * fq;
        f32x4 craw[2][4];
#pragma unroll
        for (int bj = 0; bj < 2; ++bj) { const float* cp = c12 + (size_t)(u.pn * 256 + bj * 128 + cl) * 2; craw[bj][0] = *(const f32x4*)cp; craw[bj][1] = *(const f32x4*)(cp + 4); craw[bj][2] = *(const f32x4*)(cp + 8); craw[bj][3] = *(const f32x4*)(cp + 12); }
        ln_table(st, u.pm, key, wr, wc, fr, fq);
        f32x4 c1a[2], c1b[2], c2a[2], c2b[2];
#pragma unroll
        for (int bj = 0; bj < 2; ++bj) { const f32x4 ca = craw[bj][0], cb = craw[bj][1], cc = craw[bj][2], cd = craw[bj][3];
            c1a[bj] = (f32x4){ca[0], ca[2], cb[0], cb[2]}; c2a[bj] = (f32x4){ca[1], ca[3], cb[1], cb[3]}; c1b[bj] = (f32x4){cc[0], cc[2], cd[0], cd[2]}; c2b[bj] = (f32x4){cc[1], cc[3], cd[1], cd[3]}; }
#pragma unroll
        for (int ai = 0; ai < 2; ++ai)
#pragma unroll
            for (int m = 0; m < 4; ++m) {
                const int row = u.pm * 256 + ai * 128 + wr * 64 + m * 16 + fr;
                float mu, rstd; ln_row_stats(st, row - u.pm * 256, mu, rstd);
                const f32x4 u1a = (acc[ai][0][m][0] - c1a[0] * mu) * rstd + c2a[0], u1b = (acc[ai][0][m][1] - c1b[0] * mu) * rstd + c2b[0];
                const f32x4 u2a = (acc[ai][1][m][0] - c1a[1] * mu) * rstd + c2a[1], u2b = (acc[ai][1][m][1] - c1b[1] * mu) * rstd + c2b[1];
                f32x4 h0, h1;
#pragma unroll
                for (int j = 0; j < 4; ++j) { h0[j] = u1a[j] * sigmoidf_(u1a[j]) * u2a[j]; h1[j] = u1b[j] * sigmoidf_(u1b[j]) * u2b[j]; }
                *(u32x4*)(H + (size_t)row * DFF + u.pn * 128 + cl) = pack8(h0, h1);
            }
    }
};

__device__ __forceinline__ int colmap(int mode, int n) {
    if (mode == 1) { if (n < 640) { const int p = n & 63; return (n & ~63) + (p >> 1) + ((p & 1) << 5); } return n; }
    if (mode == 2) { const int pn = n >> 8, bj = (n >> 7) & 1, j = n & 127; return bj * DFF + pn * 128 + j; }
    return n;
}
__device__ __forceinline__ void transpose_item(const float* W, int K, int N, bf16* WT, int mode, LAS float* scr, int item, int lane) {
    const int nblk = N / 32, kb = item / nblk, nb = item % nblk, k0 = 64 * kb, n0 = 32 * nb;
    const int nsrc = colmap(mode, n0 + (lane & 31));
#pragma unroll 8
    for (int i = 0; i < 32; ++i) { const int kk = 2 * i + (lane >> 5); scr[kk * 33 + (lane & 31)] = __builtin_nontemporal_load(W + (size_t)(k0 + kk) * N + nsrc); }
    LDS_WAIT();
    const int c = lane & 7;
#pragma unroll
    for (int j = 0; j < 4; ++j) { const int n = (lane >> 3) + 8 * j; const LAS float* s = scr + (8 * c) * 33 + n;
        u32x4 o; o.x = cvtpk(s[0 * 33], s[1 * 33]); o.y = cvtpk(s[2 * 33], s[3 * 33]); o.z = cvtpk(s[4 * 33], s[5 * 33]); o.w = cvtpk(s[6 * 33], s[7 * 33]);
        *(u32x4*)(WT + (size_t)(n0 + n) * K + k0 + 8 * c) = o; }
    LDS_WAIT();
}
__device__ __forceinline__ void transpose_item_ln(const float* W, int K, int N, bf16* WT, int mode, LAS float* scr, int item, int lane, const float* gk, const float* bk, float* part) {
    const int nblk = N / 32, kb = item / nblk, nb = item % nblk, k0 = 64 * kb, n0 = 32 * nb;
    const int nsrc = colmap(mode, n0 + (lane & 31));
    LAS float* gs = scr + 64 * 33; LAS float* bs = gs + 64;
    gs[lane] = gk[k0 + lane]; bs[lane] = bk[k0 + lane];
    LDS_WAIT();
    float s1 = 0.f, s2 = 0.f;
#pragma unroll 8
    for (int i = 0; i < 32; ++i) { const int kk = 2 * i + (lane >> 5); const float w = __builtin_nontemporal_load(W + (size_t)(k0 + kk) * N + nsrc); const float wg = w * gs[kk];
        scr[kk * 33 + (lane & 31)] = wg; s1 += bf2f(cvtpk(wg, 0.f) & 0xffffu); s2 += bs[kk] * w; }
    s1 += __shfl_xor(s1, 32); s2 += __shfl_xor(s2, 32);
    if (lane < 32) { float* pp = part + ((size_t)kb * NC12 + n0 + lane) * 2; pp[0] = s1; pp[1] = s2; }
    LDS_WAIT();
    const int c = lane & 7;
#pragma unroll
    for (int j = 0; j < 4; ++j) { const int n = (lane >> 3) + 8 * j; const LAS float* s = scr + (8 * c) * 33 + n;
        u32x4 o; o.x = cvtpk(s[0 * 33], s[1 * 33]); o.y = cvtpk(s[2 * 33], s[3 * 33]); o.z = cvtpk(s[4 * 33], s[5 * 33]); o.w = cvtpk(s[6 * 33], s[7 * 33]);
        *(u32x4*)(WT + (size_t)(n0 + n) * K + k0 + 8 * c) = o; }
    LDS_WAIT();
}
__device__ __forceinline__ void prologue(const Params& P, LAS unsigned char* lds, int tid_in) {
    const int tid = tid_in, lane = tid & 63, wave = tid >> 6;
    const int gw = blockIdx.x * 8 + wave, NGW = gridDim.x * 8;
    LAS float* scr = (LAS float*)(lds + wave * 9216);
    unsigned char* ws = P.ws;
    constexpr int IT_IN = 16 * (DIN / 32), IT_AP = 8 * 32, IT_LP = 16 * 32, IT_OUT = 16 * 32, IT_FI = 16 * (2 * DFF / 32), IT_FO = (DFF / 64) * 32, IT_LW = 16 * 8;
    constexpr int IT_LAYER = IT_IN + IT_AP + IT_LP + IT_OUT + IT_FI + IT_FO + IT_LW;
    for (int it = gw; it < DEPTH * IT_LAYER; it += NGW) {
        const int l = it / IT_LAYER; int r = it % IT_LAYER;
        if (r < IT_IN) { if (l == 0) transpose_item(P.in[I_WIN], D, DIN, (bf16*)(ws + WS_WIN), 1, scr, r, lane);
                         else transpose_item_ln(P.in[I_WIN] + (size_t)l * D * DIN, D, DIN, (bf16*)(ws + WS_WIN + l * SZ_WIN), 1, scr, r, lane, P.in[I_L2G] + (l - 1) * D, P.in[I_L2B] + (l - 1) * D, (float*)(ws + WS_PART) + (size_t)l * 16 * NC12 * 2);
                         continue; } r -= IT_IN;
        if (r < IT_AP) { transpose_item(P.in[I_WAP] + (size_t)l * 512 * D, 512, D, (bf16*)(ws + WS_WAP + l * SZ_WAP), 0, scr, r, lane); continue; } r -= IT_AP;
        if (r < IT_LP) { transpose_item(P.in[I_WLP] + (size_t)l * D * D, D, D, (bf16*)(ws + WS_WLP + l * SZ_WLP), 0, scr, r, lane); continue; } r -= IT_LP;
        if (r < IT_OUT) { transpose_item(P.in[I_WOUT] + (size_t)l * D * D, D, D, (bf16*)(ws + WS_WOUT + l * SZ_WOUT), 0, scr, r, lane); continue; } r -= IT_OUT;
        if (r < IT_FI) { transpose_item_ln(P.in[I_WFI] + (size_t)l * D * 2 * DFF, D, 2 * DFF, (bf16*)(ws + WS_WFI + l * SZ_WFI), 2, scr, r, lane, P.in[I_L1G] + l * D, P.in[I_L1B] + l * D, (float*)(ws + WS_PART) + ((size_t)l * 16 * NC12 + DIN) * 2); continue; } r -= IT_FI;
        if (r < IT_FO) { transpose_item(P.in[I_WFO] + (size_t)l * DFF * D, DFF, D, (bf16*)(ws + WS_WFO + l * SZ_WFO), 0, scr, r, lane); continue; } r -= IT_FO;
        { const int mat = r >> 3, sub = r & 7, nb = mat >> 1, which = mat & 1;
          transpose_item(P.in[which ? I_WX : I_WA] + (size_t)(l * 8 + nb) * 128 * 128, 128, 128, (bf16*)(ws + WS_LW + l * SZ_LW) + (size_t)(nb * 256 + which * 128) * 128, 0, scr, sub, lane); }
    }
    float* X = (float*)(ws + WS_X); bf16* XB = (bf16*)(ws + WS_XB);
    {
        f32x4 vn[4];
        auto row_src = [&](int m) -> const float* {
            if (m < NPT) { const int bb = m / LP, t = m % LP; return t < 16 ? P.in[I_META] + (size_t)t * D : P.in[I_XP] + ((size_t)bb * 2048 + (t - 16)) * D; }
            if (m < M) return P.in[I_XS] + (size_t)(m - NPT) * D;
            return nullptr; };
        if (gw < MP) { const float* src = row_src(gw);
#pragma unroll
            for (int j = 0; j < 4; ++j) { vn[j] = (f32x4){0.f, 0.f, 0.f, 0.f}; if (src) vn[j] = __builtin_nontemporal_load((const f32x4*)(src + 256 * j + 4 * lane)); } }
        for (int m = gw; m < MP; m += NGW) {
            f32x4 v[4];
#pragma unroll
            for (int j = 0; j < 4; ++j) v[j] = vn[j];
            if (m + NGW < MP) { const float* src = row_src(m + NGW);
#pragma unroll
                for (int j = 0; j < 4; ++j) { vn[j] = (f32x4){0.f, 0.f, 0.f, 0.f}; if (src) vn[j] = __builtin_nontemporal_load((const f32x4*)(src + 256 * j + 4 * lane)); } }
#pragma unroll
            for (int j = 0; j < 4; ++j) { u32x2 w; w.x = cvtpk(v[j][0], v[j][1]); w.y = cvtpk(v[j][2], v[j][3]); *(u32x2*)(XB + (size_t)m * D + 256 * j + 4 * lane) = w; }
        }
    }
    { unsigned* ag = (unsigned*)(ws + WS_AGG); for (int e = blockIdx.x * 512 + tid; e < (int)(DEPTH * AGG_LAYER); e += gridDim.x * 512) ag[e] = AGG_SENTINEL; }
    float* rope = (float*)(ws + WS_ROPE);
    for (int e = blockIdx.x * 512 + tid; e < (LP + 4) * 32; e += gridDim.x * 512) {
        const int pi = e >> 5, d = e & 31; const double pos = pi < LP ? (double)pi : (double)(8192 + pi - LP);
        const double inv = pow(10000.0, -(double)d / 32.0), ang = pos * inv;
        rope[2 * e] = (float)cos(ang); rope[2 * e + 1] = (float)sin(ang);
    }
}

template <bool FINAL> __device__ __forceinline__ void ln_pass(const Params& P, const float* g, const float* b, int tid_in) {
    const int tid = tid_in, lane = tid & 63, wave = tid >> 6, gw = blockIdx.x * 8 + wave, NGW = gridDim.x * 8;
    float* X = (float*)(P.ws + WS_X); bf16* XB = (bf16*)(P.ws + WS_XB);
    f32x4 gv[4], bv[4];
#pragma unroll
    for (int j = 0; j < 4; ++j) { gv[j] = *(const f32x4*)(g + 256 * j + 4 * lane); bv[j] = *(const f32x4*)(b + 256 * j + 4 * lane); }
    f32x4 vn[4];
    if (gw < M) {
#pragma unroll
        for (int j = 0; j < 4; ++j) vn[j] = *(const f32x4*)(X + (size_t)gw * D + 256 * j + 4 * lane);
    }
    for (int m = gw; m < M; m += NGW) {
        f32x4 v[4]; float s = 0.f;
#pragma unroll
        for (int j = 0; j < 4; ++j) { v[j] = vn[j]; s += (v[j][0] + v[j][1]) + (v[j][2] + v[j][3]); }
        { const int mn = m + NGW < M ? m + NGW : m;
#pragma unroll
          for (int j = 0; j < 4; ++j) vn[j] = *(const f32x4*)(X + (size_t)mn * D + 256 * j + 4 * lane); }
#pragma unroll
        for (int o = 1; o < 64; o <<= 1) s += __shfl_xor(s, o);
        const float mean = s * (1.f / D); float q = 0.f;
#pragma unroll
        for (int j = 0; j < 4; ++j) { v[j] = v[j] - mean; q += (v[j][0] * v[j][0] + v[j][1] * v[j][1]) + (v[j][2] * v[j][2] + v[j][3] * v[j][3]); }
#pragma unroll
        for (int o = 1; o < 64; o <<= 1) q += __shfl_xor(q, o);
        const float rstd = 1.f / sqrtf(q * (1.f / D) + LN_EPS);
        float* yo = nullptr;
        if (FINAL) { if (m < NPT) { const int bb = m / LP, t = m % LP; if (t >= 16) yo = P.out + O_YP + ((size_t)bb * 2048 + (t - 16)) * D; } else yo = P.out + O_YS + (size_t)(m - NPT) * D; }
#pragma unroll
        for (int j = 0; j < 4; ++j) {
            const f32x4 y = v[j] * rstd * gv[j] + bv[j];
            if (FINAL) { if (yo) *(f32x4*)(yo + 256 * j + 4 * lane) = y; }
            else { *(f32x4*)(X + (size_t)m * D + 256 * j + 4 * lane) = y;
                   u32x2 w; w.x = cvtpk(y[0], y[1]); w.y = cvtpk(y[2], y[3]); *(u32x2*)(XB + (size_t)m * D + 256 * j + 4 * lane) = w; }
        }
    }
}

#define BAR_LDS() do { asm volatile("s_waitcnt lgkmcnt(0)" ::: "memory"); __builtin_amdgcn_s_barrier(); asm volatile("" ::: "memory"); } while (0)
__device__ __forceinline__ void lru_load_rows(const Params& P, int l, int tile, int r0, int c0, u32x4 (&xr)[2][4]) {
    const bf16* XR = (const bf16*)(P.ws + WS_XR);
    const bool samp = tile * 64 >= NPT;
#pragma unroll
    for (int j = 0; j < 2; ++j) {
        const int m = tile * 64 + r0 + 32 * j;
        const int pos = samp ? ((m - NPT) & 3) : (m % LP);
#pragma unroll
        for (int i = 0; i < 4; ++i) {
            u32x4 v = {0u, 0u, 0u, 0u};
            if (pos - i >= 0) v = *(const u32x4*)(XR + (size_t)(m - i) * 1024 + c0);
            else if (samp) { const float* buf = P.in[I_SC] + ((size_t)((l * 128 + ((m - NPT) >> 2)) * 3) + (3 + pos - i)) * 1024 + c0; v = pack8(*(const f32x4*)buf, *(const f32x4*)(buf + 4)); }
            xr[j][i] = v;
        }
    }
}
template <int MODE> __device__ __forceinline__ void lru_phase(const Params& P, LAS unsigned char* lds, int l, int tid_in) {
    const int tid = tid_in, lane = tid & 63, wid = tid >> 6;
    LAS bf16* xcb = (LAS bf16*)lds;
    LAS float* qa = (LAS float*)lds; LAS float* qb = qa + 512;
    LAS float* sab = (LAS float*)(lds + 17408);
    LAS float* cwl = (LAS float*)(lds + 148480);
    LAS float* fa = (LAS float*)(lds + 151040); LAS float* fb = fa + 512;
    const int nb = blockIdx.x & 7, tstride = gridDim.x >> 3;
    const int c8 = tid & 15, r0 = tid >> 4, c0 = nb * 128 + c8 * 8;
    for (int e = tid; e < 640; e += 512) { const int i = e >> 7, cc = e & 127; cwl[e] = i < 4 ? P.in[I_CW][(size_t)(l * 4 + 3 - i) * 1024 + nb * 128 + cc] : P.in[I_CB][l * 1024 + nb * 128 + cc]; }
    const int rb = wid & 1, cb = wid >> 1, l32 = lane & 31, h = lane >> 5;
    bf16x8 br[8], bi[8];
    { const bf16* LW = (const bf16*)(P.ws + WS_LW + l * SZ_LW) + (size_t)(nb * 256 + cb * 32 + l32) * 128 + h * 8;
#pragma unroll
      for (int kk = 0; kk < 8; ++kk) { br[kk] = *(const bf16x8*)(LW + kk * 16); bi[kk] = *(const bf16x8*)(LW + 128 * 128 + kk * 16); } }
    const int cgate = cb * 32 + l32;
    const float ba = P.in[I_BA][l * 1024 + nb * 128 + cgate], bx = P.in[I_BX][l * 1024 + nb * 128 + cgate];
    const float sp = log1pf(expf(-P.in[I_LAM][l * 1024 + nb * 128 + cgate]));
    const float L2E = 1.4426950408889634f, nba = -L2E * ba, nbx = -L2E * bx, ca = -8.f * sp * L2E;
    const int cs = tid & 127, q = tid >> 7, cgs = nb * 128 + cs;
    float* AGG = (float*)(P.ws + WS_AGG) + (size_t)l * AGG_LAYER;
    bf16* GG = (bf16*)(P.ws + WS_GG);
    u32x4 xr[2][4], gwp[2];
    float pqa[3] = {1.f, 1.f, 1.f}, pqb[3] = {0.f, 0.f, 0.f};
    int tile = blockIdx.x >> 3, prev = -1, par = 0;
    BAR_LDS();
    if (tile < NTILE64) lru_load_rows(P, l, tile, r0, c0, xr);
    for (;; tile += tstride, par ^= 1) {
        const bool cur = tile < NTILE64;
        if (!cur && prev < 0) break;
        const int t0 = tile * 64; const bool samp = t0 >= NPT;
        LAS float* sa = sab + par * 16384; LAS float* sb = sa + 8192;
        LAS float* psa = sab + (par ^ 1) * 16384; LAS float* psb = psa + 8192;
        const int pt0 = prev * 64; const bool psamp = pt0 >= NPT;
        u32x4 gw[2];
        if (cur) {
#pragma unroll
            for (int j = 0; j < 2; ++j) {
                f32x4 a0 = *(const LAS f32x4*)(cwl + 512 + c8 * 8), a1 = *(const LAS f32x4*)(cwl + 512 + c8 * 8 + 4);
#pragma unroll
                for (int i = 0; i < 4; ++i) { const u32x4 xw = xr[j][i]; f32x4 x0, x1; const f32x4 w0 = *(const LAS f32x4*)(cwl + i * 128 + c8 * 8), w1 = *(const LAS f32x4*)(cwl + i * 128 + c8 * 8 + 4);
                    x0[0] = bflo(xw.x); x0[1] = bfhi(xw.x); x0[2] = bflo(xw.y); x0[3] = bfhi(xw.y); x1[0] = bflo(xw.z); x1[1] = bfhi(xw.z); x1[2] = bflo(xw.w); x1[3] = bfhi(xw.w);
                    a0 += w0 * x0; a1 += w1 * x1; }
                *(LAS u32x4*)(xcb + (r0 + 32 * j) * 136 + c8 * 8) = pack8(a0, a1);
            }
            if (tile + tstride < NTILE64) lru_load_rows(P, l, tile + tstride, r0, c0, xr);
#pragma unroll
            for (int j = 0; j < 2; ++j) gw[j] = *(const u32x4*)(GG + (size_t)(t0 + r0 + 32 * j) * 1024 + c0);
        }
        if (prev >= 0) {
            float fA = 1.f, fB = 0.f;
            if (!psamp && (pt0 % LP) != 0) {
                const int j0 = (((pt0 - 1) / LP) * LP) / 64, n = prev - j0, per = (n + 3) >> 2, ja = j0 + q * per;
                float aa[9], bb[9];
                for (unsigned spin = 0; spin < (1u << 20); ++spin) {
                    bool bad = false;
#pragma unroll
                    for (int i = 0; i < 9; ++i) { const bool ok = i < per && ja + i < prev; const int j = ok ? ja + i : j0;
                        aa[i] = __hip_atomic_load(AGG + (size_t)j * 2048 + cgs, __ATOMIC_RELAXED, __HIP_MEMORY_SCOPE_AGENT); bb[i] = __hip_atomic_load(AGG + (size_t)j * 2048 + 1024 + cgs, __ATOMIC_RELAXED, __HIP_MEMORY_SCOPE_AGENT); }
#pragma unroll
                    for (int i = 0; i < 9; ++i) { bad = bad || __float_as_uint(aa[i]) == AGG_SENTINEL || __float_as_uint(bb[i]) == AGG_SENTINEL; }
                    if (!bad) break;
                    __builtin_amdgcn_s_sleep(8);
                }
#pragma unroll
                for (int i = 0; i < 9; ++i) { const bool ok = i < per && ja + i < prev; if (!ok) { aa[i] = 1.f; bb[i] = 0.f; } }
#pragma unroll
                for (int i = 0; i < 9; ++i) { fB = aa[i] * fB + bb[i]; fA *= aa[i]; }
            }
            fa[q * 128 + cs] = fA; fb[q * 128 + cs] = fB;
        }
        BAR_LDS();
        if (cur) {
            f32x16 ar, ai;
#pragma unroll
            for (int i = 0; i < 16; ++i) { ar[i] = 0.f; ai[i] = 0.f; }
#pragma unroll
            for (int kk = 0; kk < 8; ++kk) {
                const bf16x8 a = *(const LAS bf16x8*)(xcb + (rb * 32 + l32) * 136 + kk * 16 + h * 8);
                ar = MFMA32(a, br[kk], ar); ai = MFMA32(a, bi[kk], ai);
            }
#pragma unroll
            for (int i = 0; i < 16; ++i) {
                const int r = rb * 32 + crow(i, h);
                const float rr = __builtin_amdgcn_rcpf(1.f + __builtin_amdgcn_exp2f(ar[i] * -L2E + nba)), ii = __builtin_amdgcn_rcpf(1.f + __builtin_amdgcn_exp2f(ai[i] * -L2E + nbx));
                const float a = __builtin_amdgcn_exp2f(ca * rr), mult = __builtin_amdgcn_sqrtf(fmaxf(1.f - a * a, 0.f));
                sa[r * 128 + cgate] = a; sb[r * 128 + cgate] = mult * ii * bf2f(xcb[r * 136 + cgate]);
            }
        }
        BAR_LDS();
        if (cur) {
            const int pos0 = samp ? 0 : ((t0 + 16 * q) % LP);
            const int rs = samp ? -1 : (pos0 == 0 ? 0 : (LP - pos0 < 16 ? LP - pos0 : -1));
            float A = 1.f, B = 0.f;
#pragma unroll
            for (int i = 0; i < 16; ++i) {
                const float a2 = sa[(16 * q + i) * 128 + cs], b2 = sb[(16 * q + i) * 128 + cs];
                const bool reset = samp ? ((i & 3) == 0) : (i == rs);
                float h0 = 0.f; if (samp && reset) h0 = P.in[I_SLRU][(size_t)(l * 128 + ((t0 + 16 * q - NPT) >> 2) + (i >> 2)) * 1024 + cgs];
                if (reset) { A = 0.f; B = a2 * h0 + b2; } else { A *= a2; B = a2 * B + b2; }
            }
            qa[q * 128 + cs] = A; qb[q * 128 + cs] = B;
        }
        if (prev >= 0) {
            const int pos0 = psamp ? 0 : ((pt0 + 16 * q) % LP);
            const int rs = psamp ? -1 : (pos0 == 0 ? 0 : (LP - pos0 < 16 ? LP - pos0 : -1));
            float hh = 0.f;
#pragma unroll
            for (int r = 0; r < 4; ++r) hh = fa[r * 128 + cs] * hh + fb[r * 128 + cs];
#pragma unroll
            for (int j = 0; j < 3; ++j) if (j < q) hh = pqa[j] * hh + pqb[j];
#pragma unroll
            for (int i = 0; i < 16; ++i) {
                const float a2 = psa[(16 * q + i) * 128 + cs], b2 = psb[(16 * q + i) * 128 + cs];
                const bool reset = psamp ? ((i & 3) == 0) : (i == rs);
                float h0 = 0.f; if (psamp && reset) h0 = P.in[I_SLRU][(size_t)(l * 128 + ((pt0 + 16 * q - NPT) >> 2) + (i >> 2)) * 1024 + cgs];
                hh = reset ? a2 * h0 + b2 : a2 * hh + b2;
                psb[(16 * q + i) * 128 + cs] = hh;
            }
        }
        BAR_LDS();
        if (cur) {
            if (q == 3) {
                float A = 1.f, B = 0.f;
#pragma unroll
                for (int j = 0; j < 4; ++j) { const float Aj = qa[j * 128 + cs], Bj = qb[j * 128 + cs]; B = Aj * B + Bj; A *= Aj; }
                __hip_atomic_store(AGG + (size_t)tile * 2048 + cgs, A, __ATOMIC_RELAXED, __HIP_MEMORY_SCOPE_AGENT); __hip_atomic_store(AGG + (size_t)tile * 2048 + 1024 + cgs, B, __ATOMIC_RELAXED, __HIP_MEMORY_SCOPE_AGENT);
            }
        }
        if (prev >= 0) {
#pragma unroll
            for (int j = 0; j < 2; ++j) {
                const int r = r0 + 32 * j, m = pt0 + r;
                const f32x4 h0 = *(const LAS f32x4*)(psb + r * 128 + c8 * 8), h1 = *(const LAS f32x4*)(psb + r * 128 + c8 * 8 + 4);
                f32x4 q0, q1;
                q0[0] = h0[0] * bflo(gwp[j].x); q0[1] = h0[1] * bfhi(gwp[j].x); q0[2] = h0[2] * bflo(gwp[j].y); q0[3] = h0[3] * bfhi(gwp[j].y);
                q1[0] = h1[0] * bflo(gwp[j].z); q1[1] = h1[1] * bfhi(gwp[j].z); q1[2] = h1[2] * bflo(gwp[j].w); q1[3] = h1[3] * bfhi(gwp[j].w);
                *(u32x4*)(GG + (size_t)m * 1024 + c0) = pack8(q0, q1);
                float* so = nullptr;
                if (psamp) { if ((r & 3) == 3) so = P.out + O_LRS + (size_t)(l * 128 + ((m - NPT) >> 2)) * 1024; }
                else if (m % LP == LP - 1) so = P.out + O_LRP + (size_t)(l * 8 + m / LP) * 1024;
                if (so) { *(f32x4*)(so + c0) = h0; *(f32x4*)(so + c0 + 4) = h1; }
            }
        }
        if (cur) {
#pragma unroll
            for (int j = 0; j < 3; ++j) { pqa[j] = qa[j * 128 + cs]; pqb[j] = qb[j * 128 + cs]; }
            gwp[0] = gw[0]; gwp[1] = gw[1];
        }
        prev = cur ? tile : -1;
        BAR_LDS();
    }
}

__device__ __forceinline__ void attn_prompt_wave(const Params& P, int l, int qt, int tid_in) {
    const int tid = tid_in, lane = tid & 63, l32 = lane & 31, h = lane >> 5, head = tid >> 6, kvh = head >> 2;
    const bf16* Q = (const bf16*)((const unsigned char*)P.out + OB_Q); bf16* ATT = (bf16*)((unsigned char*)P.out + OB_ATT);
    const bf16* KB = (const bf16*)(P.ws + WS_KB); const bf16* VT = (const bf16*)(P.ws + WS_VT);
    const int q0 = qt * 32, key0 = q0 - 128;
    bf16x8 qf[4];
#pragma unroll
    for (int kk = 0; kk < 4; ++kk) qf[kk] = *(const bf16x8*)(Q + (size_t)(q0 + l32) * 512 + head * 64 + kk * 16 + h * 8);
    bf16x8 kf[5][4];
#pragma unroll
    for (int kb = 0; kb < 5; ++kb) {
        int krow_ = key0 + kb * 32 + l32; krow_ = krow_ < 0 ? 0 : krow_;
        const bf16* kp = KB + (size_t)krow_ * 128 + kvh * 64 + h * 8;
#pragma unroll
        for (int kk = 0; kk < 4; ++kk) kf[kb][kk] = *(const bf16x8*)(kp + kk * 16);
    }
    u32x2 vfa[5][2][2], vfb[5][2][2];
#pragma unroll
    for (int kb = 0; kb < 5; ++kb)
#pragma unroll
        for (int s = 0; s < 2; ++s) {
            int k0 = key0 + kb * 32 + 16 * s + 4 * h, k1 = k0 + 8; k0 = k0 < 0 ? 0 : k0; k1 = k1 < 0 ? 0 : k1;
#pragma unroll
            for (int db = 0; db < 2; ++db) {
                const bf16* vp = VT + ((size_t)kvh * (MP / 4) * 64 + db * 32 + l32) * 4;
                vfa[kb][s][db] = *(const u32x2*)(vp + (size_t)(k0 >> 2) * 256); vfb[kb][s][db] = *(const u32x2*)(vp + (size_t)(k1 >> 2) * 256);
            }
        }
    f32x16 st[5];
#pragma unroll
    for (int kb = 0; kb < 5; ++kb) {
#pragma unroll
        for (int i = 0; i < 16; ++i) st[kb][i] = 0.f;
#pragma unroll
        for (int kk = 0; kk < 4; ++kk) st[kb] = MFMA32(kf[kb][kk], qf[kk], st[kb]);
    }
    const int qi = q0 + l32, bstart = (qi / LP) * LP;
    const float sink = P.in[I_SINK][l * 8 + head];
    float mx = sink;
#pragma unroll
    for (int kb = 0; kb < 5; ++kb)
#pragma unroll
        for (int i = 0; i < 16; ++i) { const int ki = key0 + kb * 32 + crow(i, h); const bool ok = ki <= qi && ki > qi - 128 && ki >= bstart;
            st[kb][i] = ok ? st[kb][i] : -1e30f; mx = fmaxf(mx, st[kb][i]); }
    mx = fmaxf(mx, __shfl_xor(mx, 32));
    float sum = 0.f;
#pragma unroll
    for (int kb = 0; kb < 5; ++kb)
#pragma unroll
        for (int i = 0; i < 16; ++i) { const float p = st[kb][i] > -1e29f ? __expf(st[kb][i] - mx) : 0.f; st[kb][i] = p; sum += p; }
    sum += __shfl_xor(sum, 32);
    const float inv = 1.f / (sum + __expf(sink - mx));
    f32x16 o0, o1;
#pragma unroll
    for (int i = 0; i < 16; ++i) { o0[i] = 0.f; o1[i] = 0.f; }
#pragma unroll
    for (int kb = 0; kb < 5; ++kb)
#pragma unroll
        for (int s = 0; s < 2; ++s) {
            u32x4 pw; pw.x = cvtpk(st[kb][8 * s], st[kb][8 * s + 1]); pw.y = cvtpk(st[kb][8 * s + 2], st[kb][8 * s + 3]); pw.z = cvtpk(st[kb][8 * s + 4], st[kb][8 * s + 5]); pw.w = cvtpk(st[kb][8 * s + 6], st[kb][8 * s + 7]);
            const bf16x8 pf = __builtin_bit_cast(bf16x8, pw);
#pragma unroll
            for (int db = 0; db < 2; ++db) {
                const u32x2 va = vfa[kb][s][db], vb = vfb[kb][s][db];
                u32x4 vw; vw.x = va.x; vw.y = va.y; vw.z = vb.x; vw.w = vb.y;
                const bf16x8 vf = __builtin_bit_cast(bf16x8, vw);
                if (db == 0) o0 = MFMA32(vf, pf, o0); else o1 = MFMA32(vf, pf, o1);
            }
        }
    bf16* op = ATT + (size_t)qi * 512 + head * 64 + 4 * h;
#pragma unroll
    for (int g = 0; g < 4; ++g) {
        u32x2 w; w.x = cvtpk(o0[4 * g] * inv, o0[4 * g + 1] * inv); w.y = cvtpk(o0[4 * g + 2] * inv, o0[4 * g + 3] * inv); *(u32x2*)(op + 8 * g) = w;
        u32x2 w2; w2.x = cvtpk(o1[4 * g] * inv, o1[4 * g + 1] * inv); w2.y = cvtpk(o1[4 * g + 2] * inv, o1[4 * g + 3] * inv); *(u32x2*)(op + 32 + 8 * g) = w2;
    }
}

__device__ __forceinline__ void attn_sample_item(const Params& P, LAS unsigned char* lds, int l, int db, int kvh, int tid_in) {
    const int tid = tid_in, lane = tid & 63, wid = tid >> 6;
    LAS float* Ks = (LAS float*)lds;
    LAS float* Vs = Ks + 132 * 65;
    LAS float* qs = Vs + 132 * 64;
    LAS float* S = qs + 16 * 64;
    const bf16* Q = (const bf16*)((const unsigned char*)P.out + OB_Q); bf16* ATT = (bf16*)((unsigned char*)P.out + OB_ATT);
    const size_t cbase = (size_t)(l * 128 + db) * 128;
#pragma unroll
    for (int k = 0; k < 5; ++k) {
        const int e = tid + 512 * k;
        if (e < 132 * 16) {
            const int key = e >> 4, d4 = (e & 15) * 4;
            f32x4 kv, vv;
            if (key < 128) { kv = *(const f32x4*)(P.in[I_CK] + ((cbase + key) * 2 + kvh) * 64 + d4); vv = *(const f32x4*)(P.in[I_CV] + ((cbase + key) * 2 + kvh) * 64 + d4); }
            else { kv = *(const f32x4*)(P.out + O_WKS + ((cbase + key - 4) * 2 + kvh) * 64 + d4); vv = *(const f32x4*)(P.out + O_WVS + ((cbase + key - 4) * 2 + kvh) * 64 + d4); }
            Ks[key * 65 + d4] = kv[0]; Ks[key * 65 + d4 + 1] = kv[1]; Ks[key * 65 + d4 + 2] = kv[2]; Ks[key * 65 + d4 + 3] = kv[3];
            *(LAS f32x4*)(Vs + key * 64 + d4) = vv;
            if (key >= 4 && key < 128) { *(f32x4*)(P.out + O_WKS + ((cbase + key - 4) * 2 + kvh) * 64 + d4) = kv; *(f32x4*)(P.out + O_WVS + ((cbase + key - 4) * 2 + kvh) * 64 + d4) = vv; }
        }
    }
    for (int e = tid; e < 16 * 64; e += 512) {
        const int row = e >> 6, d = e & 63, g = row >> 2, s = row & 3, p = d < 32 ? 2 * d : 2 * (d - 32) + 1;
        qs[e] = bf2f(Q[(size_t)(NPT + db * 4 + s) * 512 + (kvh * 4 + g) * 64 + p]);
    }
    __syncthreads();
    for (int e = tid; e < 16 * 132; e += 512) {
        const int row = e / 132, key = e % 132, s = row & 3;
        float acc = 0.f;
#pragma unroll 16
        for (int d = 0; d < 64; ++d) acc += qs[row * 64 + d] * Ks[key * 65 + d];
        const bool ok = key < 128 ? key > s : (key - 128) <= s;
        S[e] = ok ? acc : -1e30f;
    }
    __syncthreads();
    for (int rr = 0; rr < 2; ++rr) {
        const int row = wid * 2 + rr, g = row >> 2; const float sink = P.in[I_SINK][l * 8 + kvh * 4 + g];
        float v0 = S[row * 132 + lane], v1 = S[row * 132 + 64 + lane], v2 = lane < 4 ? S[row * 132 + 128 + lane] : -1e30f;
        float mx = fmaxf(fmaxf(v0, v1), fmaxf(v2, sink));
#pragma unroll
        for (int o = 1; o < 64; o <<= 1) mx = fmaxf(mx, __shfl_xor(mx, o));
        const float p0 = v0 > -1e29f ? __expf(v0 - mx) : 0.f, p1 = v1 > -1e29f ? __expf(v1 - mx) : 0.f, p2 = v2 > -1e29f ? __expf(v2 - mx) : 0.f;
        float sum = p0 + p1 + p2;
#pragma unroll
        for (int o = 1; o < 64; o <<= 1) sum += __shfl_xor(sum, o);
        const float inv = 1.f / (sum + __expf(sink - mx));
        S[row * 132 + lane] = p0 * inv; S[row * 132 + 64 + lane] = p1 * inv; if (lane < 4) S[row * 132 + 128 + lane] = p2 * inv;
    }
    __syncthreads();
    for (int e = tid; e < 16 * 64; e += 512) {
        const int row = e >> 6, d = e & 63, g = row >> 2, s = row & 3;
        float acc = 0.f;
#pragma unroll 4
        for (int key = 0; key < 132; ++key) acc += S[row * 132 + key] * Vs[key * 64 + d];
        ATT[(size_t)(NPT + db * 4 + s) * 512 + (kvh * 4 + g) * 64 + d] = f2bf(acc);
    }
    __syncthreads();
}

constexpr int MAIN_ROWS = 16384, TAIL_TILES = ((M - MAIN_ROWS) / 64) * 16;
static_assert((M - MAIN_ROWS) % 64 == 0 && TAIL_TILES <= 256, "tail tiling");
struct TailEpi { bf16* S; const bf16* A; float* Z; bf16* ZB; const float* pst; const float* pg; const float* pb; float* ost; };
template <int EPI> __device__ __forceinline__ void tail_gemm(LAS unsigned char* lds, const bf16* Am, const bf16* Bt, int K, const TailEpi& E, int tid_in) {
    for (int su = blockIdx.x; su < TAIL_TILES; su += gridDim.x) {
    const int tid = tid_in, lane = tid & 63, w = tid >> 6, l15 = lane & 15, q4 = lane >> 4;
    const int row0 = MAIN_ROWS + (su >> 4) * 64, col0 = (su & 15) * 64;
    f32x4 acc[4][4];
#pragma unroll
    for (int i = 0; i < 4; ++i)
#pragma unroll
        for (int j = 0; j < 4; ++j) acc[i][j] = (f32x4){0.f, 0.f, 0.f, 0.f};
    const bf16* ap = Am + (size_t)(row0 + l15) * K + q4 * 8;
    const bf16* bp = Bt + (size_t)(col0 + l15) * K + q4 * 8;
    {
        const int nks = K / 32;
        bf16x8 a0[4], b0[4], a1[4], b1[4], a2[4], b2[4];
#define TG_LOAD(A_, B_, KS_) do { const int ks_ = (KS_) < nks ? (KS_) : w; _Pragma("unroll") for (int i = 0; i < 4; ++i) { A_[i] = *(const bf16x8*)(ap + (size_t)i * 16 * K + ks_ * 32); B_[i] = *(const bf16x8*)(bp + (size_t)i * 16 * K + ks_ * 32); } } while (0)
#define TG_MMA(A_, B_) do { _Pragma("unroll") for (int i = 0; i < 4; ++i) _Pragma("unroll") for (int j = 0; j < 4; ++j) acc[i][j] = __builtin_amdgcn_mfma_f32_16x16x32_bf16(A_[i], B_[j], acc[i][j], 0, 0, 0); } while (0)
        TG_LOAD(a0, b0, w); TG_LOAD(a1, b1, w + 8);
        for (int ks = w; ks < nks; ks += 24) {
            TG_LOAD(a2, b2, ks + 16); TG_MMA(a0, b0);
            if (ks + 8 < nks) { TG_LOAD(a0, b0, ks + 24); TG_MMA(a1, b1); }
            if (ks + 16 < nks) { TG_LOAD(a1, b1, ks + 32); TG_MMA(a2, b2); }
        }
#undef TG_LOAD
#undef TG_MMA
    }
    LAS float* part = (LAS float*)lds + (size_t)w * 64 * 65;
#pragma unroll
    for (int i = 0; i < 4; ++i)
#pragma unroll
        for (int j = 0; j < 4; ++j)
#pragma unroll
            for (int r = 0; r < 4; ++r) part[(16 * i + 4 * q4 + r) * 65 + 16 * j + l15] = acc[i][j][r];
    BAR_LDS();
    const int rl = tid >> 3, c8 = (tid & 7) * 8, row = row0 + rl, col = col0 + c8;
    f32x4 v0 = {0.f, 0.f, 0.f, 0.f}, v1 = v0;
#pragma unroll
    for (int ww = 0; ww < 8; ++ww) { const LAS float* p = (const LAS float*)lds + (size_t)ww * 64 * 65 + rl * 65 + c8;
        v0[0] += p[0]; v0[1] += p[1]; v0[2] += p[2]; v0[3] += p[3]; v1[0] += p[4]; v1[1] += p[5]; v1[2] += p[6]; v1[3] += p[7]; }
    const size_t off = (size_t)row * 1024 + col;
    if (EPI == 0 || EPI == 1) {
        const u32x4 s = *(const u32x4*)(E.S + off);
        v0[0] *= bflo(s.x); v0[1] *= bfhi(s.x); v0[2] *= bflo(s.y); v0[3] *= bfhi(s.y); v1[0] *= bflo(s.z); v1[1] *= bfhi(s.z); v1[2] *= bflo(s.w); v1[3] *= bfhi(s.w);
        if (EPI == 1) { const u32x4 a = *(const u32x4*)(E.A + off);
            v0[0] += bflo(a.x); v0[1] += bfhi(a.x); v0[2] += bflo(a.y); v0[3] += bfhi(a.y); v1[0] += bflo(a.z); v1[1] += bfhi(a.z); v1[2] += bflo(a.w); v1[3] += bfhi(a.w); }
        *(u32x4*)(E.S + off) = pack8(v0, v1);
    } else {
        const u32x4 zw = *(const u32x4*)(E.ZB + off);
        f32x4 x0 = {bflo(zw.x), bfhi(zw.x), bflo(zw.y), bfhi(zw.y)}, x1 = {bflo(zw.z), bfhi(zw.z), bflo(zw.w), bfhi(zw.w)};
        if (E.pst) {
            const f32x4* sp = (const f32x4*)(E.pst + (size_t)row * 32); float s = 0.f, q = 0.f;
#pragma unroll
            for (int i = 0; i < 8; ++i) { const f32x4 t = sp[i]; s += t[0] + t[2]; q += t[1] + t[3]; }
            const float mu = s * (1.f / D), rstd = __builtin_amdgcn_rsqf(fmaxf(q * (1.f / D) - mu * mu, 0.f) + LN_EPS);
            const f32x4 g0 = *(const f32x4*)(E.pg + col), g1 = *(const f32x4*)(E.pg + col + 4), b0 = *(const f32x4*)(E.pb + col), b1 = *(const f32x4*)(E.pb + col + 4);
            x0 = (x0 - mu) * rstd * g0 + b0; x1 = (x1 - mu) * rstd * g1 + b1;
        }
        x0 = x0 * ALPHA + v0; x1 = x1 * ALPHA + v1;
        if (E.Z) { *(f32x4*)(E.Z + off) = x0; *(f32x4*)(E.Z + off + 4) = x1; }
        *(u32x4*)(E.ZB + off) = pack8(x0, x1);
        float s = ((x0[0] + x0[1]) + (x0[2] + x0[3])) + ((x1[0] + x1[1]) + (x1[2] + x1[3]));
        float q = ((x0[0] * x0[0] + x0[1] * x0[1]) + (x0[2] * x0[2] + x0[3] * x0[3])) + ((x1[0] * x1[0] + x1[1] * x1[1]) + (x1[2] * x1[2] + x1[3] * x1[3]));
        s += __shfl_xor(s, 1); q += __shfl_xor(q, 1); s += __shfl_xor(s, 2); q += __shfl_xor(q, 2); s += __shfl_xor(s, 4); q += __shfl_xor(q, 4);
        if ((tid & 7) == 0) { typedef float f32x2v __attribute__((ext_vector_type(2))); *(f32x2v*)(E.ost + (size_t)row * 32 + (su & 15) * 2) = (f32x2v){s, q}; }
    }
    BAR_LDS();
    }
}

#define XB_TMO      128
#define XB_XCNT(j)  (256  + 64 * (j))
#define XB_XSUB(j)  (1280 + 64 * (j))
#define XB_XGEN(j)  (2304 + 64 * (j))
#define XB_TOP      3328
#define XB_TOPGEN   3392
#define XCD_BAR_WORDS 3456
#define XB_SPIN_CAP (1u << 18)

__device__ __forceinline__ unsigned xb_ld(unsigned* p)              { return __hip_atomic_load(p, __ATOMIC_RELAXED, __HIP_MEMORY_SCOPE_AGENT); }
__device__ __forceinline__ unsigned xb_add(unsigned* p, unsigned v) { return __hip_atomic_fetch_add(p, v, __ATOMIC_RELAXED, __HIP_MEMORY_SCOPE_AGENT); }
__device__ __forceinline__ unsigned xb_xcc_id() { return (unsigned)__builtin_amdgcn_s_getreg((3 << 11) | 20) & 0xFu; }
#define XB_SPIN(cond, bar) do { unsigned _sp = 0; while (cond) { __builtin_amdgcn_s_sleep(1); \
    if ((++_sp & 255u) == 0u) { if (xb_ld(&(bar)[XB_TMO])) break; if (_sp > XB_SPIN_CAP) { atomicAdd(&(bar)[XB_TMO], 1u); break; } } } } while (0)

struct XcdBarrier {
    unsigned* bar; unsigned x;
    volatile LAS unsigned* st;
};

__device__ __forceinline__ XcdBarrier xcd_barrier_post(unsigned* bar, volatile LAS unsigned* st, int xb_tid) {
    XcdBarrier b; b.bar = bar; b.x = xb_xcc_id(); b.st = st;
    if (xb_tid == 0) (void)xb_add(&bar[XB_XCNT(b.x)], 1u);
    return b;
}
__device__ __forceinline__ void xcd_barrier_complete(unsigned* bar, unsigned x, unsigned& nloc, unsigned& nx) {
    const unsigned G = gridDim.x * gridDim.y * gridDim.z;
    unsigned sum, cnt, mine, sp = 0u;
    for (;;) {
        sum = 0u; cnt = 0u; mine = 0u;
#pragma unroll
        for (unsigned j = 0; j < 16; ++j) { const unsigned c = xb_ld(&bar[XB_XCNT(j)]); sum += c; cnt += (c > 0u) ? 1u : 0u; mine = (j == x) ? c : mine; }
        if (sum == G) break;
        __builtin_amdgcn_s_sleep(1);
        if ((++sp & 255u) == 0u) { if (xb_ld(&bar[XB_TMO])) break; if (sp > XB_SPIN_CAP) { atomicAdd(&bar[XB_TMO], 1u); break; } }
    }
    nloc = mine > 0u ? mine : 1u; nx = cnt > 0u ? cnt : 1u;
}

__device__ __forceinline__ void xcd_barrier(const XcdBarrier& b, int xb_tid) {
    asm volatile("s_waitcnt vmcnt(0)" ::: "memory");
    __syncthreads();
    if (xb_tid == 0) {
        unsigned* bar = b.bar;
        __builtin_amdgcn_s_waitcnt(0);
        unsigned nloc = b.st[0], nx = b.st[1];
        if (nloc == 0u) { xcd_barrier_complete(bar, b.x, nloc, nx); b.st[0] = nloc; b.st[1] = nx; }
        const unsigned old = xb_add(&bar[XB_XSUB(b.x)], 1u);
        const unsigned gen = old / nloc;
        if (old + 1u == (gen + 1u) * nloc) {
            __builtin_amdgcn_fence(__ATOMIC_RELEASE, "agent");
            asm volatile("s_waitcnt vmcnt(0)" ::: "memory");
            const unsigned og = xb_add(&bar[XB_TOP], 1u);
            const unsigned tg = og / nx;
            if (og + 1u == (tg + 1u) * nx) xb_add(&bar[XB_TOPGEN], 1u);
            else XB_SPIN(xb_ld(&bar[XB_TOPGEN]) == tg, bar);
            __builtin_amdgcn_fence(__ATOMIC_ACQUIRE, "agent");
            xb_add(&bar[XB_XGEN(b.x)], 1u);
            asm volatile("s_waitcnt vmcnt(0)" ::: "memory");
        } else {
            XB_SPIN(xb_ld(&bar[XB_XGEN(b.x)]) == gen, bar);
            __builtin_amdgcn_fence(__ATOMIC_ACQUIRE, "agent");
            asm volatile("s_waitcnt vmcnt(0)" ::: "memory");
        }
    }
    __syncthreads();
}

__global__ void __launch_bounds__(512, 2) fwd_mega(Params P) {
    extern __shared__ __attribute__((aligned(16))) unsigned char lds_raw[];
    LAS unsigned char* lds = (LAS unsigned char*)lds_raw;
    cg::grid_group grid = cg::this_grid();
    unsigned char* ws = P.ws;
    const int G = gridDim.x, bx = blockIdx.x;
    const int wv = __builtin_amdgcn_readfirstlane((int)(threadIdx.x >> 6));
    bf16* XB = (bf16*)(ws + WS_XB); float* X = (float*)(ws + WS_X);
    bf16* Qb = (bf16*)((unsigned char*)P.out + OB_Q); bf16* ATT = (bf16*)((unsigned char*)P.out + OB_ATT);
    bf16 *KB = (bf16*)(ws + WS_KB), *VT = (bf16*)(ws + WS_VT), *XR = (bf16*)(ws + WS_XR), *GG = (bf16*)(ws + WS_GG), *SA = (bf16*)(ws + WS_SA), *SL = (bf16*)(ws + WS_SL), *H = (bf16*)(ws + WS_H);

    if (threadIdx.x < 4) ((volatile LAS unsigned*)(lds + LDS_ST))[threadIdx.x] = 0u;
    __syncthreads();
    const XcdBarrier xbar = xcd_barrier_post((unsigned*)(ws + WS_BAR), (volatile LAS unsigned*)(lds + LDS_ST), mk_tid(wv));
    if (G == 0x7fffffff) grid.sync();
#ifndef NO_P0
    prologue(P, lds, mk_tid(wv));
    if (DUP_P0) { __syncthreads(); prologue(P, lds, mk_tid(wv)); }
#endif
    GSYNC();
    {
        const float* part = (const float*)(ws + WS_PART); float* c12 = (float*)(ws + WS_C12);
        for (int e = bx * 512 + (int)threadIdx.x; e < DEPTH * NC12 * 2; e += G * 512) { const int l = e / (NC12 * 2), r = e % (NC12 * 2); float s = 0.f;
#pragma unroll
            for (int kb = 0; kb < 16; ++kb) s += part[((size_t)l * 16 + kb) * NC12 * 2 + r];
            c12[e] = s; }
    }
    for (int l = 0; l < DEPTH; ++l) {
        {
            pg8::Gemm g{XB, (const bf16*)(ws + WS_WIN + l * SZ_WIN), MP, DIN, D}; int bxl = bx, Gl = G; asm volatile("" : "+s"(bxl), "+s"(Gl)); pg8::StaticOrder S; S.init(MP, DIN, Gl, bxl);
            EpiProj E{l, Qb, KB, VT, XR, (const float*)(ws + WS_ROPE), P.out, l > 0 ? (const float*)(ws + WS_SS) + (size_t)((2 * l - 1) % 3) * SS_INST : nullptr, (const float*)(ws + WS_C12) + (size_t)l * NC12 * 2, 4 * l + 1};
#ifndef NO_G1
            pg8::gemm_phase<EpiProj, pg8::StaticOrder, true, true>(lds, g, S, E, mk_tid(wv));
            if (DUP_G1) { __syncthreads(); pg8::gemm_phase<EpiProj, pg8::StaticOrder, true, true>(lds, g, S, E, mk_tid(wv)); }
#endif
        }
        GSYNC();
        if (DUP_ATT) { for (int it = bx; it < 772; it += G) { if (it < 516) attn_prompt_wave(P, l, it, mk_tid(wv)); else attn_sample_item(P, lds, l, (it - 516) >> 1, (it - 516) & 1, mk_tid(wv)); } __syncthreads(); }
        for (int it = G - 1 - bx; it < 772; it += G) { if (it < 516) attn_prompt_wave(P, l, it, mk_tid(wv)); else attn_sample_item(P, lds, l, (it - 516) >> 1, (it - 516) & 1, mk_tid(wv)); }
        __syncthreads();
#ifndef NO_LRU1
        lru_phase<1>(P, lds, l, mk_tid(wv));
#endif
        GSYNC();
        {
            pg8::Gemm g{ATT, (const bf16*)(ws + WS_WAP + l * SZ_WAP), MAIN_ROWS, D, 512}; int bxl = bx, Gl = G; asm volatile("" : "+s"(bxl), "+s"(Gl)); pg8::StaticOrder S; S.init(MAIN_ROWS, D, Gl, bxl);
            EpiGate<false> E{SA, nullptr};
#ifndef NO_G3
            pg8::gemm_phase<EpiGate<false>, pg8::StaticOrder, true, true>(lds, g, S, E, mk_tid(wv));
            { TailEpi T{SA, nullptr, nullptr, nullptr, nullptr, nullptr, nullptr, nullptr}; tail_gemm<0>(lds, ATT, (const bf16*)(ws + WS_WAP + l * SZ_WAP), 512, T, mk_tid(wv)); }
#endif
        }
        __syncthreads();
        {
            pg8::Gemm g{GG, (const bf16*)(ws + WS_WLP + l * SZ_WLP), MAIN_ROWS, D, D}; int bxl = bx, Gl = G; asm volatile("" : "+s"(bxl), "+s"(Gl)); pg8::StaticOrder S; S.init(MAIN_ROWS, D, Gl, bxl);
            EpiGate<true> E{SL, SA};
#ifndef NO_G4
            pg8::gemm_phase<EpiGate<true>, pg8::StaticOrder, true, true>(lds, g, S, E, mk_tid(wv));
            { TailEpi T{SL, SA, nullptr, nullptr, nullptr, nullptr, nullptr, nullptr}; tail_gemm<1>(lds, GG, (const bf16*)(ws + WS_WLP + l * SZ_WLP), D, T, mk_tid(wv)); }
#endif
        }
        GSYNC();
        {
            pg8::Gemm g{SL, (const bf16*)(ws + WS_WOUT + l * SZ_WOUT), MAIN_ROWS, D, D}; int bxl = bx, Gl = G; asm volatile("" : "+s"(bxl), "+s"(Gl)); pg8::StaticOrder S; S.init(MAIN_ROWS, D, Gl, bxl);
            EpiRes E{nullptr, XB, l > 0 ? (const float*)(ws + WS_SS) + (size_t)((2 * l - 1) % 3) * SS_INST : nullptr, P.in[I_L2G] + (l > 0 ? l - 1 : 0) * D, P.in[I_L2B] + (l > 0 ? l - 1 : 0) * D, (float*)(ws + WS_SS) + (size_t)((2 * l) % 3) * SS_INST, 4 * l + 2};
#ifndef NO_G5
            pg8::gemm_phase<EpiRes, pg8::StaticOrder, true, true>(lds, g, S, E, mk_tid(wv));
            { TailEpi T{nullptr, nullptr, E.Z, E.ZB, E.pst, E.pg, E.pb, E.ost}; tail_gemm<2>(lds, SL, (const bf16*)(ws + WS_WOUT + l * SZ_WOUT), D, T, mk_tid(wv)); }
#endif
        }
        GSYNC();
        {
            pg8::Gemm g{XB, (const bf16*)(ws + WS_WFI + l * SZ_WFI), MP, 2 * DFF, D}; int bxl = bx, Gl = G; asm volatile("" : "+s"(bxl), "+s"(Gl)); pg8::StaticOrder S; S.init(MP, 2 * DFF, Gl, bxl);
            EpiSwiglu E{H, (const float*)(ws + WS_SS) + (size_t)((2 * l) % 3) * SS_INST, (const float*)(ws + WS_C12) + ((size_t)l * NC12 + DIN) * 2, 4 * l + 3};
#ifndef NO_G6
            pg8::gemm_phase<EpiSwiglu, pg8::StaticOrder, true, true>(lds, g, S, E, mk_tid(wv));
            if (DUP_G6) { __syncthreads(); pg8::gemm_phase<EpiSwiglu, pg8::StaticOrder, true, true>(lds, g, S, E, mk_tid(wv)); }
#endif
        }
        GSYNC();
        {
            pg8::Gemm g{H, (const bf16*)(ws + WS_WFO + l * SZ_WFO), MAIN_ROWS, D, DFF}; int bxl = bx, Gl = G; asm volatile("" : "+s"(bxl), "+s"(Gl)); pg8::StaticOrder S; S.init(MAIN_ROWS, D, Gl, bxl);
            EpiRes E{l == DEPTH - 1 ? X : nullptr, XB, (const float*)(ws + WS_SS) + (size_t)((2 * l) % 3) * SS_INST, P.in[I_L1G] + l * D, P.in[I_L1B] + l * D, (float*)(ws + WS_SS) + (size_t)((2 * l + 1) % 3) * SS_INST, 4 * l + 4};
#ifndef NO_G5
            if (DUP_G7) { EpiRes E2{nullptr, (bf16*)(ws + WS_R + (size_t)100 * 1024 * 1024), E.pst, E.pg, E.pb, (float*)(ws + WS_SS) + (size_t)((2 * l + 2) % 3) * SS_INST, 0};
                pg8::gemm_phase<EpiRes, pg8::StaticOrder, true, true>(lds, g, S, E2, mk_tid(wv)); __syncthreads(); }
            pg8::gemm_phase<EpiRes, pg8::StaticOrder, true, true>(lds, g, S, E, mk_tid(wv));
            { TailEpi T{nullptr, nullptr, E.Z, E.ZB, E.pst, E.pg, E.pb, E.ost}; tail_gemm<2>(lds, H, (const bf16*)(ws + WS_WFO + l * SZ_WFO), DFF, T, mk_tid(wv)); }
#endif
        }
        GSYNC();
    }
    ln_pass<true>(P, P.in[I_L2G] + (DEPTH - 1) * D, P.in[I_L2B] + (DEPTH - 1) * D, mk_tid(wv));
}

extern "C" void kernel_launch(void* const* d_in, const int* in_sizes, int n_in, void* d_out, int out_size, void* d_ws, size_t ws_size, hipStream_t stream) {
    static int grid = 0;
    if (grid == 0) {
        if (n_in != 25 || (size_t)out_size != O_END || ws_size < WS_TOTAL) { fprintf(stderr, "kernel_launch: unexpected shapes (n_in %d out %d ws %zu need %zu)\n", n_in, out_size, ws_size, (size_t)WS_TOTAL); grid = -1; return; }
        int dev = 0, cus = 0, per = 0;
        if (hipGetDevice(&dev) != hipSuccess || hipDeviceGetAttribute(&cus, hipDeviceAttributeMultiprocessorCount, dev) != hipSuccess) { grid = -1; return; }
        if (hipFuncSetAttribute((const void*)fwd_mega, hipFuncAttributeMaxDynamicSharedMemorySize, LDS_BYTES) != hipSuccess) { fprintf(stderr, "hipFuncSetAttribute failed\n"); grid = -1; return; }
        if (hipOccupancyMaxActiveBlocksPerMultiprocessor(&per, (const void*)fwd_mega, 512, LDS_BYTES) != hipSuccess || per < 1) { fprintf(stderr, "occupancy query: %d\n", per); per = 1; }
        (void)hipGetLastError();
        grid = cus & ~7;
        if (grid < 8) { grid = -1; return; }
    }
    if (grid < 0) return;
    if (hipMemsetAsync((unsigned char*)d_ws + WS_BAR, 0, 16384, stream) != hipSuccess) { fprintf(stderr, "kernel_launch: hipMemsetAsync of the barrier words failed\n"); return; }
    Params p{};
    for (int i = 0; i < 25; ++i) p.in[i] = (const float*)d_in[i];
    p.out = (float*)d_out; p.ws = (unsigned char*)d_ws;
    void* args[] = {&p};
    hipError_t e = hipLaunchCooperativeKernel((const void*)fwd_mega, dim3(grid), dim3(512), args, LDS_BYTES, stream);
    if (e != hipSuccess) fprintf(stderr, "cooperative launch failed: %s (grid %d)\n", hipGetErrorString(e), grid);
}
```

```cpp
#include <hip/hip_runtime.h>
#include <hip/hip_cooperative_groups.h>
#include <cstdio>
#include <cstdint>
namespace cg = cooperative_groups;
namespace pg8 {
#define PG8_LAS __attribute__((address_space(3)))
typedef unsigned short bf16_t;
typedef short bf16x8 __attribute__((ext_vector_type(8)));
typedef float f32x4 __attribute__((ext_vector_type(4)));
typedef unsigned u32x4 __attribute__((ext_vector_type(4)));
constexpr int BM = 256, BK = 64, HALF = 128, HTB = HALF * BK * 2  , STAGE_BYTES = 8 * HTB, NXCD = 8, WGM = 8;

__host__ __device__ __forceinline__ int lds_byte(int r, int c) { const int st = (r >> 4) * 2 + (c >> 5), rr = r & 15, cc = c & 31, ob = rr * 64 + cc * 2; return st * 1024 + (ob ^ (((ob >> 9) & 1) << 5)); }
__host__ __device__ __forceinline__ void stage_rc(int b, int& R, int& C) { const int st = b / 1024, sb = b % 1024, swz = sb ^ (((sb >> 9) & 1) << 5); R = (st >> 1) * 16 + swz / 64; C = (st & 1) * 32 + (swz % 64) / 2; }
__host__ __device__ __forceinline__ int perm32(int rho) { const int n = rho >> 4, i = rho & 15; return 8 * (i >> 2) + 4 * n + (i & 3); }

struct Unit { int pm, pn; };
struct Gemm { const bf16_t* A; const bf16_t* Bt; int M, N, K; };

struct StaticOrder {
    int nM, nN, nwg, G, c;
    __host__ __device__ void init(int M, int N, int G_, int c_) { nM = M / BM; nN = N / BM; nwg = nM * nN; G = G_; c = c_; }
    __host__ __device__ bool next(int i, Unit& u) const {
        const long L = (long)i * G + c; if (L >= nwg) return false;
        int wgid = (int)L; { const int q = nwg / NXCD, r = nwg % NXCD, xcd = wgid % NXCD, off = wgid / NXCD; wgid = (xcd < r ? xcd * (q + 1) : r * (q + 1) + (xcd - r) * q) + off; }
        const int nig = WGM * nN, gid = wgid / nig, fm = gid * WGM, gsz = (nM - fm) < WGM ? (nM - fm) : WGM;
        u.pm = fm + ((wgid % nig) % gsz); u.pn = (wgid % nig) / gsz; return true;
    }
    __device__ __forceinline__ void a_ready(const Unit&) const {}
    __device__ __forceinline__ void done(const Unit&) const {}
};

template <class Epi, class Sched, bool ALIGN_EPI = false, bool SP2 = false>
__device__ __forceinline__ void gemm_phase(PG8_LAS unsigned char* lds, const Gemm g, const Sched& S, const Epi& E, int tid_in) {
    int tid_ = tid_in; asm volatile("" : "+v"(tid_));
    const int tid = tid_, wid = __builtin_amdgcn_readfirstlane(tid >> 6), lane = tid & 63, wr = wid >> 2, wc = wid & 3, fr = lane & 15, fq = lane >> 4;
    const int K = g.K, nt = K / BK;
    unsigned voffA[2], voffB[2];
#pragma unroll
    for (int i = 0; i < 2; ++i) { int R, C; stage_rc(tid * 16 + i * 8192, R, C); const int Rb = Epi::PERM ? ((R & ~31) + perm32(R & 31)) : R;
        voffA[i] = (unsigned)(R * K + C) * 2u; voffB[i] = (unsigned)(Rb * K + C) * 2u; }
    const size_t kstep = (size_t)(BK * 2);
    const size_t hstep = (size_t)HALF * K * 2;
    const size_t tstep = 2 * hstep;
    const unsigned ldsw = (unsigned)wid * 1024u;
    const int aoff = lds_byte(wr * 64 + fr, fq * 8), boff = lds_byte(wc * 32 + fr, fq * 8);
#define PG8_SA(b, h) (((b) * 2 + (h)) * HTB)
#define PG8_SB(b, h) ((4 + (b) * 2 + (h)) * HTB)
#define PG8_STAGE(bufoff, gbase, voff) do { _Pragma("unroll") for (int _i = 0; _i < 2; ++_i) \
        __builtin_amdgcn_global_load_lds((const unsigned*)((const char*)(gbase) + (voff)[_i]), (PG8_LAS unsigned*)(lds + (bufoff) + ldsw + _i * 8192), 16, 0, 0); } while (0)
#define PG8_LDA(dst, b, h) do { _Pragma("unroll") for (int m = 0; m < 4; ++m) _Pragma("unroll") for (int k = 0; k < 2; ++k) dst[m][k] = *(const PG8_LAS bf16x8*)(lds + PG8_SA(b, h) + aoff + m * 2048 + k * 1024); } while (0)
#define PG8_LDB(dst, b, h) do { _Pragma("unroll") for (int n = 0; n < 2; ++n) _Pragma("unroll") for (int k = 0; k < 2; ++k) dst[n][k] = *(const PG8_LAS bf16x8*)(lds + PG8_SB(b, h) + boff + n * 2048 + k * 1024); } while (0)
#define PG8_MMA(ai, bj, At, Bt) do { __builtin_amdgcn_s_setprio(1); _Pragma("unroll") for (int m = 0; m < 4; ++m) _Pragma("unroll") for (int n = 0; n < 2; ++n) _Pragma("unroll") for (int k = 0; k < 2; ++k) \
        acc[ai][bj][m][n] = __builtin_amdgcn_mfma_f32_16x16x32_bf16(Bt[n][k], At[m][k], acc[ai][bj][m][n], 0, 0, 0); __builtin_amdgcn_s_setprio(0); } while (0)
#define PG8_WAIT_V(n) asm volatile("s_waitcnt vmcnt(" #n ")" ::: "memory")
#define PG8_WAIT_L(n) asm volatile("s_waitcnt lgkmcnt(" #n ")" ::: "memory")
#define PG8_BAR __builtin_amdgcn_s_barrier()
#define PG8_SCHED __builtin_amdgcn_sched_barrier(0)
    Unit cur, nxt; int ui = 0;
    if (!S.next(0, cur)) return;
    f32x4 acc[2][2][4][2];
#pragma unroll
    for (int a = 0; a < 2; ++a)
#pragma unroll
        for (int b = 0; b < 2; ++b)
#pragma unroll
            for (int m = 0; m < 4; ++m)
#pragma unroll
                for (int n = 0; n < 2; ++n) acc[a][b][m][n] = (f32x4){0.f, 0.f, 0.f, 0.f};
    bf16x8 At[4][2], B0[2][2], B1[2][2];
    const char* cA = (const char*)g.A + (size_t)cur.pm * tstep; const char* cB = (const char*)g.Bt + (size_t)cur.pn * tstep;
    S.a_ready(cur);
    if constexpr (SP2) {
        PG8_STAGE(PG8_SB(0, 0), cB, voffB); PG8_STAGE(PG8_SB(0, 1), cB + hstep, voffB); PG8_STAGE(PG8_SA(0, 0), cA, voffA); PG8_STAGE(PG8_SA(0, 1), cA + hstep, voffA);
        if (wr == 1) PG8_BAR;
        PG8_WAIT_V(2); PG8_BAR;
        PG8_STAGE(PG8_SB(1, 0), cB + kstep, voffB); PG8_STAGE(PG8_SA(1, 0), cA + kstep, voffA); PG8_STAGE(PG8_SB(1, 1), cB + hstep + kstep, voffB);
        PG8_WAIT_V(6); PG8_BAR;
    } else {
        PG8_STAGE(PG8_SB(0, 0), cB, voffB); PG8_STAGE(PG8_SA(0, 0), cA, voffA); PG8_STAGE(PG8_SB(0, 1), cB + hstep, voffB); PG8_STAGE(PG8_SA(0, 1), cA + hstep, voffA);
        if (wr == 1) PG8_BAR;
        PG8_WAIT_V(4); PG8_BAR;
        PG8_STAGE(PG8_SB(1, 0), cB + kstep, voffB); PG8_STAGE(PG8_SA(1, 0), cA + kstep, voffA); PG8_STAGE(PG8_SB(1, 1), cB + hstep + kstep, voffB);
        PG8_WAIT_V(6); PG8_BAR;
    }
    for (;;) {
        const bool has_next = S.next(ui + 1, nxt);
        const char* nA = has_next ? (const char*)g.A + (size_t)nxt.pm * tstep : cA; const char* nB = has_next ? (const char*)g.Bt + (size_t)nxt.pn * tstep : cB;
        for (int t = 0; t < nt; t += 2) {
            const bool last = (t == nt - 2);
            const char* a1 = cA + (size_t)(t + 1) * kstep;
            const char* a2 = last ? nA : cA + (size_t)(t + 2) * kstep; const char* b2 = last ? nB : cB + (size_t)(t + 2) * kstep;
            const char* a3 = a2 + kstep; const char* b3 = b2 + kstep;
            if (last && has_next) S.a_ready(nxt);
            if constexpr (SP2) {
            PG8_LDB(B0, 0, 0); PG8_LDB(B1, 0, 1); PG8_SCHED; PG8_LDA(At, 0, 0); PG8_STAGE(PG8_SA(1, 1), a1 + hstep, voffA);
            PG8_WAIT_V(8); PG8_WAIT_L(0); PG8_BAR; PG8_MMA(0, 0, At, B0); PG8_MMA(0, 1, At, B1); PG8_BAR; PG8_SCHED;
            PG8_LDA(At, 0, 1); PG8_STAGE(PG8_SB(0, 0), b2, voffB); PG8_STAGE(PG8_SB(0, 1), b2 + hstep, voffB); PG8_STAGE(PG8_SA(0, 0), a2, voffA);
            PG8_WAIT_V(8); PG8_WAIT_L(0); PG8_BAR; PG8_MMA(1, 0, At, B0); PG8_MMA(1, 1, At, B1); PG8_BAR; PG8_SCHED;
            PG8_LDB(B0, 1, 0); PG8_LDB(B1, 1, 1); PG8_SCHED; PG8_LDA(At, 1, 0); PG8_STAGE(PG8_SA(0, 1), a2 + hstep, voffA);
            PG8_WAIT_V(8); PG8_WAIT_L(0); PG8_BAR; PG8_MMA(0, 0, At, B0); PG8_MMA(0, 1, At, B1); PG8_BAR; PG8_SCHED;
            PG8_LDA(At, 1, 1); PG8_STAGE(PG8_SB(1, 0), b3, voffB); PG8_STAGE(PG8_SB(1, 1), b3 + hstep, voffB); PG8_STAGE(PG8_SA(1, 0), a3, voffA);
            PG8_WAIT_V(8); PG8_WAIT_L(0); PG8_BAR; PG8_MMA(1, 0, At, B0); PG8_MMA(1, 1, At, B1); PG8_BAR; PG8_SCHED;
            } else {
            PG8_LDB(B0, 0, 0); PG8_SCHED; PG8_LDA(At, 0, 0); PG8_STAGE(PG8_SA(1, 1), a1 + hstep, voffA);
            PG8_WAIT_L(8); PG8_BAR; PG8_WAIT_L(0); PG8_MMA(0, 0, At, B0); PG8_BAR; PG8_SCHED;
            PG8_LDB(B1, 0, 1); PG8_STAGE(PG8_SB(0, 0), b2, voffB);
            PG8_BAR; PG8_WAIT_L(0); PG8_MMA(0, 1, At, B1); PG8_BAR;
            PG8_LDA(At, 0, 1); PG8_STAGE(PG8_SA(0, 0), a2, voffA);
            PG8_BAR; PG8_WAIT_L(0); PG8_MMA(1, 0, At, B0); PG8_BAR; PG8_SCHED;
            PG8_STAGE(PG8_SB(0, 1), b2 + hstep, voffB);
            PG8_WAIT_V(6); PG8_BAR; PG8_MMA(1, 1, At, B1); PG8_BAR;
            PG8_LDB(B0, 1, 0); PG8_SCHED; PG8_LDA(At, 1, 0); PG8_STAGE(PG8_SA(0, 1), a2 + hstep, voffA);
            PG8_WAIT_L(8); PG8_BAR; PG8_WAIT_L(0); PG8_MMA(0, 0, At, B0); PG8_BAR; PG8_SCHED;
            PG8_LDB(B1, 1, 1); PG8_STAGE(PG8_SB(1, 0), b3, voffB);
            PG8_BAR; PG8_WAIT_L(0); PG8_MMA(0, 1, At, B1); PG8_BAR;
            PG8_LDA(At, 1, 1); PG8_STAGE(PG8_SA(1, 0), a3, voffA);
            PG8_BAR; PG8_WAIT_L(0); PG8_MMA(1, 0, At, B0); PG8_BAR; PG8_SCHED;
            PG8_STAGE(PG8_SB(1, 1), b3 + hstep, voffB);
            PG8_WAIT_V(6); PG8_BAR; PG8_MMA(1, 1, At, B1); PG8_BAR;
            }
        }
        if constexpr (ALIGN_EPI) { if (wr == 0) PG8_BAR; }
        if constexpr (!Epi::AFTER_DRAIN) { E(acc, cur, wr, wc, fr, fq); S.done(cur); }
        if (!has_next) break;
#pragma unroll
        for (int a = 0; a < 2; ++a)
#pragma unroll
            for (int b = 0; b < 2; ++b)
#pragma unroll
                for (int m = 0; m < 4; ++m)
#pragma unroll
                    for (int n = 0; n < 2; ++n) acc[a][b][m][n] = (f32x4){0.f, 0.f, 0.f, 0.f};
        cur = nxt; cA = nA; cB = nB; ++ui;
        if constexpr (ALIGN_EPI) { if (wr == 1) PG8_BAR; }
    }
    PG8_WAIT_V(0);
    if constexpr (!ALIGN_EPI) { if (wr == 0) PG8_BAR; }
    PG8_BAR;
    if constexpr (Epi::AFTER_DRAIN) { E.fused(acc, cur, wr, wc, fr, fq, lds, wid, lane); S.done(cur); }
#undef PG8_SA
#undef PG8_SB
#undef PG8_STAGE
#undef PG8_LDA
#undef PG8_LDB
#undef PG8_MMA
#undef PG8_WAIT_V
#undef PG8_WAIT_L
#undef PG8_BAR
#undef PG8_SCHED
}
}
#ifndef DUP_SYNC
#define DUP_SYNC 0
#endif
#ifndef DUP_LRU0
#define DUP_LRU0 0
#endif
#ifndef DUP_ATT
#define DUP_ATT 0
#endif
#ifndef DUP_G1
#define DUP_G1 0
#endif
#ifndef DUP_P0
#define DUP_P0 0
#endif
#ifndef DUP_G6
#define DUP_G6 0
#endif
#ifndef DUP_G7
#define DUP_G7 0
#endif
#define GSYNC() do { xcd_barrier(xbar, mk_tid(wv)); if (DUP_SYNC) xcd_barrier(xbar, mk_tid(wv)); } while (0)
#define LAS __attribute__((address_space(3)))
typedef unsigned short bf16;
typedef float f32x4 __attribute__((ext_vector_type(4)));
typedef float f32x16 __attribute__((ext_vector_type(16)));
typedef short bf16x8 __attribute__((ext_vector_type(8)));
typedef short s16x4 __attribute__((ext_vector_type(4)));
typedef unsigned u32x4 __attribute__((ext_vector_type(4)));
typedef unsigned u32x2 __attribute__((ext_vector_type(2)));
typedef float f32x2_t __attribute__((ext_vector_type(2)));
typedef __bf16 bf16x2_t __attribute__((ext_vector_type(2)));

constexpr int D = 1024, LP = 2064, NPT = 8 * LP  , M = NPT + 512  , MP = 17152, DIN = 4864, DFF = 2816, DEPTH = 4;
constexpr int NTILE64 = M / 64;
constexpr float ALPHA = 1.6817928305074292f;
constexpr float LN_EPS = 1e-5f;
constexpr size_t O_YP = 0, O_YS = 16777216, O_WKP = 17301504, O_WVP = 17825792, O_CVP = 18350080, O_LRP = 18448384,
                 O_WKS = 18481152, O_WVS = 26869760, O_CVS = 35258368, O_LRS = 36831232, O_END = 37355520;
constexpr size_t OB_Q = 0, OB_ATT = (size_t)MP * 512 * 2;
constexpr size_t SZ_WIN = (size_t)DIN * D * 2, SZ_WAP = (size_t)D * 512 * 2, SZ_WLP = (size_t)D * D * 2, SZ_WOUT = SZ_WLP, SZ_WFI = (size_t)2 * DFF * D * 2, SZ_WFO = (size_t)D * DFF * 2, SZ_LW = (size_t)8 * 256 * 128 * 2;
constexpr size_t WS_WIN = 0, WS_WAP = WS_WIN + 4 * SZ_WIN, WS_WLP = WS_WAP + 4 * SZ_WAP, WS_WOUT = WS_WLP + 4 * SZ_WLP, WS_WFI = WS_WOUT + 4 * SZ_WOUT, WS_WFO = WS_WFI + 4 * SZ_WFI,
                 WS_LW = WS_WFO + 4 * SZ_WFO, WS_ROPE = WS_LW + 4 * SZ_LW, WS_AGG = WS_ROPE + 1048576, WS_X = WS_AGG + 4 * 2359296,     WS_XB = WS_X + (size_t)MP * D * 4,
                 WS_R = WS_XB + (size_t)MP * D * 2;
constexpr size_t WS_KB = WS_R, WS_VT = WS_KB + (size_t)MP * 128 * 2, WS_XR = WS_VT + (size_t)MP * 128 * 2, WS_GG = WS_XR + (size_t)MP * D * 2, WS_SA = WS_GG + (size_t)MP * D * 2, WS_SL = WS_SA + (size_t)MP * D * 2,
                 WS_END = WS_SL + (size_t)MP * D * 2;
constexpr size_t WS_BAR = WS_END;
constexpr size_t WS_SS = WS_BAR + 16384;
constexpr size_t SS_INST = (size_t)MP * 32;
constexpr size_t WS_C12 = WS_SS + 3 * SS_INST * 4;
constexpr int NC12 = DIN + 2 * DFF;
constexpr size_t WS_PART = WS_SS;
static_assert((size_t)DEPTH * 16 * NC12 * 2 * 4 <= 3 * SS_INST * 4, "partials fit in the statistics region");
constexpr size_t WS_TOTAL = WS_C12 + (size_t)DEPTH * NC12 * 2 * 4;
static_assert(WS_TOTAL <= 405000000, "workspace budget (ws_size >= sum of inputs = 409.2 MB)");
constexpr size_t WS_H = WS_R;
static_assert(WS_H + (size_t)MP * DFF * 2 <= WS_END, "H overlay");
static_assert(WS_GG == WS_XR + (size_t)MP * D * 2 && WS_SA == WS_GG + (size_t)MP * D * 2 && WS_SL == WS_SA + (size_t)MP * D * 2, "XR|GG|SA|SL consecutive");
constexpr int LDS_BYTES = 159744;
constexpr int LDS_ST = 155648;
constexpr size_t AGG_LAYER = 2359296 / 4;
constexpr unsigned AGG_SENTINEL = 0x7fc0deadu;

struct Params { const float* in[25]; float* out; unsigned char* ws; };
enum { I_XP = 0, I_XS, I_CK, I_CV, I_SC, I_SLRU, I_META, I_WIN, I_WAP, I_WLP, I_WOUT, I_SINK, I_CW, I_CB, I_WA, I_BA, I_WX, I_BX, I_LAM, I_L1G, I_L1B, I_WFI, I_WFO, I_L2G, I_L2B };

__device__ __forceinline__ unsigned cvtpk(float lo, float hi) { f32x2_t v = {lo, hi}; bf16x2_t b = __builtin_convertvector(v, bf16x2_t); return __builtin_bit_cast(unsigned, b); }
__device__ __forceinline__ bf16 f2bf(float f) { return (bf16)(cvtpk(f, 0.f) & 0xffffu); }
__device__ __forceinline__ float bf2f(unsigned b) { return __uint_as_float(b << 16); }
__device__ __forceinline__ float bflo(unsigned w) { return __uint_as_float(w << 16); }
__device__ __forceinline__ float bfhi(unsigned w) { return __uint_as_float(w & 0xffff0000u); }
__device__ __forceinline__ float sigmoidf_(float x) { return __builtin_amdgcn_rcpf(1.f + __expf(-x)); }
__device__ __forceinline__ float gelu_tanh(float x) { return x * sigmoidf_(1.5957691216057308f * (x + 0.044715f * x * x * x)); }
__device__ __forceinline__ u32x4 pack8(f32x4 a, f32x4 b) { u32x4 w; w.x = cvtpk(a[0], a[1]); w.y = cvtpk(a[2], a[3]); w.z = cvtpk(b[0], b[1]); w.w = cvtpk(b[2], b[3]); return w; }
__device__ __forceinline__ int mk_tid(int wv) { int t = wv * 64 + (int)__builtin_amdgcn_mbcnt_hi(~0u, __builtin_amdgcn_mbcnt_lo(~0u, 0u)); asm volatile("" : "+v"(t)); return t; }
__device__ __forceinline__ int crow(int reg, int h) { return (reg & 3) + 8 * (reg >> 2) + 4 * h; }
#define MFMA32(a, b, c) __builtin_amdgcn_mfma_f32_32x32x16_bf16((a), (b), (c), 0, 0, 0)
#define LDS_WAIT() asm volatile("s_waitcnt lgkmcnt(0)" ::: "memory")

__device__ __forceinline__ void ln_table(const float* st, int pm, int key, int wr, int wc, int fr, int fq) {
    typedef float f32x2v __attribute__((ext_vector_type(2)));
    LAS f32x2v* tab = (LAS f32x2v*)((LAS unsigned char*)0 + 131072);
    volatile LAS int* kw = (volatile LAS int*)((LAS unsigned char*)0 + LDS_ST + 8);
    const int t = (wr * 4 + wc) * 64 + fq * 16 + fr;
    if (st) {
        const int want = key * 128 + pm + 1;
        if (__builtin_amdgcn_readfirstlane(*kw) != want) {
            if (t < 256) {
                const f32x4* p = (const f32x4*)(st + ((size_t)(pm * 256 + t)) * 32);
                float s = 0.f, q = 0.f;
#pragma unroll
                for (int i = 0; i < 8; ++i) { const f32x4 v = p[i]; s += v[0] + v[2]; q += v[1] + v[3]; }
                const float mu = s * (1.f / D);
                tab[t] = (f32x2v){mu, __builtin_amdgcn_rsqf(fmaxf(q * (1.f / D) - mu * mu, 0.f) + LN_EPS)};
            }
            asm volatile("s_waitcnt lgkmcnt(0)" ::: "memory"); __builtin_amdgcn_s_barrier(); asm volatile("" ::: "memory");
            if (t == 0) *kw = want;
        }
    }
}
__device__ __forceinline__ void ln_row_stats(const float* st, int rloc, float& mu, float& rstd) {
    typedef float f32x2v __attribute__((ext_vector_type(2)));
    const f32x2v v = ((const LAS f32x2v*)((LAS unsigned char*)0 + 131072))[rloc]; mu = v.x; rstd = v.y;
}
struct EpiProj {
    static constexpr bool PERM = true, AFTER_DRAIN = false;
    int l; bf16 *Q, *KB, *VT, *XR; const float* rope; float* out; const float* st; const float* c12; int key;
    __device__ __forceinline__ static int pos_idx(int row) { return row < NPT ? row % LP : (row < M ? LP + ((row - NPT) & 3) : 0); }
    __device__ __forceinline__ void operator()(const pg8::f32x4 (&acc)[2][2][4][2], const pg8::Unit& u, int wr, int wc, int fr, int fq) const {
        asm volatile("" : "+v"(fr), "+v"(fq));
        const int pn = u.pn, cl = wc * 32 + 8 * fq;
        ln_table(st, u.pm, key, wr, wc, fr, fq);
        if (pn < 3) {
            const int d0 = (cl & 63) >> 1;
#pragma unroll
            for (int bj = 0; bj < 2; ++bj) {
                f32x4 c1a = {0.f, 0.f, 0.f, 0.f}, c1b = c1a, c2a = c1a, c2b = c1a;
                if (st) { const float* cp = c12 + (size_t)(pn * 256 + bj * 128 + cl) * 2; const f32x4 ca = *(const f32x4*)cp, cb = *(const f32x4*)(cp + 4), cc = *(const f32x4*)(cp + 8), cd = *(const f32x4*)(cp + 12);
                    c1a = (f32x4){ca[0], ca[2], cb[0], cb[2]}; c2a = (f32x4){ca[1], ca[3], cb[1], cb[3]}; c1b = (f32x4){cc[0], cc[2], cd[0], cd[2]}; c2b = (f32x4){cc[1], cc[3], cd[1], cd[3]}; }
#pragma unroll
                for (int ai = 0; ai < 2; ++ai)
#pragma unroll
                for (int mp = 0; mp < 2; ++mp) {
                    f32x4 cs0[2], cs1[2];
#pragma unroll
                    for (int mm = 0; mm < 2; ++mm) { const int pi = pos_idx(u.pm * 256 + ai * 128 + wr * 64 + (2 * mp + mm) * 16 + fr); cs0[mm] = *(const f32x4*)(rope + (size_t)pi * 64 + d0 * 2); cs1[mm] = *(const f32x4*)(rope + (size_t)pi * 64 + d0 * 2 + 4); }
#pragma unroll
                    for (int mm = 0; mm < 2; ++mm) {
                        const int m = 2 * mp + mm;
                        const int rloc = ai * 128 + wr * 64 + m * 16 + fr, row = u.pm * 256 + rloc;
                        float mu = 0.f, rstd = 1.f; if (st) ln_row_stats(st, rloc, mu, rstd);
                        const f32x4 v0 = (acc[ai][bj][m][0] - c1a * mu) * rstd + c2a, v1 = (acc[ai][bj][m][1] - c1b * mu) * rstd + c2b;
                        if (pn == 2 && bj == 1) {
                            const int vc = cl;
                            const u32x4 w = pack8(v0, v1);
                            bf16* vt = VT + ((size_t)((vc >> 6) * (MP / 4) + (row >> 2)) * 64 + (vc & 63)) * 4 + (row & 3);
                            vt[0] = (bf16)(w.x & 0xffff); vt[4] = (bf16)(w.x >> 16); vt[8] = (bf16)(w.y & 0xffff); vt[12] = (bf16)(w.y >> 16);
                            vt[16] = (bf16)(w.z & 0xffff); vt[20] = (bf16)(w.z >> 16); vt[24] = (bf16)(w.w & 0xffff); vt[28] = (bf16)(w.w >> 16);
                            float* dst = nullptr;
                            if (row < NPT) { const int t = row % LP; if (t >= LP - 128) dst = out + O_WVP + ((size_t)((l * 8 + row / LP) * 128 + (t - (LP - 128)))) * 128 + vc; }
                            else if (row < M) { const int db = (row - NPT) >> 2, s = (row - NPT) & 3; dst = out + O_WVS + ((size_t)((l * 128 + db) * 128 + 124 + s)) * 128 + vc; }
                            if (dst) { *(f32x4*)dst = v0; *(f32x4*)(dst + 4) = v1; }
                        } else {
                            const f32x4 c0 = cs0[mm], c1 = cs1[mm];
                            f32x4 y0, y1;
                            y0[0] = v0[0] * c0[0] - v0[1] * c0[1]; y0[1] = v0[1] * c0[0] + v0[0] * c0[1];
                            y0[2] = v0[2] * c0[2] - v0[3] * c0[3]; y0[3] = v0[3] * c0[2] + v0[2] * c0[3];
                            y1[0] = v1[0] * c1[0] - v1[1] * c1[1]; y1[1] = v1[1] * c1[0] + v1[0] * c1[1];
                            y1[2] = v1[2] * c1[2] - v1[3] * c1[3]; y1[3] = v1[3] * c1[2] + v1[2] * c1[3];
                            if (pn < 2) {
                                const int col = pn * 256 + bj * 128 + cl;
                                *(u32x4*)(Q + (size_t)row * 512 + col) = pack8(y0 * 0.125f, y1 * 0.125f);
                            } else {
                                *(u32x4*)(KB + (size_t)row * 128 + cl) = pack8(y0, y1);
                                float* dst = nullptr;
                                if (row < NPT) { const int t = row % LP; if (t >= LP - 128) dst = out + O_WKP + ((size_t)((l * 8 + row / LP) * 128 + (t - (LP - 128)))) * 128; }
                                else if (row < M) { const int db = (row - NPT) >> 2, s = (row - NPT) & 3; dst = out + O_WKS + ((size_t)((l * 128 + db) * 128 + 124 + s)) * 128; }
                                if (dst) { dst += (cl & 64) + d0;
                                    dst[0] = y0[0]; dst[32] = y0[1]; dst[1] = y0[2]; dst[33] = y0[3]; dst[2] = y1[0]; dst[34] = y1[1]; dst[3] = y1[2]; dst[35] = y1[3]; }
                            }
                        }
                    }
                    asm volatile("" ::: "memory");
                }
            }
        } else {
            const int kind = (pn - 3) >> 2;
            bf16* dstb = XR + (size_t)kind * ((size_t)MP * D);
            const int cbase = ((pn - 3) & 3) * 256 + cl;
#pragma unroll
            for (int bj = 0; bj < 2; ++bj) {
                f32x4 c1a = {0.f, 0.f, 0.f, 0.f}, c1b = c1a, c2a = c1a, c2b = c1a;
                if (st) { const float* cp = c12 + (size_t)(pn * 256 + bj * 128 + cl) * 2; const f32x4 ca = *(const f32x4*)cp, cb = *(const f32x4*)(cp + 4), cc = *(const f32x4*)(cp + 8), cd = *(const f32x4*)(cp + 12);
                    c1a = (f32x4){ca[0], ca[2], cb[0], cb[2]}; c2a = (f32x4){ca[1], ca[3], cb[1], cb[3]}; c1b = (f32x4){cc[0], cc[2], cd[0], cd[2]}; c2b = (f32x4){cc[1], cc[3], cd[1], cd[3]}; }
                const int c = cbase + bj * 128;
#pragma unroll
                for (int ai = 0; ai < 2; ++ai)
#pragma unroll
                    for (int m = 0; m < 4; ++m) {
                        const int rloc = ai * 128 + wr * 64 + m * 16 + fr, row = u.pm * 256 + rloc;
                        float mu = 0.f, rstd = 1.f; if (st) ln_row_stats(st, rloc, mu, rstd);
                        f32x4 v0 = (acc[ai][bj][m][0] - c1a * mu) * rstd + c2a, v1 = (acc[ai][bj][m][1] - c1b * mu) * rstd + c2b;
                        if (kind == 0) {
                            float* dst = nullptr;
                            if (row < NPT) { const int t = row % LP; if (t >= LP - 3) dst = out + O_CVP + ((size_t)((l * 8 + row / LP) * 3 + (t - (LP - 3)))) * 1024 + c; }
                            else if (row < M) { const int db = (row - NPT) >> 2, s = (row - NPT) & 3; if (s >= 1) dst = out + O_CVS + ((size_t)((l * 128 + db) * 3 + (s - 1))) * 1024 + c; }
                            if (dst) { *(f32x4*)dst = v0; *(f32x4*)(dst + 4) = v1; }
                        } else if (kind == 1) {
#pragma unroll
                            for (int j = 0; j < 4; ++j) { v0[j] = gelu_tanh(v0[j]); v1[j] = gelu_tanh(v1[j]); }
                        } else {
#pragma unroll
                            for (int j = 0; j < 4; ++j) { v0[j] = sigmoidf_(v0[j]); v1[j] = sigmoidf_(v1[j]); }
                        }
                        *(u32x4*)(dstb + (size_t)row * 1024 + c) = pack8(v0, v1);
                    }
            }
        }
    }
};
template <bool ADD> struct EpiGate {
    static constexpr bool PERM = true, AFTER_DRAIN = false;
    bf16* S; const bf16* A;
    __device__ __forceinline__ void operator()(const pg8::f32x4 (&acc)[2][2][4][2], const pg8::Unit& u, int wr, int wc, int fr, int fq) const {
        asm volatile("" : "+v"(fr), "+v"(fq));
#pragma unroll
        for (int ai = 0; ai < 2; ++ai) {
            u32x4 sv[4][2], av[4][2];
            const size_t off0 = (size_t)(u.pm * 256 + ai * 128 + wr * 64 + fr) * 1024 + u.pn * 256 + wc * 32 + 8 * fq;
#pragma unroll
            for (int m = 0; m < 4; ++m)
#pragma unroll
                for (int bj = 0; bj < 2; ++bj) { sv[m][bj] = *(const u32x4*)(S + off0 + (size_t)m * 16 * 1024 + bj * 128); if (ADD) av[m][bj] = *(const u32x4*)(A + off0 + (size_t)m * 16 * 1024 + bj * 128); }
#pragma unroll
            for (int m = 0; m < 4; ++m)
#pragma unroll
                for (int bj = 0; bj < 2; ++bj) {
                    const u32x4 s = sv[m][bj];
                    f32x4 v0 = acc[ai][bj][m][0], v1 = acc[ai][bj][m][1];
                    v0[0] *= bflo(s.x); v0[1] *= bfhi(s.x); v0[2] *= bflo(s.y); v0[3] *= bfhi(s.y); v1[0] *= bflo(s.z); v1[1] *= bfhi(s.z); v1[2] *= bflo(s.w); v1[3] *= bfhi(s.w);
                    if (ADD) { const u32x4 a = av[m][bj];
                        v0[0] += bflo(a.x); v0[1] += bfhi(a.x); v0[2] += bflo(a.y); v0[3] += bfhi(a.y); v1[0] += bflo(a.z); v1[1] += bfhi(a.z); v1[2] += bflo(a.w); v1[3] += bfhi(a.w); }
                    *(u32x4*)(S + off0 + (size_t)m * 16 * 1024 + bj * 128) = pack8(v0, v1);
                }
            asm volatile("" ::: "memory");
        }
    }
};
struct EpiRes {
    static constexpr bool PERM = true, AFTER_DRAIN = false;
    float* Z; bf16* ZB; const float* pst; const float* pg; const float* pb; float* ost; int key;
    __device__ __forceinline__ void operator()(const pg8::f32x4 (&acc)[2][2][4][2], const pg8::Unit& u, int wr, int wc, int fr, int fq) const {
        asm volatile("" : "+v"(fr), "+v"(fq));
        ln_table(pst, u.pm, key, wr, wc, fr, fq);
        const int col0 = u.pn * 256 + wc * 32 + 8 * fq;
#pragma unroll
        for (int ai = 0; ai < 2; ++ai) {
            u32x4 zx[4][2];
#pragma unroll
            for (int m = 0; m < 4; ++m)
#pragma unroll
                for (int bj = 0; bj < 2; ++bj) zx[m][bj] = *(const u32x4*)(ZB + (size_t)(u.pm * 256 + ai * 128 + wr * 64 + m * 16 + fr) * 1024 + col0 + bj * 128);
#pragma unroll
            for (int m = 0; m < 4; ++m) {
                const int rloc = ai * 128 + wr * 64 + m * 16 + fr, row = u.pm * 256 + rloc;
                float mu = 0.f, rstd = 1.f; if (pst) ln_row_stats(pst, rloc, mu, rstd);
                float s = 0.f, q = 0.f;
#pragma unroll
                for (int bj = 0; bj < 2; ++bj) {
                    const int col = col0 + bj * 128;
                    const u32x4 zw = zx[m][bj];
                    f32x4 x0 = {bflo(zw.x), bfhi(zw.x), bflo(zw.y), bfhi(zw.y)}, x1 = {bflo(zw.z), bfhi(zw.z), bflo(zw.w), bfhi(zw.w)};
                    if (pst) { const f32x4 g0 = *(const f32x4*)(pg + col), g1 = *(const f32x4*)(pg + col + 4), b0 = *(const f32x4*)(pb + col), b1 = *(const f32x4*)(pb + col + 4);
                        x0 = (x0 - mu) * rstd * g0 + b0; x1 = (x1 - mu) * rstd * g1 + b1; }
                    x0 = x0 * ALPHA + acc[ai][bj][m][0]; x1 = x1 * ALPHA + acc[ai][bj][m][1];
                    if (Z) { float* p = Z + (size_t)row * 1024 + col; *(f32x4*)p = x0; *(f32x4*)(p + 4) = x1; }
                    *(u32x4*)(ZB + (size_t)row * 1024 + col) = pack8(x0, x1);
                    s += ((x0[0] + x0[1]) + (x0[2] + x0[3])) + ((x1[0] + x1[1]) + (x1[2] + x1[3]));
                    q += ((x0[0] * x0[0] + x0[1] * x0[1]) + (x0[2] * x0[2] + x0[3] * x0[3])) + ((x1[0] * x1[0] + x1[1] * x1[1]) + (x1[2] * x1[2] + x1[3] * x1[3]));
                }
                s += __shfl_xor(s, 16); q += __shfl_xor(q, 16); s += __shfl_xor(s, 32); q += __shfl_xor(q, 32);
                if (fq == 0) { typedef float f32x2v __attribute__((ext_vector_type(2))); *(f32x2v*)(ost + (size_t)row * 32 + (u.pn * 4 + wc) * 2) = (f32x2v){s, q}; }
            }
            asm volatile("" ::: "memory");
        }
    }
};
struct EpiSwiglu {
    static constexpr bool PERM = true, AFTER_DRAIN = false;
    bf16* H; const float* st; const float* c12; int key;
    __device__ __forceinline__ void operator()(const pg8::f32x4 (&acc)[2][2][4][2], const pg8::Unit& u, int wr, int wc, int fr, int fq) const {
        asm volatile("" : "+v"(fr), "+v"(fq));
        const int cl = wc * 32 + 8 * fq;
        f32x4 craw[2][4];
#pragma unroll
        for (int bj = 0; bj < 2; ++bj) { const float* cp = c12 + (size_t)(u.pn * 256 + bj * 128 + cl) * 2; craw[bj][0] = *(const f32x4*)cp; craw[bj][1] = *(const f32x4*)(cp + 4); craw[bj][2] = *(const f32x4*)(cp + 8); craw[bj][3] = *(const f32x4*)(cp + 12); }
        ln_table(st, u.pm, key, wr, wc, fr, fq);
        f32x4 c1a[2], c1b[2], c2a[2], c2b[2];
#pragma unroll
        for (int bj = 0; bj < 2; ++bj) { const f32x4 ca = craw[bj][0], cb = craw[bj][1], cc = craw[bj][2], cd = craw[bj][3];
            c1a[bj] = (f32x4){ca[0], ca[2], cb[0], cb[2]}; c2a[bj] = (f32x4){ca[1], ca[3], cb[1], cb[3]}; c1b[bj] = (f32x4){cc[0], cc[2], cd[0], cd[2]}; c2b[bj] = (f32x4){cc[1], cc[3], cd[1], cd[3]}; }
#pragma unroll
        for (int ai = 0; ai < 2; ++ai)
#pragma unroll
            for (int m = 0; m < 4; ++m) {
                const int row = u.pm * 256 + ai * 128 + wr * 64 + m * 16 + fr;
                float mu, rstd; ln_row_stats(st, row - u.pm * 256, mu, rstd);
                const f32x4 u1a = (acc[ai][0][m][0] - c1a[0] * mu) * rstd + c2a[0], u1b = (acc[ai][0][m][1] - c1b[0] * mu) * rstd + c2b[0];
                const f32x4 u2a = (acc[ai][1][m][0] - c1a[1] * mu) * rstd + c2a[1], u2b = (acc[ai][1][m][1] - c1b[1] * mu) * rstd + c2b[1];
                f32x4 h0, h1;
#pragma unroll
                for (int j = 0; j < 4; ++j) { h0[j] = u1a[j] * sigmoidf_(u1a[j]) * u2a[j]; h1[j] = u1b[j] * sigmoidf_(u1b[j]) * u2b[j]; }
                *(u32x4*)(H + (size_t)row * DFF + u.pn * 128 + cl) = pack8(h0, h1);
            }
    }
};

__device__ __forceinline__ int colmap(int mode, int n) {
    if (mode == 1) { if (n < 640) { const int p = n & 63; return (n & ~63) + (p >> 1) + ((p & 1) << 5); } return n; }
    if (mode == 2) { const int pn = n >> 8, bj = (n >> 7) & 1, j = n & 127; return bj * DFF + pn * 128 + j; }
    return n;
}
__device__ __forceinline__ void transpose_item(const float* W, int K, int N, bf16* WT, int mode, LAS float* scr, int item, int lane) {
    const int nblk = N / 32, kb = item / nblk, nb = item % nblk, k0 = 64 * kb, n0 = 32 * nb;
    const int nsrc = colmap(mode, n0 + (lane & 31));
#pragma unroll 8
    for (int i = 0; i < 32; ++i) { const int kk = 2 * i + (lane >> 5); scr[kk * 33 + (lane & 31)] = __builtin_nontemporal_load(W + (size_t)(k0 + kk) * N + nsrc); }
    LDS_WAIT();
    const int c = lane & 7;
#pragma unroll
    for (int j = 0; j < 4; ++j) { const int n = (lane >> 3) + 8 * j; const LAS float* s = scr + (8 * c) * 33 + n;
        u32x4 o; o.x = cvtpk(s[0 * 33], s[1 * 33]); o.y = cvtpk(s[2 * 33], s[3 * 33]); o.z = cvtpk(s[4 * 33], s[5 * 33]); o.w = cvtpk(s[6 * 33], s[7 * 33]);
        *(u32x4*)(WT + (size_t)(n0 + n) * K + k0 + 8 * c) = o; }
    LDS_WAIT();
}
__device__ __forceinline__ void transpose_item_ln(const float* W, int K, int N, bf16* WT, int mode, LAS float* scr, int item, int lane, const float* gk, const float* bk, float* part) {
    const int nblk = N / 32, kb = item / nblk, nb = item % nblk, k0 = 64 * kb, n0 = 32 * nb;
    const int nsrc = colmap(mode, n0 + (lane & 31));
    LAS float* gs = scr + 64 * 33; LAS float* bs = gs + 64;
    gs[lane] = gk[k0 + lane]; bs[lane] = bk[k0 + lane];
    LDS_WAIT();
    float s1 = 0.f, s2 = 0.f;
#pragma unroll 8
    for (int i = 0; i < 32; ++i) { const int kk = 2 * i + (lane >> 5); const float w = __builtin_nontemporal_load(W + (size_t)(k0 + kk) * N + nsrc); const float wg = w * gs[kk];
        scr[kk * 33 + (lane & 31)] = wg; s1 += bf2f(cvtpk(wg, 0.f) & 0xffffu); s2 += bs[kk] * w; }
    s1 += __shfl_xor(s1, 32); s2 += __shfl_xor(s2, 32);
    if (lane < 32) { float* pp = part + ((size_t)kb * NC12 + n0 + lane) * 2; pp[0] = s1; pp[1] = s2; }
    LDS_WAIT();
    const int c = lane & 7;
#pragma unroll
    for (int j = 0; j < 4; ++j) { const int n = (lane >> 3) + 8 * j; const LAS float* s = scr + (8 * c) * 33 + n;
        u32x4 o; o.x = cvtpk(s[0 * 33], s[1 * 33]); o.y = cvtpk(s[2 * 33], s[3 * 33]); o.z = cvtpk(s[4 * 33], s[5 * 33]); o.w = cvtpk(s[6 * 33], s[7 * 33]);
        *(u32x4*)(WT + (size_t)(n0 + n) * K + k0 + 8 * c) = o; }
    LDS_WAIT();
}
__device__ __forceinline__ void prologue(const Params& P, LAS unsigned char* lds, int tid_in) {
    const int tid = tid_in, lane = tid & 63, wave = tid >> 6;
    const int gw = blockIdx.x * 8 + wave, NGW = gridDim.x * 8;
    LAS float* scr = (LAS float*)(lds + wave * 9216);
    unsigned char* ws = P.ws;
    constexpr int IT_IN = 16 * (DIN / 32), IT_AP = 8 * 32, IT_LP = 16 * 32, IT_OUT = 16 * 32, IT_FI = 16 * (2 * DFF / 32), IT_FO = (DFF / 64) * 32, IT_LW = 16 * 8;
    constexpr int IT_LAYER = IT_IN + IT_AP + IT_LP + IT_OUT + IT_FI + IT_FO + IT_LW;
    for (int it = gw; it < DEPTH * IT_LAYER; it += NGW) {
        const int l = it / IT_LAYER; int r = it % IT_LAYER;
        if (r < IT_IN) { if (l == 0) transpose_item(P.in[I_WIN], D, DIN, (bf16*)(ws + WS_WIN), 1, scr, r, lane);
                         else transpose_item_ln(P.in[I_WIN] + (size_t)l * D * DIN, D, DIN, (bf16*)(ws + WS_WIN + l * SZ_WIN), 1, scr, r, lane, P.in[I_L2G] + (l - 1) * D, P.in[I_L2B] + (l - 1) * D, (float*)(ws + WS_PART) + (size_t)l * 16 * NC12 * 2);
                         continue; } r -= IT_IN;
        if (r < IT_AP) { transpose_item(P.in[I_WAP] + (size_t)l * 512 * D, 512, D, (bf16*)(ws + WS_WAP + l * SZ_WAP), 0, scr, r, lane); continue; } r -= IT_AP;
        if (r < IT_LP) { transpose_item(P.in[I_WLP] + (size_t)l * D * D, D, D, (bf16*)(ws + WS_WLP + l * SZ_WLP), 0, scr, r, lane); continue; } r -= IT_LP;
        if (r < IT_OUT) { transpose_item(P.in[I_WOUT] + (size_t)l * D * D, D, D, (bf16*)(ws + WS_WOUT + l * SZ_WOUT), 0, scr, r, lane); continue; } r -= IT_OUT;
        if (r < IT_FI) { transpose_item_ln(P.in[I_WFI] + (size_t)l * D * 2 * DFF, D, 2 * DFF, (bf16*)(ws + WS_WFI + l * SZ_WFI), 2, scr, r, lane, P.in[I_L1G] + l * D, P.in[I_L1B] + l * D, (float*)(ws + WS_PART) + ((size_t)l * 16 * NC12 + DIN) * 2); continue; } r -= IT_FI;
        if (r < IT_FO) { transpose_item(P.in[I_WFO] + (size_t)l * DFF * D, DFF, D, (bf16*)(ws + WS_WFO + l * SZ_WFO), 0, scr, r, lane); continue; } r -= IT_FO;
        { const int mat = r >> 3, sub = r & 7, nb = mat >> 1, which = mat & 1;
          transpose_item(P.in[which ? I_WX : I_WA] + (size_t)(l * 8 + nb) * 128 * 128, 128, 128, (bf16*)(ws + WS_LW + l * SZ_LW) + (size_t)(nb * 256 + which * 128) * 128, 0, scr, sub, lane); }
    }
    float* X = (float*)(ws + WS_X); bf16* XB = (bf16*)(ws + WS_XB);
    {
        f32x4 vn[4];
        auto row_src = [&](int m) -> const float* {
            if (m < NPT) { const int bb = m / LP, t = m % LP; return t < 16 ? P.in[I_META] + (size_t)t * D : P.in[I_XP] + ((size_t)bb * 2048 + (t - 16)) * D; }
            if (m < M) return P.in[I_XS] + (size_t)(m - NPT) * D;
            return nullptr; };
        if (gw < MP) { const float* src = row_src(gw);
#pragma unroll
            for (int j = 0; j < 4; ++j) { vn[j] = (f32x4){0.f, 0.f, 0.f, 0.f}; if (src) vn[j] = __builtin_nontemporal_load((const f32x4*)(src + 256 * j + 4 * lane)); } }
        for (int m = gw; m < MP; m += NGW) {
            f32x4 v[4];
#pragma unroll
            for (int j = 0; j < 4; ++j) v[j] = vn[j];
            if (m + NGW < MP) { const float* src = row_src(m + NGW);
#pragma unroll
                for (int j = 0; j < 4; ++j) { vn[j] = (f32x4){0.f, 0.f, 0.f, 0.f}; if (src) vn[j] = __builtin_nontemporal_load((const f32x4*)(src + 256 * j + 4 * lane)); } }
#pragma unroll
            for (int j = 0; j < 4; ++j) { u32x2 w; w.x = cvtpk(v[j][0], v[j][1]); w.y = cvtpk(v[j][2], v[j][3]); *(u32x2*)(XB + (size_t)m * D + 256 * j + 4 * lane) = w; }
        }
    }
    { unsigned* ag = (unsigned*)(ws + WS_AGG); for (int e = blockIdx.x * 512 + tid; e < (int)(DEPTH * AGG_LAYER); e += gridDim.x * 512) ag[e] = AGG_SENTINEL; }
    float* rope = (float*)(ws + WS_ROPE);
    for (int e = blockIdx.x * 512 + tid; e < (LP + 4) * 32; e += gridDim.x * 512) {
        const int pi = e >> 5, d = e & 31; const double pos = pi < LP ? (double)pi : (double)(8192 + pi - LP);
        const double inv = pow(10000.0, -(double)d / 32.0), ang = pos * inv;
        rope[2 * e] = (float)cos(ang); rope[2 * e + 1] = (float)sin(ang);
    }
}

template <bool FINAL> __device__ __forceinline__ void ln_pass(const Params& P, const float* g, const float* b, int tid_in) {
    const int tid = tid_in, lane = tid & 63, wave = tid >> 6, gw = blockIdx.x * 8 + wave, NGW = gridDim.x * 8;
    float* X = (float*)(P.ws + WS_X); bf16* XB = (bf16*)(P.ws + WS_XB);
    f32x4 gv[4], bv[4];
#pragma unroll
    for (int j = 0; j < 4; ++j) { gv[j] = *(const f32x4*)(g + 256 * j + 4 * lane); bv[j] = *(const f32x4*)(b + 256 * j + 4 * lane); }
    f32x4 vn[4];
    if (gw < M) {
#pragma unroll
        for (int j = 0; j < 4; ++j) vn[j] = *(const f32x4*)(X + (size_t)gw * D + 256 * j + 4 * lane);
    }
    for (int m = gw; m < M; m += NGW) {
        f32x4 v[4]; float s = 0.f;
#pragma unroll
        for (int j = 0; j < 4; ++j) { v[j] = vn[j]; s += (v[j][0] + v[j][1]) + (v[j][2] + v[j][3]); }
        { const int mn = m + NGW < M ? m + NGW : m;
#pragma unroll
          for (int j = 0; j < 4; ++j) vn[j] = *(const f32x4*)(X + (size_t)mn * D + 256 * j + 4 * lane); }
#pragma unroll
        for (int o = 1; o < 64; o <<= 1) s += __shfl_xor(s, o);
        const float mean = s * (1.f / D); float q = 0.f;
#pragma unroll
        for (int j = 0; j < 4; ++j) { v[j] = v[j] - mean; q += (v[j][0] * v[j][0] + v[j][1] * v[j][1]) + (v[j][2] * v[j][2] + v[j][3] * v[j][3]); }
#pragma unroll
        for (int o = 1; o < 64; o <<= 1) q += __shfl_xor(q, o);
        const float rstd = 1.f / sqrtf(q * (1.f / D) + LN_EPS);
        float* yo = nullptr;
        if (FINAL) { if (m < NPT) { const int bb = m / LP, t = m % LP; if (t >= 16) yo = P.out + O_YP + ((size_t)bb * 2048 + (t - 16)) * D; } else yo = P.out + O_YS + (size_t)(m - NPT) * D; }
#pragma unroll
        for (int j = 0; j < 4; ++j) {
            const f32x4 y = v[j] * rstd * gv[j] + bv[j];
            if (FINAL) { if (yo) *(f32x4*)(yo + 256 * j + 4 * lane) = y; }
            else { *(f32x4*)(X + (size_t)m * D + 256 * j + 4 * lane) = y;
                   u32x2 w; w.x = cvtpk(y[0], y[1]); w.y = cvtpk(y[2], y[3]); *(u32x2*)(XB + (size_t)m * D + 256 * j + 4 * lane) = w; }
        }
    }
}

#define BAR_LDS() do { asm volatile("s_waitcnt lgkmcnt(0)" ::: "memory"); __builtin_amdgcn_s_barrier(); asm volatile("" ::: "memory"); } while (0)
__device__ __forceinline__ void lru_load_rows(const Params& P, int l, int tile, int r0, int c0, u32x4 (&xr)[2][4]) {
    const bf16* XR = (const bf16*)(P.ws + WS_XR);
    const bool samp = tile * 64 >= NPT;
#pragma unroll
    for (int j = 0; j < 2; ++j) {
        const int m = tile * 64 + r0 + 32 * j;
        const int pos = samp ? ((m - NPT) & 3) : (m % LP);
#pragma unroll
        for (int i = 0; i < 4; ++i) {
            u32x4 v = {0u, 0u, 0u, 0u};
            if (pos - i >= 0) v = *(const u32x4*)(XR + (size_t)(m - i) * 1024 + c0);
            else if (samp) { const float* buf = P.in[I_SC] + ((size_t)((l * 128 + ((m - NPT) >> 2)) * 3) + (3 + pos - i)) * 1024 + c0; v = pack8(*(const f32x4*)buf, *(const f32x4*)(buf + 4)); }
            xr[j][i] = v;
        }
    }
}
template <int MODE> __device__ __forceinline__ void lru_phase(const Params& P, LAS unsigned char* lds, int l, int tid_in) {
    const int tid = tid_in, lane = tid & 63, wid = tid >> 6;
    LAS bf16* xcb = (LAS bf16*)lds;
    LAS float* qa = (LAS float*)lds; LAS float* qb = qa + 512;
    LAS float* sab = (LAS float*)(lds + 17408);
    LAS float* cwl = (LAS float*)(lds + 148480);
    LAS float* fa = (LAS float*)(lds + 151040); LAS float* fb = fa + 512;
    const int nb = blockIdx.x & 7, tstride = gridDim.x >> 3;
    const int c8 = tid & 15, r0 = tid >> 4, c0 = nb * 128 + c8 * 8;
    for (int e = tid; e < 640; e += 512) { const int i = e >> 7, cc = e & 127; cwl[e] = i < 4 ? P.in[I_CW][(size_t)(l * 4 + 3 - i) * 1024 + nb * 128 + cc] : P.in[I_CB][l * 1024 + nb * 128 + cc]; }
    const int rb = wid & 1, cb = wid >> 1, l32 = lane & 31, h = lane >> 5;
    bf16x8 br[8], bi[8];
    { const bf16* LW = (const bf16*)(P.ws + WS_LW + l * SZ_LW) + (size_t)(nb * 256 + cb * 32 + l32) * 128 + h * 8;
#pragma unroll
      for (int kk = 0; kk < 8; ++kk) { br[kk] = *(const bf16x8*)(LW + kk * 16); bi[kk] = *(const bf16x8*)(LW + 128 * 128 + kk * 16); } }
    const int cgate = cb * 32 + l32;
    const float ba = P.in[I_BA][l * 1024 + nb * 128 + cgate], bx = P.in[I_BX][l * 1024 + nb * 128 + cgate];
    const float sp = log1pf(expf(-P.in[I_LAM][l * 1024 + nb * 128 + cgate]));
    const float L2E = 1.4426950408889634f, nba = -L2E * ba, nbx = -L2E * bx, ca = -8.f * sp * L2E;
    const int cs = tid & 127, q = tid >> 7, cgs = nb * 128 + cs;
    float* AGG = (float*)(P.ws + WS_AGG) + (size_t)l * AGG_LAYER;
    bf16* GG = (bf16*)(P.ws + WS_GG);
    u32x4 xr[2][4], gwp[2];
    float pqa[3] = {1.f, 1.f, 1.f}, pqb[3] = {0.f, 0.f, 0.f};
    int tile = blockIdx.x >> 3, prev = -1, par = 0;
    BAR_LDS();
    if (tile < NTILE64) lru_load_rows(P, l, tile, r0, c0, xr);
    for (;; tile += tstride, par ^= 1) {
        const bool cur = tile < NTILE64;
        if (!cur && prev < 0) break;
        const int t0 = tile * 64; const bool samp = t0 >= NPT;
        LAS float* sa = sab + par * 16384; LAS float* sb = sa + 8192;
        LAS float* psa = sab + (par ^ 1) * 16384; LAS float* psb = psa + 8192;
        const int pt0 = prev * 64; const bool psamp = pt0 >= NPT;
        u32x4 gw[2];
        if (cur) {
#pragma unroll
            for (int j = 0; j < 2; ++j) {
                f32x4 a0 = *(const LAS f32x4*)(cwl + 512 + c8 * 8), a1 = *(const LAS f32x4*)(cwl + 512 + c8 * 8 + 4);
#pragma unroll
                for (int i = 0; i < 4; ++i) { const u32x4 xw = xr[j][i]; f32x4 x0, x1; const f32x4 w0 = *(const LAS f32x4*)(cwl + i * 128 + c8 * 8), w1 = *(const LAS f32x4*)(cwl + i * 128 + c8 * 8 + 4);
                    x0[0] = bflo(xw.x); x0[1] = bfhi(xw.x); x0[2] = bflo(xw.y); x0[3] = bfhi(xw.y); x1[0] = bflo(xw.z); x1[1] = bfhi(xw.z); x1[2] = bflo(xw.w); x1[3] = bfhi(xw.w);
                    a0 += w0 * x0; a1 += w1 * x1; }
                *(LAS u32x4*)(xcb + (r0 + 32 * j) * 136 + c8 * 8) = pack8(a0, a1);
            }
            if (tile + tstride < NTILE64) lru_load_rows(P, l, tile + tstride, r0, c0, xr);
#pragma unroll
            for (int j = 0; j < 2; ++j) gw[j] = *(const u32x4*)(GG + (size_t)(t0 + r0 + 32 * j) * 1024 + c0);
        }
        if (prev >= 0) {
            float fA = 1.f, fB = 0.f;
            if (!psamp && (pt0 % LP) != 0) {
                const int j0 = (((pt0 - 1) / LP) * LP) / 64, n = prev - j0, per = (n + 3) >> 2, ja = j0 + q * per;
                float aa[9], bb[9];
                for (unsigned spin = 0; spin < (1u << 20); ++spin) {
                    bool bad = false;
#pragma unroll
                    for (int i = 0; i < 9; ++i) { const bool ok = i < per && ja + i < prev; const int j = ok ? ja + i : j0;
                        aa[i] = __hip_atomic_load(AGG + (size_t)j * 2048 + cgs, __ATOMIC_RELAXED, __HIP_MEMORY_SCOPE_AGENT); bb[i] = __hip_atomic_load(AGG + (size_t)j * 2048 + 1024 + cgs, __ATOMIC_RELAXED, __HIP_MEMORY_SCOPE_AGENT); }
#pragma unroll
                    for (int i = 0; i < 9; ++i) { bad = bad || __float_as_uint(aa[i]) == AGG_SENTINEL || __float_as_uint(bb[i]) == AGG_SENTINEL; }
                    if (!bad) break;
                    __builtin_amdgcn_s_sleep(8);
                }
#pragma unroll
                for (int i = 0; i < 9; ++i) { const bool ok = i < per && ja + i < prev; if (!ok) { aa[i] = 1.f; bb[i] = 0.f; } }
#pragma unroll
                for (int i = 0; i < 9; ++i) { fB = aa[i] * fB + bb[i]; fA *= aa[i]; }
            }
            fa[q * 128 + cs] = fA; fb[q * 128 + cs] = fB;
        }
        BAR_LDS();
        if (cur) {
            f32x16 ar, ai;
#pragma unroll
            for (int i = 0; i < 16; ++i) { ar[i] = 0.f; ai[i] = 0.f; }
#pragma unroll
            for (int kk = 0; kk < 8; ++kk) {
                const bf16x8 a = *(const LAS bf16x8*)(xcb + (rb * 32 + l32) * 136 + kk * 16 + h * 8);
                ar = MFMA32(a, br[kk], ar); ai = MFMA32(a, bi[kk], ai);
            }
#pragma unroll
            for (int i = 0; i < 16; ++i) {
                const int r = rb * 32 + crow(i, h);
                const float rr = __builtin_amdgcn_rcpf(1.f + __builtin_amdgcn_exp2f(ar[i] * -L2E + nba)), ii = __builtin_amdgcn_rcpf(1.f + __builtin_amdgcn_exp2f(ai[i] * -L2E + nbx));
                const float a = __builtin_amdgcn_exp2f(ca * rr), mult = __builtin_amdgcn_sqrtf(fmaxf(1.f - a * a, 0.f));
                sa[r * 128 + cgate] = a; sb[r * 128 + cgate] = mult * ii * bf2f(xcb[r * 136 + cgate]);
            }
        }
        BAR_LDS();
        if (cur) {
            const int pos0 = samp ? 0 : ((t0 + 16 * q) % LP);
            const int rs = samp ? -1 : (pos0 == 0 ? 0 : (LP - pos0 < 16 ? LP - pos0 : -1));
            float A = 1.f, B = 0.f;
#pragma unroll
            for (int i = 0; i < 16; ++i) {
                const float a2 = sa[(16 * q + i) * 128 + cs], b2 = sb[(16 * q + i) * 128 + cs];
                const bool reset = samp ? ((i & 3) == 0) : (i == rs);
                float h0 = 0.f; if (samp && reset) h0 = P.in[I_SLRU][(size_t)(l * 128 + ((t0 + 16 * q - NPT) >> 2) + (i >> 2)) * 1024 + cgs];
                if (reset) { A = 0.f; B = a2 * h0 + b2; } else { A *= a2; B = a2 * B + b2; }
            }
            qa[q * 128 + cs] = A; qb[q * 128 + cs] = B;
        }
        if (prev >= 0) {
            const int pos0 = psamp ? 0 : ((pt0 + 16 * q) % LP);
            const int rs = psamp ? -1 : (pos0 == 0 ? 0 : (LP - pos0 < 16 ? LP - pos0 : -1));
            float hh = 0.f;
#pragma unroll
            for (int r = 0; r < 4; ++r) hh = fa[r * 128 + cs] * hh + fb[r * 128 + cs];
#pragma unroll
            for (int j = 0; j < 3; ++j) if (j < q) hh = pqa[j] * hh + pqb[j];
#pragma unroll
            for (int i = 0; i < 16; ++i) {
                const float a2 = psa[(16 * q + i) * 128 + cs], b2 = psb[(16 * q + i) * 128 + cs];
                const bool reset = psamp ? ((i & 3) == 0) : (i == rs);
                float h0 = 0.f; if (psamp && reset) h0 = P.in[I_SLRU][(size_t)(l * 128 + ((pt0 + 16 * q - NPT) >> 2) + (i >> 2)) * 1024 + cgs];
                hh = reset ? a2 * h0 + b2 : a2 * hh + b2;
                psb[(16 * q + i) * 128 + cs] = hh;
            }
        }
        BAR_LDS();
        if (cur) {
            if (q == 3) {
                float A = 1.f, B = 0.f;
#pragma unroll
                for (int j = 0; j < 4; ++j) { const float Aj = qa[j * 128 + cs], Bj = qb[j * 128 + cs]; B = Aj * B + Bj; A *= Aj; }
                __hip_atomic_store(AGG + (size_t)tile * 2048 + cgs, A, __ATOMIC_RELAXED, __HIP_MEMORY_SCOPE_AGENT); __hip_atomic_store(AGG + (size_t)tile * 2048 + 1024 + cgs, B, __ATOMIC_RELAXED, __HIP_MEMORY_SCOPE_AGENT);
            }
        }
        if (prev >= 0) {
#pragma unroll
            for (int j = 0; j < 2; ++j) {
                const int r = r0 + 32 * j, m = pt0 + r;
                const f32x4 h0 = *(const LAS f32x4*)(psb + r * 128 + c8 * 8), h1 = *(const LAS f32x4*)(psb + r * 128 + c8 * 8 + 4);
                f32x4 q0, q1;
                q0[0] = h0[0] * bflo(gwp[j].x); q0[1] = h0[1] * bfhi(gwp[j].x); q0[2] = h0[2] * bflo(gwp[j].y); q0[3] = h0[3] * bfhi(gwp[j].y);
                q1[0] = h1[0] * bflo(gwp[j].z); q1[1] = h1[1] * bfhi(gwp[j].z); q1[2] = h1[2] * bflo(gwp[j].w); q1[3] = h1[3] * bfhi(gwp[j].w);
                *(u32x4*)(GG + (size_t)m * 1024 + c0) = pack8(q0, q1);
                float* so = nullptr;
                if (psamp) { if ((r & 3) == 3) so = P.out + O_LRS + (size_t)(l * 128 + ((m - NPT) >> 2)) * 1024; }
                else if (m % LP == LP - 1) so = P.out + O_LRP + (size_t)(l * 8 + m / LP) * 1024;
                if (so) { *(f32x4*)(so + c0) = h0; *(f32x4*)(so + c0 + 4) = h1; }
            }
        }
        if (cur) {
#pragma unroll
            for (int j = 0; j < 3; ++j) { pqa[j] = qa[j * 128 + cs]; pqb[j] = qb[j * 128 + cs]; }
            gwp[0] = gw[0]; gwp[1] = gw[1];
        }
        prev = cur ? tile : -1;
        BAR_LDS();
    }
}

__device__ __forceinline__ void attn_prompt_wave(const Params& P, int l, int qt, int tid_in) {
    const int tid = tid_in, lane = tid & 63, l32 = lane & 31, h = lane >> 5, head = tid >> 6, kvh = head >> 2;
    const bf16* Q = (const bf16*)((const unsigned char*)P.out + OB_Q); bf16* ATT = (bf16*)((unsigned char*)P.out + OB_ATT);
    const bf16* KB = (const bf16*)(P.ws + WS_KB); const bf16* VT = (const bf16*)(P.ws + WS_VT);
    const int q0 = qt * 32, key0 = q0 - 128;
    bf16x8 qf[4];
#pragma unroll
    for (int kk = 0; kk < 4; ++kk) qf[kk] = *(const bf16x8*)(Q + (size_t)(q0 + l32) * 512 + head * 64 + kk * 16 + h * 8);
    bf16x8 kf[5][4];
#pragma unroll
    for (int kb = 0; kb < 5; ++kb) {
        int krow_ = key0 + kb * 32 + l32; krow_ = krow_ < 0 ? 0 : krow_;
        const bf16* kp = KB + (size_t)krow_ * 128 + kvh * 64 + h * 8;
#pragma unroll
        for (int kk = 0; kk < 4; ++kk) kf[kb][kk] = *(const bf16x8*)(kp + kk * 16);
    }
    u32x2 vfa[5][2][2], vfb[5][2][2];
#pragma unroll
    for (int kb = 0; kb < 5; ++kb)
#pragma unroll
        for (int s = 0; s < 2; ++s) {
            int k0 = key0 + kb * 32 + 16 * s + 4 * h, k1 = k0 + 8; k0 = k0 < 0 ? 0 : k0; k1 = k1 < 0 ? 0 : k1;
#pragma unroll
            for (int db = 0; db < 2; ++db) {
                const bf16* vp = VT + ((size_t)kvh * (MP / 4) * 64 + db * 32 + l32) * 4;
                vfa[kb][s][db] = *(const u32x2*)(vp + (size_t)(k0 >> 2) * 256); vfb[kb][s][db] = *(const u32x2*)(vp + (size_t)(k1 >> 2) * 256);
            }
        }
    f32x16 st[5];
#pragma unroll
    for (int kb = 0; kb < 5; ++kb) {
#pragma unroll
        for (int i = 0; i < 16; ++i) st[kb][i] = 0.f;
#pragma unroll
        for (int kk = 0; kk < 4; ++kk) st[kb] = MFMA32(kf[kb][kk], qf[kk], st[kb]);
    }
    const int qi = q0 + l32, bstart = (qi / LP) * LP;
    const float sink = P.in[I_SINK][l * 8 + head];
    float mx = sink;
#pragma unroll
    for (int kb = 0; kb < 5; ++kb)
#pragma unroll
        for (int i = 0; i < 16; ++i) { const int ki = key0 + kb * 32 + crow(i, h); const bool ok = ki <= qi && ki > qi - 128 && ki >= bstart;
            st[kb][i] = ok ? st[kb][i] : -1e30f; mx = fmaxf(mx, st[kb][i]); }
    mx = fmaxf(mx, __shfl_xor(mx, 32));
    float sum = 0.f;
#pragma unroll
    for (int kb = 0; kb < 5; ++kb)
#pragma unroll
        for (int i = 0; i < 16; ++i) { const float p = st[kb][i] > -1e29f ? __expf(st[kb][i] - mx) : 0.f; st[kb][i] = p; sum += p; }
    sum += __shfl_xor(sum, 32);
    const float inv = 1.f / (sum + __expf(sink - mx));
    f32x16 o0, o1;
#pragma unroll
    for (int i = 0; i < 16; ++i) { o0[i] = 0.f; o1[i] = 0.f; }
#pragma unroll
    for (int kb = 0; kb < 5; ++kb)
#pragma unroll
        for (int s = 0; s < 2; ++s) {
            u32x4 pw; pw.x = cvtpk(st[kb][8 * s], st[kb][8 * s + 1]); pw.y = cvtpk(st[kb][8 * s + 2], st[kb][8 * s + 3]); pw.z = cvtpk(st[kb][8 * s + 4], st[kb][8 * s + 5]); pw.w = cvtpk(st[kb][8 * s + 6], st[kb][8 * s + 7]);
            const bf16x8 pf = __builtin_bit_cast(bf16x8, pw);
#pragma unroll
            for (int db = 0; db < 2; ++db) {
                const u32x2 va = vfa[kb][s][db], vb = vfb[kb][s][db];
                u32x4 vw; vw.x = va.x; vw.y = va.y; vw.z = vb.x; vw.w = vb.y;
                const bf16x8 vf = __builtin_bit_cast(bf16x8, vw);
                if (db == 0) o0 = MFMA32(vf, pf, o0); else o1 = MFMA32(vf, pf, o1);
            }
        }
    bf16* op = ATT + (size_t)qi * 512 + head * 64 + 4 * h;
#pragma unroll
    for (int g = 0; g < 4; ++g) {
        u32x2 w; w.x = cvtpk(o0[4 * g] * inv, o0[4 * g + 1] * inv); w.y = cvtpk(o0[4 * g + 2] * inv, o0[4 * g + 3] * inv); *(u32x2*)(op + 8 * g) = w;
        u32x2 w2; w2.x = cvtpk(o1[4 * g] * inv, o1[4 * g + 1] * inv); w2.y = cvtpk(o1[4 * g + 2] * inv, o1[4 * g + 3] * inv); *(u32x2*)(op + 32 + 8 * g) = w2;
    }
}

__device__ __forceinline__ void attn_sample_item(const Params& P, LAS unsigned char* lds, int l, int db, int kvh, int tid_in) {
    const int tid = tid_in, lane = tid & 63, wid = tid >> 6;
    LAS float* Ks = (LAS float*)lds;
    LAS float* Vs = Ks + 132 * 65;
    LAS float* qs = Vs + 132 * 64;
    LAS float* S = qs + 16 * 64;
    const bf16* Q = (const bf16*)((const unsigned char*)P.out + OB_Q); bf16* ATT = (bf16*)((unsigned char*)P.out + OB_ATT);
    const size_t cbase = (size_t)(l * 128 + db) * 128;
#pragma unroll
    for (int k = 0; k < 5; ++k) {
        const int e = tid + 512 * k;
        if (e < 132 * 16) {
            const int key = e >> 4, d4 = (e & 15) * 4;
            f32x4 kv, vv;
            if (key < 128) { kv = __builtin_nontemporal_load((const f32x4*)(P.in[I_CK] + ((cbase + key) * 2 + kvh) * 64 + d4)); vv = __builtin_nontemporal_load((const f32x4*)(P.in[I_CV] + ((cbase + key) * 2 + kvh) * 64 + d4)); }
            else { kv = *(const f32x4*)(P.out + O_WKS + ((cbase + key - 4) * 2 + kvh) * 64 + d4); vv = *(const f32x4*)(P.out + O_WVS + ((cbase + key - 4) * 2 + kvh) * 64 + d4); }
            Ks[key * 65 + d4] = kv[0]; Ks[key * 65 + d4 + 1] = kv[1]; Ks[key * 65 + d4 + 2] = kv[2]; Ks[key * 65 + d4 + 3] = kv[3];
            *(LAS f32x4*)(Vs + key * 64 + d4) = vv;
            if (key >= 4 && key < 128) { *(f32x4*)(P.out + O_WKS + ((cbase + key - 4) * 2 + kvh) * 64 + d4) = kv; *(f32x4*)(P.out + O_WVS + ((cbase + key - 4) * 2 + kvh) * 64 + d4) = vv; }
        }
    }
    for (int e = tid; e < 16 * 64; e += 512) {
        const int row = e >> 6, d = e & 63, g = row >> 2, s = row & 3, p = d < 32 ? 2 * d : 2 * (d - 32) + 1;
        qs[e] = bf2f(Q[(size_t)(NPT + db * 4 + s) * 512 + (kvh * 4 + g) * 64 + p]);
    }
    __syncthreads();
    for (int e = tid; e < 16 * 132; e += 512) {
        const int row = e / 132, key = e % 132, s = row & 3;
        float acc = 0.f;
#pragma unroll 16
        for (int d = 0; d < 64; ++d) acc += qs[row * 64 + d] * Ks[key * 65 + d];
        const bool ok = key < 128 ? key > s : (key - 128) <= s;
        S[e] = ok ? acc : -1e30f;
    }
    __syncthreads();
    for (int rr = 0; rr < 2; ++rr) {
        const int row = wid * 2 + rr, g = row >> 2; const float sink = P.in[I_SINK][l * 8 + kvh * 4 + g];
        float v0 = S[row * 132 + lane], v1 = S[row * 132 + 64 + lane], v2 = lane < 4 ? S[row * 132 + 128 + lane] : -1e30f;
        float mx = fmaxf(fmaxf(v0, v1), fmaxf(v2, sink));
#pragma unroll
        for (int o = 1; o < 64; o <<= 1) mx = fmaxf(mx, __shfl_xor(mx, o));
        const float p0 = v0 > -1e29f ? __expf(v0 - mx) : 0.f, p1 = v1 > -1e29f ? __expf(v1 - mx) : 0.f, p2 = v2 > -1e29f ? __expf(v2 - mx) : 0.f;
        float sum = p0 + p1 + p2;
#pragma unroll
        for (int o = 1; o < 64; o <<= 1) sum += __shfl_xor(sum, o);
        const float inv = 1.f / (sum + __expf(sink - mx));
        S[row * 132 + lane] = p0 * inv; S[row * 132 + 64 + lane] = p1 * inv; if (lane < 4) S[row * 132 + 128 + lane] = p2 * inv;
    }
    __syncthreads();
    for (int e = tid; e < 16 * 64; e += 512) {
        const int row = e >> 6, d = e & 63, g = row >> 2, s = row & 3;
        float acc = 0.f;
#pragma unroll 4
        for (int key = 0; key < 132; ++key) acc += S[row * 132 + key] * Vs[key * 64 + d];
        ATT[(size_t)(NPT + db * 4 + s) * 512 + (kvh * 4 + g) * 64 + d] = f2bf(acc);
    }
    __syncthreads();
}

constexpr int MAIN_ROWS = 16384, TAIL_TILES = ((M - MAIN_ROWS) / 64) * 16;
static_assert((M - MAIN_ROWS) % 64 == 0 && TAIL_TILES <= 256, "tail tiling");
struct TailEpi { bf16* S; const bf16* A; float* Z; bf16* ZB; const float* pst; const float* pg; const float* pb; float* ost; };
template <int EPI> __device__ __forceinline__ void tail_gemm(LAS unsigned char* lds, const bf16* Am, const bf16* Bt, int K, const TailEpi& E, int tid_in) {
    for (int su = blockIdx.x; su < TAIL_TILES; su += gridDim.x) {
    const int tid = tid_in, lane = tid & 63, w = tid >> 6, l15 = lane & 15, q4 = lane >> 4;
    const int row0 = MAIN_ROWS + (su >> 4) * 64, col0 = (su & 15) * 64;
    f32x4 acc[4][4];
#pragma unroll
    for (int i = 0; i < 4; ++i)
#pragma unroll
        for (int j = 0; j < 4; ++j) acc[i][j] = (f32x4){0.f, 0.f, 0.f, 0.f};
    const bf16* ap = Am + (size_t)(row0 + l15) * K + q4 * 8;
    const bf16* bp = Bt + (size_t)(col0 + l15) * K + q4 * 8;
    {
        const int nks = K / 32;
        bf16x8 a0[4], b0[4], a1[4], b1[4], a2[4], b2[4];
#define TG_LOAD(A_, B_, KS_) do { const int ks_ = (KS_) < nks ? (KS_) : w; _Pragma("unroll") for (int i = 0; i < 4; ++i) { A_[i] = *(const bf16x8*)(ap + (size_t)i * 16 * K + ks_ * 32); B_[i] = *(const bf16x8*)(bp + (size_t)i * 16 * K + ks_ * 32); } } while (0)
#define TG_MMA(A_, B_) do { _Pragma("unroll") for (int i = 0; i < 4; ++i) _Pragma("unroll") for (int j = 0; j < 4; ++j) acc[i][j] = __builtin_amdgcn_mfma_f32_16x16x32_bf16(A_[i], B_[j], acc[i][j], 0, 0, 0); } while (0)
        TG_LOAD(a0, b0, w); TG_LOAD(a1, b1, w + 8);
        for (int ks = w; ks < nks; ks += 24) {
            TG_LOAD(a2, b2, ks + 16); TG_MMA(a0, b0);
            if (ks + 8 < nks) { TG_LOAD(a0, b0, ks + 24); TG_MMA(a1, b1); }
            if (ks + 16 < nks) { TG_LOAD(a1, b1, ks + 32); TG_MMA(a2, b2); }
        }
#undef TG_LOAD
#undef TG_MMA
    }
    LAS float* part = (LAS float*)lds + (size_t)w * 64 * 65;
#pragma unroll
    for (int i = 0; i < 4; ++i)
#pragma unroll
        for (int j = 0; j < 4; ++j)
#pragma unroll
            for (int r = 0; r < 4; ++r) part[(16 * i + 4 * q4 + r) * 65 + 16 * j + l15] = acc[i][j][r];
    BAR_LDS();
    const int rl = tid >> 3, c8 = (tid & 7) * 8, row = row0 + rl, col = col0 + c8;
    f32x4 v0 = {0.f, 0.f, 0.f, 0.f}, v1 = v0;
#pragma unroll
    for (int ww = 0; ww < 8; ++ww) { const LAS float* p = (const LAS float*)lds + (size_t)ww * 64 * 65 + rl * 65 + c8;
        v0[0] += p[0]; v0[1] += p[1]; v0[2] += p[2]; v0[3] += p[3]; v1[0] += p[4]; v1[1] += p[5]; v1[2] += p[6]; v1[3] += p[7]; }
    const size_t off = (size_t)row * 1024 + col;
    if (EPI == 0 || EPI == 1) {
        const u32x4 s = *(const u32x4*)(E.S + off);
        v0[0] *= bflo(s.x); v0[1] *= bfhi(s.x); v0[2] *= bflo(s.y); v0[3] *= bfhi(s.y); v1[0] *= bflo(s.z); v1[1] *= bfhi(s.z); v1[2] *= bflo(s.w); v1[3] *= bfhi(s.w);
        if (EPI == 1) { const u32x4 a = *(const u32x4*)(E.A + off);
            v0[0] += bflo(a.x); v0[1] += bfhi(a.x); v0[2] += bflo(a.y); v0[3] += bfhi(a.y); v1[0] += bflo(a.z); v1[1] += bfhi(a.z); v1[2] += bflo(a.w); v1[3] += bfhi(a.w); }
        *(u32x4*)(E.S + off) = pack8(v0, v1);
    } else {
        const u32x4 zw = *(const u32x4*)(E.ZB + off);
        f32x4 x0 = {bflo(zw.x), bfhi(zw.x), bflo(zw.y), bfhi(zw.y)}, x1 = {bflo(zw.z), bfhi(zw.z), bflo(zw.w), bfhi(zw.w)};
        if (E.pst) {
            const f32x4* sp = (const f32x4*)(E.pst + (size_t)row * 32); float s = 0.f, q = 0.f;
#pragma unroll
            for (int i = 0; i < 8; ++i) { const f32x4 t = sp[i]; s += t[0] + t[2]; q += t[1] + t[3]; }
            const float mu = s * (1.f / D), rstd = __builtin_amdgcn_rsqf(fmaxf(q * (1.f / D) - mu * mu, 0.f) + LN_EPS);
            const f32x4 g0 = *(const f32x4*)(E.pg + col), g1 = *(const f32x4*)(E.pg + col + 4), b0 = *(const f32x4*)(E.pb + col), b1 = *(const f32x4*)(E.pb + col + 4);
            x0 = (x0 - mu) * rstd * g0 + b0; x1 = (x1 - mu) * rstd * g1 + b1;
        }
        x0 = x0 * ALPHA + v0; x1 = x1 * ALPHA + v1;
        if (E.Z) { *(f32x4*)(E.Z + off) = x0; *(f32x4*)(E.Z + off + 4) = x1; }
        *(u32x4*)(E.ZB + off) = pack8(x0, x1);
        float s = ((x0[0] + x0[1]) + (x0[2] + x0[3])) + ((x1[0] + x1[1]) + (x1[2] + x1[3]));
        float q = ((x0[0] * x0[0] + x0[1] * x0[1]) + (x0[2] * x0[2] + x0[3] * x0[3])) + ((x1[0] * x1[0] + x1[1] * x1[1]) + (x1[2] * x1[2] + x1[3] * x1[3]));
        s += __shfl_xor(s, 1); q += __shfl_xor(q, 1); s += __shfl_xor(s, 2); q += __shfl_xor(q, 2); s += __shfl_xor(s, 4); q += __shfl_xor(q, 4);
        if ((tid & 7) == 0) { typedef float f32x2v __attribute__((ext_vector_type(2))); *(f32x2v*)(E.ost + (size_t)row * 32 + (su & 15) * 2) = (f32x2v){s, q}; }
    }
    BAR_LDS();
    }
}

#define XB_TMO      128
#define XB_XCNT(j)  (256  + 64 * (j))
#define XB_XSUB(j)  (1280 + 64 * (j))
#define XB_XGEN(j)  (2304 + 64 * (j))
#define XB_TOP      3328
#define XB_TOPGEN   3392
#define XCD_BAR_WORDS 3456
#define XB_SPIN_CAP (1u << 18)

__device__ __forceinline__ unsigned xb_ld(unsigned* p)              { return __hip_atomic_load(p, __ATOMIC_RELAXED, __HIP_MEMORY_SCOPE_AGENT); }
__device__ __forceinline__ unsigned xb_add(unsigned* p, unsigned v) { return __hip_atomic_fetch_add(p, v, __ATOMIC_RELAXED, __HIP_MEMORY_SCOPE_AGENT); }
__device__ __forceinline__ unsigned xb_xcc_id() { return (unsigned)__builtin_amdgcn_s_getreg((3 << 11) | 20) & 0xFu; }
#define XB_SPIN(cond, bar) do { unsigned _sp = 0; while (cond) { __builtin_amdgcn_s_sleep(1); \
    if ((++_sp & 255u) == 0u) { if (xb_ld(&(bar)[XB_TMO])) break; if (_sp > XB_SPIN_CAP) { atomicAdd(&(bar)[XB_TMO], 1u); break; } } } } while (0)

struct XcdBarrier {
    unsigned* bar; unsigned x;
    volatile LAS unsigned* st;
};

__device__ __forceinline__ XcdBarrier xcd_barrier_post(unsigned* bar, volatile LAS unsigned* st, int xb_tid) {
    XcdBarrier b; b.bar = bar; b.x = xb_xcc_id(); b.st = st;
    if (xb_tid == 0) (void)xb_add(&bar[XB_XCNT(b.x)], 1u);
    return b;
}
__device__ __forceinline__ void xcd_barrier_complete(unsigned* bar, unsigned x, unsigned& nloc, unsigned& nx) {
    const unsigned G = gridDim.x * gridDim.y * gridDim.z;
    unsigned sum, cnt, mine, sp = 0u;
    for (;;) {
        sum = 0u; cnt = 0u; mine = 0u;
#pragma unroll
        for (unsigned j = 0; j < 16; ++j) { const unsigned c = xb_ld(&bar[XB_XCNT(j)]); sum += c; cnt += (c > 0u) ? 1u : 0u; mine = (j == x) ? c : mine; }
        if (sum == G) break;
        __builtin_amdgcn_s_sleep(1);
        if ((++sp & 255u) == 0u) { if (xb_ld(&bar[XB_TMO])) break; if (sp > XB_SPIN_CAP) { atomicAdd(&bar[XB_TMO], 1u); break; } }
    }
    nloc = mine > 0u ? mine : 1u; nx = cnt > 0u ? cnt : 1u;
}

__device__ __forceinline__ void xcd_barrier(const XcdBarrier& b, int xb_tid) {
    asm volatile("s_waitcnt vmcnt(0)" ::: "memory");
    __syncthreads();
    if (xb_tid == 0) {
        unsigned* bar = b.bar;
        __builtin_amdgcn_s_waitcnt(0);
        unsigned nloc = b.st[0], nx = b.st[1];
        if (nloc == 0u) { xcd_barrier_complete(bar, b.x, nloc, nx); b.st[0] = nloc; b.st[1] = nx; }
        const unsigned old = xb_add(&bar[XB_XSUB(b.x)], 1u);
        const unsigned gen = old / nloc;
        if (old + 1u == (gen + 1u) * nloc) {
            __builtin_amdgcn_fence(__ATOMIC_RELEASE, "agent");
            asm volatile("s_waitcnt vmcnt(0)" ::: "memory");
            const unsigned og = xb_add(&bar[XB_TOP], 1u);
            const unsigned tg = og / nx;
            if (og + 1u == (tg + 1u) * nx) xb_add(&bar[XB_TOPGEN], 1u);
            else XB_SPIN(xb_ld(&bar[XB_TOPGEN]) == tg, bar);
            __builtin_amdgcn_fence(__ATOMIC_ACQUIRE, "agent");
            xb_add(&bar[XB_XGEN(b.x)], 1u);
            asm volatile("s_waitcnt vmcnt(0)" ::: "memory");
        } else {
            XB_SPIN(xb_ld(&bar[XB_XGEN(b.x)]) == gen, bar);
            __builtin_amdgcn_fence(__ATOMIC_ACQUIRE, "agent");
            asm volatile("s_waitcnt vmcnt(0)" ::: "memory");
        }
    }
    __syncthreads();
}

__global__ void __launch_bounds__(512, 2) fwd_mega(Params P) {
    extern __shared__ __attribute__((aligned(16))) unsigned char lds_raw[];
    LAS unsigned char* lds = (LAS unsigned char*)lds_raw;
    cg::grid_group grid = cg::this_grid();
    unsigned char* ws = P.ws;
    const int G = gridDim.x, bx = blockIdx.x;
    const int wv = __builtin_amdgcn_readfirstlane((int)(threadIdx.x >> 6));
    bf16* XB = (bf16*)(ws + WS_XB); float* X = (float*)(ws + WS_X);
    bf16* Qb = (bf16*)((unsigned char*)P.out + OB_Q); bf16* ATT = (bf16*)((unsigned char*)P.out + OB_ATT);
    bf16 *KB = (bf16*)(ws + WS_KB), *VT = (bf16*)(ws + WS_VT), *XR = (bf16*)(ws + WS_XR), *GG = (bf16*)(ws + WS_GG), *SA = (bf16*)(ws + WS_SA), *SL = (bf16*)(ws + WS_SL), *H = (bf16*)(ws + WS_H);

    if (threadIdx.x < 4) ((volatile LAS unsigned*)(lds + LDS_ST))[threadIdx.x] = 0u;
    __syncthreads();
    const XcdBarrier xbar = xcd_barrier_post((unsigned*)(ws + WS_BAR), (volatile LAS unsigned*)(lds + LDS_ST), mk_tid(wv));
    if (G == 0x7fffffff) grid.sync();
#ifndef NO_P0
    prologue(P, lds, mk_tid(wv));
    if (DUP_P0) { __syncthreads(); prologue(P, lds, mk_tid(wv)); }
#endif
    GSYNC();
    {
        const float* part = (const float*)(ws + WS_PART); float* c12 = (float*)(ws + WS_C12);
        for (int e = bx * 512 + (int)threadIdx.x; e < DEPTH * NC12 * 2; e += G * 512) { const int l = e / (NC12 * 2), r = e % (NC12 * 2); float s = 0.f;
#pragma unroll
            for (int kb = 0; kb < 16; ++kb) s += part[((size_t)l * 16 + kb) * NC12 * 2 + r];
            c12[e] = s; }
    }
    for (int l = 0; l < DEPTH; ++l) {
        {
            pg8::Gemm g{XB, (const bf16*)(ws + WS_WIN + l * SZ_WIN), MP, DIN, D}; int bxl = bx, Gl = G; asm volatile("" : "+s"(bxl), "+s"(Gl)); pg8::StaticOrder S; S.init(MP, DIN, Gl, bxl);
            EpiProj E{l, Qb, KB, VT, XR, (const float*)(ws + WS_ROPE), P.out, l > 0 ? (const float*)(ws + WS_SS) + (size_t)((2 * l - 1) % 3) * SS_INST : nullptr, (const float*)(ws + WS_C12) + (size_t)l * NC12 * 2, 4 * l + 1};
#ifndef NO_G1
            pg8::gemm_phase<EpiProj, pg8::StaticOrder, true, true>(lds, g, S, E, mk_tid(wv));
            if (DUP_G1) { __syncthreads(); pg8::gemm_phase<EpiProj, pg8::StaticOrder, true, true>(lds, g, S, E, mk_tid(wv)); }
#endif
        }
        GSYNC();
        if (DUP_ATT) { for (int it = bx; it < 772; it += G) { if (it < 516) attn_prompt_wave(P, l, it, mk_tid(wv)); else attn_sample_item(P, lds, l, (it - 516) >> 1, (it - 516) & 1, mk_tid(wv)); } __syncthreads(); }
        for (int it = G - 1 - bx; it < 772; it += G) { if (it < 516) attn_prompt_wave(P, l, it, mk_tid(wv)); else attn_sample_item(P, lds, l, (it - 516) >> 1, (it - 516) & 1, mk_tid(wv)); }
        __syncthreads();
#ifndef NO_LRU1
        lru_phase<1>(P, lds, l, mk_tid(wv));
#endif
        GSYNC();
        {
            pg8::Gemm g{ATT, (const bf16*)(ws + WS_WAP + l * SZ_WAP), MAIN_ROWS, D, 512}; int bxl = bx, Gl = G; asm volatile("" : "+s"(bxl), "+s"(Gl)); pg8::StaticOrder S; S.init(MAIN_ROWS, D, Gl, bxl);
            EpiGate<false> E{SA, nullptr};
#ifndef NO_G3
            pg8::gemm_phase<EpiGate<false>, pg8::StaticOrder, true, true>(lds, g, S, E, mk_tid(wv));
            { TailEpi T{SA, nullptr, nullptr, nullptr, nullptr, nullptr, nullptr, nullptr}; tail_gemm<0>(lds, ATT, (const bf16*)(ws + WS_WAP + l * SZ_WAP), 512, T, mk_tid(wv)); }
#endif
        }
        __syncthreads();
        {
            pg8::Gemm g{GG, (const bf16*)(ws + WS_WLP + l * SZ_WLP), MAIN_ROWS, D, D}; int bxl = bx, Gl = G; asm volatile("" : "+s"(bxl), "+s"(Gl)); pg8::StaticOrder S; S.init(MAIN_ROWS, D, Gl, bxl);
            EpiGate<true> E{SL, SA};
#ifndef NO_G4
            pg8::gemm_phase<EpiGate<true>, pg8::StaticOrder, true, true>(lds, g, S, E, mk_tid(wv));
            { TailEpi T{SL, SA, nullptr, nullptr, nullptr, nullptr, nullptr, nullptr}; tail_gemm<1>(lds, GG, (const bf16*)(ws + WS_WLP + l * SZ_WLP), D, T, mk_tid(wv)); }
#endif
        }
        GSYNC();
        {
            pg8::Gemm g{SL, (const bf16*)(ws + WS_WOUT + l * SZ_WOUT), MAIN_ROWS, D, D}; int bxl = bx, Gl = G; asm volatile("" : "+s"(bxl), "+s"(Gl)); pg8::StaticOrder S; S.init(MAIN_ROWS, D, Gl, bxl);
            EpiRes E{nullptr, XB, l > 0 ? (const float*)(ws + WS_SS) + (size_t)((2 * l - 1) % 3) * SS_INST : nullptr, P.in[I_L2G] + (l > 0 ? l - 1 : 0) * D, P.in[I_L2B] + (l > 0 ? l - 1 : 0) * D, (float*)(ws + WS_SS) + (size_t)((2 * l) % 3) * SS_INST, 4 * l + 2};
#ifndef NO_G5
            pg8::gemm_phase<EpiRes, pg8::StaticOrder, true, true>(lds, g, S, E, mk_tid(wv));
            { TailEpi T{nullptr, nullptr, E.Z, E.ZB, E.pst, E.pg, E.pb, E.ost}; tail_gemm<2>(lds, SL, (const bf16*)(ws + WS_WOUT + l * SZ_WOUT), D, T, mk_tid(wv)); }
#endif
        }
        GSYNC();
        {
            pg8::Gemm g{XB, (const bf16*)(ws + WS_WFI + l * SZ_WFI), MP, 2 * DFF, D}; int bxl = bx, Gl = G; asm volatile("" : "+s"(bxl), "+s"(Gl)); pg8::StaticOrder S; S.init(MP, 2 * DFF, Gl, bxl);
            EpiSwiglu E{H, (const float*)(ws + WS_SS) + (size_t)((2 * l) % 3) * SS_INST, (const float*)(ws + WS_C12) + ((size_t)l * NC12 + DIN) * 2, 4 * l + 3};
#ifndef NO_G6
            pg8::gemm_phase<EpiSwiglu, pg8::StaticOrder, true, true>(lds, g, S, E, mk_tid(wv));
            if (DUP_G6) { __syncthreads(); pg8::gemm_phase<EpiSwiglu, pg8::StaticOrder, true, true>(lds, g, S, E, mk_tid(wv)); }
#endif
        }
        GSYNC();
        {
            pg8::Gemm g{H, (const bf16*)(ws + WS_WFO + l * SZ_WFO), MAIN_ROWS, D, DFF}; int bxl = bx, Gl = G; asm volatile("" : "+s"(bxl), "+s"(Gl)); pg8::StaticOrder S; S.init(MAIN_ROWS, D, Gl, bxl);
            EpiRes E{l == DEPTH - 1 ? X : nullptr, XB, (const float*)(ws + WS_SS) + (size_t)((2 * l) % 3) * SS_INST, P.in[I_L1G] + l * D, P.in[I_L1B] + l * D, (float*)(ws + WS_SS) + (size_t)((2 * l + 1) % 3) * SS_INST, 4 * l + 4};
#ifndef NO_G5
            if (DUP_G7) { EpiRes E2{nullptr, (bf16*)(ws + WS_R + (size_t)100 * 1024 * 1024), E.pst, E.pg, E.pb, (float*)(ws + WS_SS) + (size_t)((2 * l + 2) % 3) * SS_INST, 0};
                pg8::gemm_phase<EpiRes, pg8::StaticOrder, true, true>(lds, g, S, E2, mk_tid(wv)); __syncthreads(); }
            pg8::gemm_phase<EpiRes, pg8::StaticOrder, true, true>(lds, g, S, E, mk_tid(wv));
            { TailEpi T{nullptr, nullptr, E.Z, E.ZB, E.pst, E.pg, E.pb, E.ost}; tail_gemm<2>(lds, H, (const bf16*)(ws + WS_WFO + l * SZ_WFO), DFF, T, mk_tid(wv)); }
#endif
        }
        GSYNC();
    }
    ln_pass<true>(P, P.in[I_L2G] + (DEPTH - 1) * D, P.in[I_L2B] + (DEPTH - 1) * D, mk_tid(wv));
}

extern "C" void kernel_launch(void* const* d_in, const int* in_sizes, int n_in, void* d_out, int out_size, void* d_ws, size_t ws_size, hipStream_t stream) {
    static int grid = 0;
    if (grid == 0) {
        if (n_in != 25 || (size_t)out_size != O_END || ws_size < WS_TOTAL) { fprintf(stderr, "kernel_launch: unexpected shapes (n_in %d out %d ws %zu need %zu)\n", n_in, out_size, ws_size, (size_t)WS_TOTAL); grid = -1; return; }
        int dev = 0, cus = 0, per = 0;
        if (hipGetDevice(&dev) != hipSuccess || hipDeviceGetAttribute(&cus, hipDeviceAttributeMultiprocessorCount, dev) != hipSuccess) { grid = -1; return; }
        if (hipFuncSetAttribute((const void*)fwd_mega, hipFuncAttributeMaxDynamicSharedMemorySize, LDS_BYTES) != hipSuccess) { fprintf(stderr, "hipFuncSetAttribute failed\n"); grid = -1; return; }
        if (hipOccupancyMaxActiveBlocksPerMultiprocessor(&per, (const void*)fwd_mega, 512, LDS_BYTES) != hipSuccess || per < 1) { fprintf(stderr, "occupancy query: %d\n", per); per = 1; }
        (void)hipGetLastError();
        grid = cus & ~7;
        if (grid < 8) { grid = -1; return; }
    }
    if (grid < 0) return;
    if (hipMemsetAsync((unsigned char*)d_ws + WS_BAR, 0, 16384, stream) != hipSuccess) { fprintf(stderr, "kernel_launch: hipMemsetAsync of the barrier words failed\n"); return; }
    Params p{};
    for (int i = 0; i < 25; ++i) p.in[i] = (const float*)d_in[i];
    p.out = (float*)d_out; p.ws = (unsigned char*)d_ws;
    void* args[] = {&p};
    hipError_t e = hipLaunchCooperativeKernel((const void*)fwd_mega, dim3(grid), dim3(512), args, LDS_BYTES, stream);
    if (e != hipSuccess) fprintf(stderr, "cooperative launch failed: %s (grid %d)\n", hipGetErrorString(e), grid);
}
```
